# Optimizing an MI355X kernel written in HIP

```python
import math
import jax
import jax.numpy as jnp
from jax import lax
import numpy as np

D_MODEL = 1024
BATCH = 4
SEQ = 4096
DEPTH = 2

GRID_W = 64
CTX_LEN = 256
HEAD_DIM = 64
ATT_Q_HEADS = 8
ATT_KV_HEADS = 2
ATT_GROUP = ATT_Q_HEADS // ATT_KV_HEADS
ATT_W = ATT_Q_HEADS * HEAD_DIM
KV_W = ATT_KV_HEADS * HEAD_DIM
Q_BLOCK = 128
ROPE_THETA = 10000.0
HY_W = 256
HY_SHORT = 3
HY_EMB = 33
HY_BANDS = (HY_EMB - 1) // 2
HY_FO = 64
HY_DECAY_TARGET = 1e-2
HY_FAST_DECAY_PCT = 0.3
HY_SLOW_DECAY_PCT = 1.5
HY_MIN_DECAY = math.log(HY_DECAY_TARGET) / HY_SLOW_DECAY_PCT
HY_MAX_DECAY = math.log(HY_DECAY_TARGET) / HY_FAST_DECAY_PCT
NA_HEADS = 4
NA_W = NA_HEADS * HEAD_DIM
NA_WIN_ROWS = 8
NA_WIN_COLS = 16
D_MIX = ATT_W + HY_W + NA_W
D_IN = ATT_W + 2 * KV_W + 3 * HY_W + 3 * NA_W
SPLIT_POINTS = (ATT_W, ATT_W + KV_W, ATT_W + 2 * KV_W, ATT_W + 2 * KV_W + 3 * HY_W,
                ATT_W + 2 * KV_W + 3 * HY_W + NA_W, ATT_W + 2 * KV_W + 3 * HY_W + 2 * NA_W)
N_EXPERTS = 32
TOP_K = 4
D_EXPERT = D_MODEL
SWIGLU_ALPHA = 1.702
SWIGLU_LIMIT = 7.0
DEEPNORM_ALPHA = (2.0 * DEPTH) ** 0.25
DEEPNORM_BETA = (8.0 * DEPTH) ** -0.25
NORM_EPS = 1e-6

kernel_name = 'hybrid_gqa_hyena_natten_moe_dit'


def layer_norm(x, g=None, b=None):
    xf = x.astype(jnp.float32)
    mu = jnp.mean(xf, axis=-1, keepdims=True)
    var = jnp.mean(jnp.square(xf - mu), axis=-1, keepdims=True)
    y = (xf - mu) * lax.rsqrt(var + NORM_EPS)
    if g is not None:
        y = y * g + b
    return y.astype(x.dtype)


def rms_norm(x, g):
    xf = x.astype(jnp.float32)
    y = xf * lax.rsqrt(jnp.mean(jnp.square(xf), axis=-1, keepdims=True) + NORM_EPS) * g
    return y.astype(x.dtype)


def modulate(x, shift, scale):
    return layer_norm(x) * (1.0 + scale) + shift


def heads(t, n):
    return t.reshape(t.shape[0], t.shape[1], n, HEAD_DIM)


def rope_2d_tables(n_tokens):
    t = jnp.arange(n_tokens)
    row = (t // GRID_W).astype(jnp.float32)[:, None]
    col = (t % GRID_W).astype(jnp.float32)[:, None]
    axis_dim = HEAD_DIM // 2
    inv_freq = ROPE_THETA ** (-jnp.arange(0, axis_dim, 2, dtype=jnp.float32) / axis_dim)
    ang_r = row * inv_freq
    ang_c = col * inv_freq
    ang = jnp.concatenate([ang_r, ang_r, ang_c, ang_c], axis=-1)[:, None, :]
    return jnp.cos(ang), jnp.sin(ang)


def apply_rope_2d(x, cos, sin):
    xf = x.astype(jnp.float32)
    xs = xf.reshape(*x.shape[:-1], 2, 2, HEAD_DIM // 4)
    rot = jnp.stack([-xs[..., 1, :], xs[..., 0, :]], axis=-2).reshape(x.shape)
    return (xf * cos + rot * sin).astype(x.dtype)


def gqa_attention(q, k, v):
    s = jnp.einsum('blkgd,bskd->bkgls', q, k).astype(jnp.float32)
    p = jax.nn.softmax(s, axis=-1).astype(v.dtype)
    o = jnp.einsum('bkgls,bskd->blkgd', p, v)
    return o.reshape(o.shape[0], o.shape[1], -1)


def gqa_block_sweep(q, k, v):
    B, L = q.shape[:2]
    nb = L // Q_BLOCK
    qb = jnp.moveaxis(q.reshape(B, nb, Q_BLOCK, *q.shape[2:]), 1, 0)
    o = lax.map(lambda qq: gqa_attention(qq, k, v), qb)
    return jnp.moveaxis(o, 0, 1).reshape(B, L, -1)


def neighbourhood_attention(q, k, v, k_ctx, v_ctx, rpb):
    B, N, H, hd = q.shape
    rows = N // GRID_W
    wr = min(NA_WIN_ROWS, rows)
    wc = NA_WIN_COLS
    qg = jnp.moveaxis(q.reshape(B, rows, GRID_W, H, hd), 1, 0) * (hd ** -0.5)
    kg = k.reshape(B, rows, GRID_W, H, hd)
    vg = v.reshape(B, rows, GRID_W, H, hd)
    col = jnp.arange(GRID_W)
    col_idx = jnp.clip(col - wc // 2, 0, GRID_W - wc)[:, None] + jnp.arange(wc)[None, :]
    rel_col = col_idx - col[:, None] + (NA_WIN_COLS - 1)
    rpb_cols = rpb[:, :, rel_col]

    def row_block(args):
        r, qr = args
        rs = jnp.clip(r - wr // 2, 0, rows - wr)
        kw = lax.dynamic_slice_in_dim(kg, rs, wr, axis=1)[:, :, col_idx]
        vw = lax.dynamic_slice_in_dim(vg, rs, wr, axis=1)[:, :, col_idx]
        rel_row = rs + jnp.arange(wr) - r + (NA_WIN_ROWS - 1)
        bias = jnp.moveaxis(rpb_cols[:, rel_row], 1, 2).astype(jnp.float32)
        s_loc = jnp.einsum('bqhd,biqjhd->bhqij', qr, kw).astype(jnp.float32) + bias
        s_ctx = jnp.einsum('bqhd,bmhd->bhqm', qr, k_ctx).astype(jnp.float32)
        s = jnp.concatenate([s_loc.reshape(B, H, GRID_W, wr * wc), s_ctx], axis=-1)
        p = jax.nn.softmax(s, axis=-1).astype(v.dtype)
        p_loc = p[..., :wr * wc].reshape(B, H, GRID_W, wr, wc)
        return (jnp.einsum('bhqij,biqjhd->bqhd', p_loc, vw)
                + jnp.einsum('bhqm,bmhd->bqhd', p[..., wr * wc:], v_ctx))

    o = lax.map(row_block, (jnp.arange(rows), qg))
    return jnp.moveaxis(o, 0, 1).reshape(B, N, H * hd)


def short_conv(u, w, b):
    L = u.shape[1]
    pad = HY_SHORT // 2
    up = jnp.pad(u, ((0, 0), (pad, HY_SHORT - 1 - pad), (0, 0)))
    return sum(up[:, j:j + L] * w[j] for j in range(HY_SHORT)) + b


def hyena_filter(L, f_w1, f_b1, f_freq, f_w2, f_b2, f_w3, f_b3):
    f32 = jnp.float32
    t = jnp.linspace(0.0, 1.0, L, dtype=f32)[:, None]
    w = (2.0 * math.pi / L) * jnp.arange(L, dtype=f32)[:, None]
    bands = jnp.linspace(1e-4, HY_BANDS - 1, HY_BANDS, dtype=f32)[None, :]
    z = jnp.concatenate([t, jnp.cos(bands * w), -jnp.sin(bands * w)], axis=-1)
    hid = jnp.sin(f_freq[0] * (z @ f_w1 + f_b1))
    hid = jnp.sin(f_freq[1] * (hid @ f_w2 + f_b2))
    filt = (hid @ f_w3 + f_b3).astype(f32).reshape(L, 2, HY_W)
    deltas = jnp.linspace(HY_MIN_DECAY, HY_MAX_DECAY, HY_W, dtype=f32)
    filt = filt * jnp.exp(-t * jnp.abs(deltas))[:, None, :]
    h_fwd, h_bwd = filt[:, 0], filt[:, 1]
    g = jnp.concatenate([h_fwd, jnp.zeros((1, HY_W), f32), h_bwd[:0:-1]], axis=0)
    return g * lax.rsqrt(jnp.sum(g * g, axis=0, keepdims=True) + NORM_EPS)


def hyena_mixer(p, conv_w, conv_b, f_w1, f_b1, f_freq, f_w2, f_b2, f_w3, f_b3, d_skip):
    L = p.shape[1]
    x0, x1, v = jnp.split(short_conv(p, conv_w, conv_b), 3, axis=-1)
    g = hyena_filter(L, f_w1, f_b1, f_freq, f_w2, f_b2, f_w3, f_b3)
    z = (x1 * v).astype(jnp.float32)
    zf = jnp.fft.rfft(z, n=2 * L, axis=1)
    gf = jnp.fft.rfft(g, n=2 * L, axis=0)
    y = jnp.fft.irfft(zf * gf[None], n=2 * L, axis=1)[:, :L] + z * d_skip
    return (x0 * y).astype(p.dtype)


def token_mixer(h, hc, need_ctx, w_in, w_out, q_gain, k_gain, conv_w, conv_b, f_w1, f_b1, f_freq,
                f_w2, f_b2, f_w3, f_b3, d_skip, rpb, cos, sin):
    B, N, _ = h.shape
    M = hc.shape[1]
    scale = HEAD_DIM ** -0.5
    a_q, a_k, a_v, hy_p, n_q, n_k, n_v = jnp.split(h @ w_in, SPLIT_POINTS, axis=-1)
    if need_ctx:
        ca_q, ca_k, ca_v, chy_p, cn_q, cn_k, cn_v = jnp.split(hc @ w_in, SPLIT_POINTS, axis=-1)
    else:
        ca_k, ca_v = jnp.split(hc @ w_in[:, ATT_W:ATT_W + 2 * KV_W], 2, axis=-1)
        cn_k, cn_v = jnp.split(hc @ w_in[:, D_IN - 2 * NA_W:], 2, axis=-1)
    q = apply_rope_2d(rms_norm(heads(a_q, ATT_Q_HEADS), q_gain), cos, sin) * scale
    k = apply_rope_2d(rms_norm(heads(a_k, ATT_KV_HEADS), k_gain), cos, sin)
    ck = rms_norm(heads(ca_k, ATT_KV_HEADS), k_gain)
    cv = heads(ca_v, ATT_KV_HEADS)
    k_all = jnp.concatenate([k, ck], axis=1)
    v_all = jnp.concatenate([heads(a_v, ATT_KV_HEADS), cv], axis=1)
    y_att = gqa_block_sweep(q.reshape(B, N, ATT_KV_HEADS, ATT_GROUP, HEAD_DIM), k_all, v_all)
    y_hy = hyena_mixer(hy_p, conv_w, conv_b, f_w1, f_b1, f_freq, f_w2, f_b2, f_w3, f_b3, d_skip)
    nk_c = heads(cn_k, NA_HEADS)
    nv_c = heads(cn_v, NA_HEADS)
    y_na = neighbourhood_attention(heads(n_q, NA_HEADS), heads(n_k, NA_HEADS), heads(n_v, NA_HEADS),
                                   nk_c, nv_c, rpb)
    y = jnp.concatenate([y_att, y_hy, y_na], axis=-1) @ w_out
    if not need_ctx:
        return y, None
    cq = rms_norm(heads(ca_q, ATT_Q_HEADS), q_gain) * scale
    yc_att = gqa_attention(cq.reshape(B, M, ATT_KV_HEADS, ATT_GROUP, HEAD_DIM), ck, cv)
    yc_hy = hyena_mixer(chy_p, conv_w, conv_b, f_w1, f_b1, f_freq, f_w2, f_b2, f_w3, f_b3, d_skip)
    yc_na = gqa_attention(heads(cn_q, NA_HEADS)[:, :, :, None] * scale, nk_c, nv_c)
    yc = jnp.concatenate([yc_att, yc_hy, yc_na], axis=-1) @ w_out
    return y, yc


def expert_ffn(t, router_w, router_b, w1, b1, w2, b2):
    logits = (t @ router_w + router_b).astype(jnp.float32)
    top_v, top_i = lax.top_k(logits, TOP_K)
    wts = jax.nn.softmax(top_v, axis=-1)
    gates = jnp.sum(jax.nn.one_hot(top_i, N_EXPERTS, dtype=jnp.float32) * wts[..., None], axis=1)
    gates = gates.astype(t.dtype)
    out = jnp.zeros_like(t)
    for e in range(N_EXPERTS):
        hid = t @ w1[e] + b1[e]
        glu = jnp.minimum(hid[:, :D_EXPERT], SWIGLU_LIMIT)
        lin = jnp.clip(hid[:, D_EXPERT:], -SWIGLU_LIMIT, SWIGLU_LIMIT)
        act = glu * jax.nn.sigmoid(SWIGLU_ALPHA * glu) * (lin + 1.0)
        out = out + gates[:, e:e + 1] * (act @ w2[e] + b2[e])
    return out


def setup_inputs(seed: int = 0) -> dict:
    key = jax.random.key(seed)
    ks = iter(jax.random.split(key, 31))

    def nrm(shape, scale):
        return scale * jax.random.normal(next(ks), shape, jnp.float32)

    L = DEPTH
    return {
        'x': nrm((BATCH, SEQ, D_MODEL), 1.0),
        'c': nrm((BATCH, D_MODEL), 1.0),
        'ctx': nrm((BATCH, CTX_LEN, D_MODEL), 1.0),
        'c_ctx': nrm((D_MODEL,), 1.0),
        'ada_w': nrm((L, D_MODEL, 6 * D_MODEL), 0.5 * D_MODEL ** -0.5),
        'ada_b': nrm((L, 6 * D_MODEL), 0.01),
        'w_in': nrm((L, D_MODEL, D_IN), D_MODEL ** -0.5),
        'w_out': nrm((L, D_MIX, D_MODEL), DEEPNORM_BETA * D_MIX ** -0.5),
        'q_gain': 1.0 + nrm((L, HEAD_DIM), 0.01),
        'k_gain': 1.0 + nrm((L, HEAD_DIM), 0.01),
        'hy_conv_w': nrm((L, HY_SHORT, 3 * HY_W), HY_SHORT ** -0.5),
        'hy_conv_b': nrm((L, 3 * HY_W), 0.01),
        'hy_w1': nrm((L, HY_EMB, HY_FO), HY_EMB ** -0.5),
        'hy_b1': nrm((L, HY_FO), 0.01),
        'hy_freq': 1.0 + nrm((L, 2, HY_FO), 0.01),
        'hy_w2': nrm((L, HY_FO, HY_FO), HY_FO ** -0.5),
        'hy_b2': nrm((L, HY_FO), 0.01),
        'hy_w3': nrm((L, HY_FO, 2 * HY_W), HY_FO ** -0.5),
        'hy_b3': nrm((L, 2 * HY_W), 0.01),
        'hy_d': nrm((L, HY_W), 0.5),
        'na_rpb': nrm((L, NA_HEADS, 2 * NA_WIN_ROWS - 1, 2 * NA_WIN_COLS - 1), 0.05),
        'ln1_g': 1.0 + nrm((L, D_MODEL), 0.01),
        'ln1_b': nrm((L, D_MODEL), 0.01),
        'ln2_g': 1.0 + nrm((L, D_MODEL), 0.01),
        'ln2_b': nrm((L, D_MODEL), 0.01),
        'router_w': nrm((L, D_MODEL, N_EXPERTS), D_MODEL ** -0.5),
        'router_b': nrm((L, N_EXPERTS), 0.01),
        'exp_w1': nrm((L, N_EXPERTS, D_MODEL, 2 * D_EXPERT), D_MODEL ** -0.5),
        'exp_b1': nrm((L, N_EXPERTS, 2 * D_EXPERT), 0.01),
        'exp_w2': nrm((L, N_EXPERTS, D_EXPERT, D_MODEL), DEEPNORM_BETA * D_EXPERT ** -0.5),
        'exp_b2': nrm((L, N_EXPERTS, D_MODEL), 0.01),
    }


def reference(x, c, ctx, c_ctx, ada_w, ada_b, w_in, w_out, q_gain, k_gain, hy_conv_w, hy_conv_b,
              hy_w1, hy_b1, hy_freq, hy_w2, hy_b2, hy_w3, hy_b3, hy_d, na_rpb, ln1_g, ln1_b,
              ln2_g, ln2_b, router_w, router_b, exp_w1, exp_b1, exp_w2, exp_b2):
    B, N, D = x.shape
    M = ctx.shape[1]
    cos, sin = rope_2d_tables(N)
    c_act = jax.nn.silu(c)
    cc_act = jax.nn.silu(c_ctx)
    for l in range(DEPTH):
        need_ctx = l < DEPTH - 1
        mod = jnp.split((c_act @ ada_w[l] + ada_b[l])[:, None, :], 6, axis=-1)
        cmod = jnp.split(cc_act @ ada_w[l] + ada_b[l], 6, axis=-1)
        y, yc = token_mixer(modulate(x, mod[0], mod[1]), modulate(ctx, cmod[0], cmod[1]), need_ctx,
                            w_in[l], w_out[l], q_gain[l], k_gain[l], hy_conv_w[l], hy_conv_b[l],
                            hy_w1[l], hy_b1[l], hy_freq[l], hy_w2[l], hy_b2[l], hy_w3[l], hy_b3[l],
                            hy_d[l], na_rpb[l], cos, sin)
        x = layer_norm(DEEPNORM_ALPHA * x + mod[2] * y, ln1_g[l], ln1_b[l])
        if need_ctx:
            ctx = layer_norm(DEEPNORM_ALPHA * ctx + cmod[2] * yc, ln1_g[l], ln1_b[l])
            h = modulate(x, mod[3], mod[4]).reshape(B * N, D)
            hc = modulate(ctx, cmod[3], cmod[4]).reshape(B * M, D)
            out = expert_ffn(jnp.concatenate([h, hc], axis=0), router_w[l], router_b[l],
                             exp_w1[l], exp_b1[l], exp_w2[l], exp_b2[l])
            y = out[:B * N].reshape(B, N, D)
            ctx = layer_norm(DEEPNORM_ALPHA * ctx + cmod[5] * out[B * N:].reshape(B, M, D),
                             ln2_g[l], ln2_b[l])
        else:
            y = expert_ffn(modulate(x, mod[3], mod[4]).reshape(B * N, D), router_w[l], router_b[l],
                           exp_w1[l], exp_b1[l], exp_w2[l], exp_b2[l]).reshape(B, N, D)
        x = layer_norm(DEEPNORM_ALPHA * x + mod[5] * y, ln2_g[l], ln2_b[l])
    return x
```

```cpp
#include <hip/hip_runtime.h>
#include <cstdio>
#include <cstdint>
namespace pg8 {
#define PG8_LAS __attribute__((address_space(3)))
typedef unsigned short bf16_t;
typedef short bf16x8 __attribute__((ext_vector_type(8)));
typedef float f32x4 __attribute__((ext_vector_type(4)));
typedef unsigned u32x4 __attribute__((ext_vector_type(4)));
constexpr int BM = 256, BK = 64, HALF = 128, HTB = HALF * BK * 2  , STAGE_BYTES = 8 * HTB, NXCD = 8, WGM = 8;

__host__ __device__ __forceinline__ int lds_byte(int r, int c) { const int st = (r >> 4) * 2 + (c >> 5), rr = r & 15, cc = c & 31, ob = rr * 64 + cc * 2; return st * 1024 + (ob ^ (((ob >> 9) & 1) << 5)); }
__host__ __device__ __forceinline__ void stage_rc(int b, int& R, int& C) { const int st = b / 1024, sb = b % 1024, swz = sb ^ (((sb >> 9) & 1) << 5); R = (st >> 1) * 16 + swz / 64; C = (st & 1) * 32 + (swz % 64) / 2; }
__host__ __device__ __forceinline__ int perm32(int rho) { const int n = rho >> 4, i = rho & 15; return 8 * (i >> 2) + 4 * n + (i & 3); }

struct Unit { int pm, pn, pb, pe; };
struct Gemm { const bf16_t* A; const bf16_t* Bt; int M, N, K; };

struct StaticOrder {
    int nM, nN, nwg, G, c;
    __host__ __device__ void init(int M, int N, int G_, int c_) { nM = M / BM; nN = N / BM; nwg = nM * nN; G = G_; c = c_; }
    __host__ __device__ bool next(int i, Unit& u) const {
        const long L = (long)i * G + c; if (L >= nwg) return false;
        int wgid = (int)L; { const int q = nwg / NXCD, r = nwg % NXCD, xcd = wgid % NXCD, off = wgid / NXCD; wgid = (xcd < r ? xcd * (q + 1) : r * (q + 1) + (xcd - r) * q) + off; }
        const int nig = WGM * nN, gid = wgid / nig, fm = gid * WGM, gsz = (nM - fm) < WGM ? (nM - fm) : WGM;
        u.pm = fm + ((wgid % nig) % gsz); u.pn = (wgid % nig) / gsz; u.pb = u.pn; u.pe = 0; return true;
    }
    __device__ __forceinline__ void a_ready(const Unit&) const {}
    __device__ __forceinline__ void done(const Unit&) const {}
};

__device__ __forceinline__ unsigned cvt_pk_bf16(float lo, float hi) { unsigned r; asm volatile("v_cvt_pk_bf16_f32 %0, %1, %2" : "=v"(r) : "v"(lo), "v"(hi)); return r; }
typedef float f32x2 __attribute__((ext_vector_type(2)));
__device__ __forceinline__ f32x2 gelu_pk(f32x2 v) {
    const f32x2 av = __builtin_elementwise_abs(v), d = av * 0.2316418882f + 1.0f;
    f32x2 t; t.x = __builtin_amdgcn_rcpf(d.x); t.y = __builtin_amdgcn_rcpf(d.y);
    f32x2 q = t * 0.5307027145f + (-0.7265760135f); q = q * t + 0.7107068705f; q = q * t + (-0.142248368f); q = q * t + 0.127414796f; q = q * t;
    const f32x2 s = (v * v) * (-0.72134752044f);
    f32x2 e; e.x = __builtin_amdgcn_exp2f(s.x); e.y = __builtin_amdgcn_exp2f(s.y);
    const f32x2 m = v * (q * e), r = v - m;
    f32x2 o; o.x = v.x < 0.f ? m.x : r.x; o.y = v.y < 0.f ? m.y : r.y; return o;
}

template <int ACT  > struct EpiBf16 {
    static constexpr bool PERM = true, AFTER_DRAIN = false; static_assert(ACT == 0 || ACT == 1, "EpiBf16: ACT is 0 (none) or 1 (gelu_pk)");
    bf16_t* O; int ldc; const float* bias; int split_cols; size_t split_stride; float scale0;
    __device__ __forceinline__ void operator()(const f32x4 (&acc)[2][2][4][2], const Unit& u, int wr, int wc, int fr, int fq) const {
        const int row0 = u.pm * BM + wr * 64 + fr; int colt = u.pn * BM; bf16_t* base = O;
        float sc = 1.f; if (split_cols) { const int t = colt / split_cols; base += (size_t)t * split_stride; colt -= t * split_cols; if (t == 0) sc = scale0; }
        const int col0 = colt + wc * 32 + 8 * fq, bcol0 = u.pn * BM + wc * 32 + 8 * fq;
        f32x4 bv[2][2];
#pragma unroll
        for (int bj = 0; bj < 2; ++bj)
#pragma unroll
            for (int n = 0; n < 2; ++n) bv[bj][n] = bias ? *(const f32x4*)(bias + bcol0 + bj * HALF + 4 * n) : (f32x4){0.f, 0.f, 0.f, 0.f};
#pragma unroll
        for (int ai = 0; ai < 2; ++ai)
#pragma unroll
            for (int m = 0; m < 4; ++m) { bf16_t* rowp = base + (size_t)(row0 + ai * HALF + m * 16) * ldc + col0;
#pragma unroll
                for (int bj = 0; bj < 2; ++bj) { f32x4 v0 = acc[ai][bj][m][0] + bv[bj][0], v1 = acc[ai][bj][m][1] + bv[bj][1];
                    if (ACT == 1) { f32x2 a = gelu_pk((f32x2){v0[0], v0[1]}), b = gelu_pk((f32x2){v0[2], v0[3]}), c = gelu_pk((f32x2){v1[0], v1[1]}), d = gelu_pk((f32x2){v1[2], v1[3]});
                        v0 = (f32x4){a.x, a.y, b.x, b.y}; v1 = (f32x4){c.x, c.y, d.x, d.y}; }
                    v0 = v0 * sc; v1 = v1 * sc; u32x4 w; w.x = cvt_pk_bf16(v0[0], v0[1]); w.y = cvt_pk_bf16(v0[2], v0[3]); w.z = cvt_pk_bf16(v1[0], v1[1]); w.w = cvt_pk_bf16(v1[2], v1[3]);
                    *(u32x4*)(rowp + bj * HALF) = w; } }
    }
};

template <class Epi, class Sched, bool ALIGN_EPI = false, bool SP2 = false>
__device__ __forceinline__ void gemm_phase(PG8_LAS unsigned char* lds, const Gemm g, const Sched& S, const Epi& E, const int tid) {
    const int wid = __builtin_amdgcn_readfirstlane(tid >> 6), lane = tid & 63, wr = wid >> 2, wc = wid & 3, fr = lane & 15, fq = lane >> 4;
    const int K = g.K, nt = K / BK;
    unsigned voffA[2], voffB[2];
#pragma unroll
    for (int i = 0; i < 2; ++i) { int R, C; stage_rc(tid * 16 + i * 8192, R, C); const int Rb = Epi::PERM ? ((R & ~31) + perm32(R & 31)) : R;
        voffA[i] = (unsigned)(R * K + C) * 2u; voffB[i] = (unsigned)(Rb * K + C) * 2u; }
    const size_t kstep = (size_t)(BK * 2);
    const size_t hstep = (size_t)HALF * K * 2;
    const size_t tstep = 2 * hstep;
    const unsigned ldsw = (unsigned)wid * 1024u;
    const int aoff = lds_byte(wr * 64 + fr, fq * 8), boff = lds_byte(wc * 32 + fr, fq * 8);
#define PG8_SA(b, h) (((b) * 2 + (h)) * HTB)
#define PG8_SB(b, h) ((4 + (b) * 2 + (h)) * HTB)
#define PG8_STAGE(bufoff, gbase, voff) do { _Pragma("unroll") for (int _i = 0; _i < 2; ++_i) \
        __builtin_amdgcn_global_load_lds((const unsigned*)((const char*)(gbase) + (voff)[_i]), (PG8_LAS unsigned*)(lds + (bufoff) + ldsw + _i * 8192), 16, 0, 0); } while (0)
#define PG8_LDA(dst, b, h) do { _Pragma("unroll") for (int m = 0; m < 4; ++m) _Pragma("unroll") for (int k = 0; k < 2; ++k) dst[m][k] = *(const PG8_LAS bf16x8*)(lds + PG8_SA(b, h) + aoff + m * 2048 + k * 1024); } while (0)
#define PG8_LDB(dst, b, h) do { _Pragma("unroll") for (int n = 0; n < 2; ++n) _Pragma("unroll") for (int k = 0; k < 2; ++k) dst[n][k] = *(const PG8_LAS bf16x8*)(lds + PG8_SB(b, h) + boff + n * 2048 + k * 1024); } while (0)
#define PG8_MMA(ai, bj, At, Bt) do { __builtin_amdgcn_s_setprio(1); _Pragma("unroll") for (int m = 0; m < 4; ++m) _Pragma("unroll") for (int n = 0; n < 2; ++n) _Pragma("unroll") for (int k = 0; k < 2; ++k) \
        acc[ai][bj][m][n] = __builtin_amdgcn_mfma_f32_16x16x32_bf16(Bt[n][k], At[m][k], acc[ai][bj][m][n], 0, 0, 0); __builtin_amdgcn_s_setprio(0); } while (0)
#define PG8_WAIT_V(n) asm volatile("s_waitcnt vmcnt(" #n ")" ::: "memory")
#define PG8_WAIT_L(n) asm volatile("s_waitcnt lgkmcnt(" #n ")" ::: "memory")
#define PG8_BAR __builtin_amdgcn_s_barrier()
#define PG8_SCHED __builtin_amdgcn_sched_barrier(0)
    Unit cur, nxt; int ui = 0;
    if (!S.next(0, cur)) return;
    f32x4 acc[2][2][4][2];
#pragma unroll
    for (int a = 0; a < 2; ++a)
#pragma unroll
        for (int b = 0; b < 2; ++b)
#pragma unroll
            for (int m = 0; m < 4; ++m)
#pragma unroll
                for (int n = 0; n < 2; ++n) acc[a][b][m][n] = (f32x4){0.f, 0.f, 0.f, 0.f};
    bf16x8 At[4][2], B0[2][2], B1[2][2];
    const char* cA = (const char*)g.A + (size_t)cur.pm * tstep; const char* cB = (const char*)g.Bt + (size_t)cur.pb * tstep;
    S.a_ready(cur);
    if constexpr (SP2) {
        PG8_STAGE(PG8_SB(0, 0), cB, voffB); PG8_STAGE(PG8_SB(0, 1), cB + hstep, voffB); PG8_STAGE(PG8_SA(0, 0), cA, voffA); PG8_STAGE(PG8_SA(0, 1), cA + hstep, voffA);
        if (wr == 1) PG8_BAR;
        PG8_WAIT_V(2); PG8_BAR;
        PG8_STAGE(PG8_SB(1, 0), cB + kstep, voffB); PG8_STAGE(PG8_SA(1, 0), cA + kstep, voffA); PG8_STAGE(PG8_SB(1, 1), cB + hstep + kstep, voffB);
        PG8_WAIT_V(6); PG8_BAR;
    } else {
        PG8_STAGE(PG8_SB(0, 0), cB, voffB); PG8_STAGE(PG8_SA(0, 0), cA, voffA); PG8_STAGE(PG8_SB(0, 1), cB + hstep, voffB); PG8_STAGE(PG8_SA(0, 1), cA + hstep, voffA);
        if (wr == 1) PG8_BAR;
        PG8_WAIT_V(4); PG8_BAR;
        PG8_STAGE(PG8_SB(1, 0), cB + kstep, voffB); PG8_STAGE(PG8_SA(1, 0), cA + kstep, voffA); PG8_STAGE(PG8_SB(1, 1), cB + hstep + kstep, voffB);
        PG8_WAIT_V(6); PG8_BAR;
    }
    for (;;) {
        const bool has_next = S.next(ui + 1, nxt);
        const char* nA = has_next ? (const char*)g.A + (size_t)nxt.pm * tstep : cA; const char* nB = has_next ? (const char*)g.Bt + (size_t)nxt.pb * tstep : cB;
        for (int t = 0; t < nt; t += 2) {
            const bool last = (t == nt - 2);
            const char* a1 = cA + (size_t)(t + 1) * kstep;
            const char* a2 = last ? nA : cA + (size_t)(t + 2) * kstep; const char* b2 = last ? nB : cB + (size_t)(t + 2) * kstep;
            const char* a3 = a2 + kstep; const char* b3 = b2 + kstep;
            if (last && has_next) S.a_ready(nxt);
            if constexpr (SP2) {
            PG8_LDB(B0, 0, 0); PG8_LDB(B1, 0, 1); PG8_SCHED; PG8_LDA(At, 0, 0); PG8_STAGE(PG8_SA(1, 1), a1 + hstep, voffA);
            PG8_WAIT_V(8); PG8_WAIT_L(0); PG8_BAR; PG8_MMA(0, 0, At, B0); PG8_MMA(0, 1, At, B1); PG8_BAR; PG8_SCHED;
            PG8_LDA(At, 0, 1); PG8_STAGE(PG8_SB(0, 0), b2, voffB); PG8_STAGE(PG8_SB(0, 1), b2 + hstep, voffB); PG8_STAGE(PG8_SA(0, 0), a2, voffA);
            PG8_WAIT_V(8); PG8_WAIT_L(0); PG8_BAR; PG8_MMA(1, 0, At, B0); PG8_MMA(1, 1, At, B1); PG8_BAR; PG8_SCHED;
            PG8_LDB(B0, 1, 0); PG8_LDB(B1, 1, 1); PG8_SCHED; PG8_LDA(At, 1, 0); PG8_STAGE(PG8_SA(0, 1), a2 + hstep, voffA);
            PG8_WAIT_V(8); PG8_WAIT_L(0); PG8_BAR; PG8_MMA(0, 0, At, B0); PG8_MMA(0, 1, At, B1); PG8_BAR; PG8_SCHED;
            PG8_LDA(At, 1, 1); PG8_STAGE(PG8_SB(1, 0), b3, voffB); PG8_STAGE(PG8_SB(1, 1), b3 + hstep, voffB); PG8_STAGE(PG8_SA(1, 0), a3, voffA);
            PG8_WAIT_V(8); PG8_WAIT_L(0); PG8_BAR; PG8_MMA(1, 0, At, B0); PG8_MMA(1, 1, At, B1); PG8_BAR; PG8_SCHED;
            } else {
            PG8_LDB(B0, 0, 0); PG8_SCHED; PG8_LDA(At, 0, 0); PG8_STAGE(PG8_SA(1, 1), a1 + hstep, voffA);
            PG8_WAIT_L(8); PG8_BAR; PG8_WAIT_L(0); PG8_MMA(0, 0, At, B0); PG8_BAR; PG8_SCHED;
            PG8_LDB(B1, 0, 1); PG8_STAGE(PG8_SB(0, 0), b2, voffB);
            PG8_BAR; PG8_WAIT_L(0); PG8_MMA(0, 1, At, B1); PG8_BAR;
            PG8_LDA(At, 0, 1); PG8_STAGE(PG8_SA(0, 0), a2, voffA);
            PG8_BAR; PG8_WAIT_L(0); PG8_MMA(1, 0, At, B0); PG8_BAR; PG8_SCHED;
            PG8_STAGE(PG8_SB(0, 1), b2 + hstep, voffB);
            PG8_WAIT_V(6); PG8_BAR; PG8_MMA(1, 1, At, B1); PG8_BAR;
            PG8_LDB(B0, 1, 0); PG8_SCHED; PG8_LDA(At, 1, 0); PG8_STAGE(PG8_SA(0, 1), a2 + hstep, voffA);
            PG8_WAIT_L(8); PG8_BAR; PG8_WAIT_L(0); PG8_MMA(0, 0, At, B0); PG8_BAR; PG8_SCHED;
            PG8_LDB(B1, 1, 1); PG8_STAGE(PG8_SB(1, 0), b3, voffB);
            PG8_BAR; PG8_WAIT_L(0); PG8_MMA(0, 1, At, B1); PG8_BAR;
            PG8_LDA(At, 1, 1); PG8_STAGE(PG8_SA(1, 0), a3, voffA);
            PG8_BAR; PG8_WAIT_L(0); PG8_MMA(1, 0, At, B0); PG8_BAR; PG8_SCHED;
            PG8_STAGE(PG8_SB(1, 1), b3 + hstep, voffB);
            PG8_WAIT_V(6); PG8_BAR; PG8_MMA(1, 1, At, B1); PG8_BAR;
            }
        }
        if constexpr (ALIGN_EPI) { if (wr == 0) PG8_BAR; }
        if constexpr (!Epi::AFTER_DRAIN) { E(acc, cur, wr, wc, fr, fq); S.done(cur); }
        if (!has_next) break;
#pragma unroll
        for (int a = 0; a < 2; ++a)
#pragma unroll
            for (int b = 0; b < 2; ++b)
#pragma unroll
                for (int m = 0; m < 4; ++m)
#pragma unroll
                    for (int n = 0; n < 2; ++n) acc[a][b][m][n] = (f32x4){0.f, 0.f, 0.f, 0.f};
        cur = nxt; cA = nA; cB = nB; ++ui;
        if constexpr (ALIGN_EPI) { if (wr == 1) PG8_BAR; }
    }
    PG8_WAIT_V(0);
    if constexpr (!ALIGN_EPI) { if (wr == 0) PG8_BAR; }
    PG8_BAR;
    if constexpr (Epi::AFTER_DRAIN) { E.fused(acc, cur, wr, wc, fr, fq, lds, wid, lane); S.done(cur); }
#undef PG8_SA
#undef PG8_SB
#undef PG8_STAGE
#undef PG8_LDA
#undef PG8_LDB
#undef PG8_MMA
#undef PG8_WAIT_V
#undef PG8_WAIT_L
#undef PG8_BAR
#undef PG8_SCHED
}
}
#include <hip/hip_bf16.h>
#include <cmath>
namespace attn_body {
using bf16=__hip_bfloat16;
using bf16x8=__attribute__((ext_vector_type(8)))short;
using s16x4=__attribute__((ext_vector_type(4)))short;
using f32x16=__attribute__((ext_vector_type(16)))float;
using u32x4=__attribute__((ext_vector_type(4)))unsigned;
constexpr int D=64;
constexpr int NW=8,QBLK=32,QB=QBLK*NW,KVBLK=64;
constexpr int ATTN_UNIT_ROWS=QB;
__device__ __forceinline__ int crow(int r,int hi){return (r&3)+8*(r>>2)+4*hi;}
#define SBAR() __builtin_amdgcn_sched_barrier(0)
__device__ __forceinline__ void cmask(f32x16&p0,f32x16&p1,int jb,int qrel,int hi){
  const float NEG=-INFINITY; int kb=64*jb+4*hi;
  #pragma unroll
  for(int r=0;r<16;++r){int kv=kb+(r&3)+8*(r>>2); if(kv>qrel)p0[r]=NEG; if(kv+32>qrel)p1[r]=NEG;}
}

constexpr int NSLOT=3, SLOTB=8192;
constexpr int LDS_K=0, LDS_V=NSLOT*SLOTB, LDS_WS=2*NSLOT*SLOTB, LDS_OST=LDS_WS+NW*64*4, LDS_BYTES=LDS_OST+NW*4096;
constexpr float C2=0.125f*1.4426950408889634f;
__device__ __forceinline__ void glds16(const void*gsrc,unsigned lds_dst){unsigned keep;
  asm volatile("s_mov_b32 %0, m0\n\ts_mov_b32 m0, %2\n\ts_nop 0\n\tglobal_load_lds_dwordx4 %1, off\n\ts_mov_b32 m0, %0":"=&s"(keep):"v"(gsrc),"s"(lds_dst):"memory");}
__device__ __forceinline__ float max3f(float a,float b,float c){float r;asm("v_max3_f32 %0, %1, %2, %3":"=v"(r):"v"(a),"v"(b),"v"(c));return r;}
__device__ __forceinline__ float max2f(float a,float b){float r;asm("v_max_f32_e32 %0, %1, %2":"=v"(r):"v"(a),"v"(b));return r;}
__device__ __forceinline__ float fadd_s(float a,float b){float r;asm("v_add_f32_e32 %0, %1, %2":"=v"(r):"v"(a),"v"(b));return r;}
__device__ __forceinline__ float fsub_s(float a,float b){float r;asm("v_sub_f32_e32 %0, %1, %2":"=v"(r):"v"(a),"v"(b));return r;}
typedef float f32x2_t __attribute__((ext_vector_type(2))); typedef __bf16 bf16x2_t __attribute__((ext_vector_type(2)));
__device__ __forceinline__ unsigned cvtpk_s(float lo,float hi){f32x2_t v={lo,hi};bf16x2_t b=__builtin_convertvector(v,bf16x2_t);return __builtin_bit_cast(unsigned,b);}
#define WAIT_BAR(N) asm volatile("s_waitcnt vmcnt(" #N ") lgkmcnt(0)\n\ts_barrier":::"memory")

__device__ __forceinline__ void qkt(f32x16&p0,f32x16&p1,const char*Kslot,const bf16x8*qr,const f32x16&negm,int r32,int hi){
  const char*kb=Kslot+hi*1024+r32*16;
  #pragma unroll
  for(int d0=0;d0<4;++d0){
    const bf16x8 b0=*reinterpret_cast<const bf16x8*>(kb+d0*2048);
    const bf16x8 b1=*reinterpret_cast<const bf16x8*>(kb+d0*2048+512);
    if(d0==0){p0=__builtin_amdgcn_mfma_f32_32x32x16_bf16(b0,qr[0],negm,0,0,0);p1=__builtin_amdgcn_mfma_f32_32x32x16_bf16(b1,qr[0],negm,0,0,0);}
    else{p0=__builtin_amdgcn_mfma_f32_32x32x16_bf16(b0,qr[d0],p0,0,0,0);p1=__builtin_amdgcn_mfma_f32_32x32x16_bf16(b1,qr[d0],p1,0,0,0);}}
}
typedef __attribute__((address_space(3))) const char* lds_cptr;
typedef short v4i16_t __attribute__((ext_vector_type(4)));
__device__ __forceinline__ void kload8(bf16x8*kf,lds_cptr kp){
  kf[0]=*(const __attribute__((address_space(3))) bf16x8*)(kp);      kf[1]=*(const __attribute__((address_space(3))) bf16x8*)(kp+512);
  kf[2]=*(const __attribute__((address_space(3))) bf16x8*)(kp+2048); kf[3]=*(const __attribute__((address_space(3))) bf16x8*)(kp+2560);
  kf[4]=*(const __attribute__((address_space(3))) bf16x8*)(kp+4096); kf[5]=*(const __attribute__((address_space(3))) bf16x8*)(kp+4608);
  kf[6]=*(const __attribute__((address_space(3))) bf16x8*)(kp+6144); kf[7]=*(const __attribute__((address_space(3))) bf16x8*)(kp+6656);
}
__device__ __forceinline__ void kload2(bf16x8*kf,lds_cptr kp,int j){ kf[2*j]=*(const __attribute__((address_space(3))) bf16x8*)(kp+j*2048); kf[2*j+1]=*(const __attribute__((address_space(3))) bf16x8*)(kp+j*2048+512); }
__device__ __forceinline__ s16x4 vtr(lds_cptr p){ return __builtin_bit_cast(s16x4,__builtin_amdgcn_ds_read_tr16_b64_v4i16((__attribute__((address_space(3))) v4i16_t*)p)); }
__device__ __forceinline__ float rowmax(const f32x16&p0,const f32x16&p1){
  float a=max3f(p0[0],p0[1],p1[0]),b=max3f(p0[2],p0[3],p1[1]);a=max3f(a,p1[2],p1[3]);
  #pragma unroll
  for(int r=4;r<16;r+=4){a=max3f(a,p0[r],p0[r+1]);b=max3f(b,p0[r+2],p0[r+3]);a=max3f(a,p1[r],p1[r+1]);b=max3f(b,p1[r+2],p1[r+3]);}
  const float m=max2f(a,b);
  auto rr=__builtin_amdgcn_permlane32_swap(__float_as_uint(m),__float_as_uint(m),false,false);
  return max2f(__uint_as_float(rr[0]),__uint_as_float(rr[1]));
}
__device__ __forceinline__ void pv(f32x16*o,int vb,bf16x8 pa0,bf16x8 pa1,bf16x8 pa2,bf16x8 pa3){
  #pragma unroll
  for(int d0=0;d0<2;++d0){s16x4 lo[4],hi[4];
    #pragma unroll
    for(int ks=0;ks<4;++ks){
      asm volatile("ds_read_b64_tr_b16 %0,%1 offset:%c2":"=&v"(lo[ks]):"v"(vb),"i"(d0*4096+ks*1024):"memory");
      asm volatile("ds_read_b64_tr_b16 %0,%1 offset:%c2":"=&v"(hi[ks]):"v"(vb),"i"(d0*4096+ks*1024+512):"memory");}
    asm volatile("s_waitcnt lgkmcnt(0)":::"memory");SBAR();
    #define PK(k) (bf16x8){lo[k][0],lo[k][1],lo[k][2],lo[k][3],hi[k][0],hi[k][1],hi[k][2],hi[k][3]}
    o[d0]=__builtin_amdgcn_mfma_f32_32x32x16_bf16(pa0,PK(0),o[d0],0,0,0);
    o[d0]=__builtin_amdgcn_mfma_f32_32x32x16_bf16(pa1,PK(1),o[d0],0,0,0);
    o[d0]=__builtin_amdgcn_mfma_f32_32x32x16_bf16(pa2,PK(2),o[d0],0,0,0);
    o[d0]=__builtin_amdgcn_mfma_f32_32x32x16_bf16(pa3,PK(3),o[d0],0,0,0);
    #undef PK
  }
}

#ifndef ATTN_STORE16
#define ATTN_STORE16(p,v) (*(u32x4*)(p)=(v))
#endif
template<int THRL> __device__ __forceinline__ void attn_unit(const bf16*Qu,const bf16*__restrict__ Kh,const bf16*__restrict__ Vh,bf16*Ou,const int QP,const int KP,const int OP,const int NT,char*shm,const int tid){
  const int lane=tid&63,r32=lane&31,hi=lane>>5; const int wid=__builtin_amdgcn_readfirstlane(tid>>6);
  const bf16*Qw=Qu+(long)(wid*QBLK)*QP;
  const unsigned lds0=(unsigned)(uintptr_t)shm;
  float*wsf=(float*)(shm+LDS_WS)+wid*64;
  const bf16*ksrc=Kh+(long)lane*KP+wid*8;
  const bf16*vsrc=Vh+(long)(16*(wid&3)+(lane>>2))*KP+(wid>>2)*32+(lane&3)*8;
  const unsigned kdst=lds0+LDS_K+wid*1024, vdst=lds0+LDS_V+wid*1024;
  #define DMA_K(t,slot) glds16(ksrc+(long)(t)*KVBLK*KP,(unsigned)__builtin_amdgcn_readfirstlane(kdst+(slot)))
  #define DMA_V(t,slot) glds16(vsrc+(long)(t)*KVBLK*KP,(unsigned)__builtin_amdgcn_readfirstlane(vdst+(slot)))
  const int vb0=(int)(lds0+LDS_V)+((lane>>4)&1)*32+(lane&3)*8+(4*hi+((lane&15)>>2))*64;
  const char*Kbase=shm+LDS_K; bf16x8 kf[8];
  const lds_cptr shm3=(lds_cptr)shm; const lds_cptr kp0=shm3+LDS_K+hi*1024+r32*16; const lds_cptr vp0=shm3+LDS_V+((lane>>4)&1)*32+(lane&3)*8+(4*hi+((lane&15)>>2))*64;
  DMA_K(0,0);DMA_V(0,0);DMA_K(1,SLOTB);
  bf16x8 qr[4];
  #pragma unroll
  for(int d0=0;d0<4;++d0)qr[d0]=*reinterpret_cast<const bf16x8*>(&Qw[(long)r32*QP+d0*16+hi*8]);
  float mhat=0.f,l_reg=0.f;f32x16 o[2];o[0]=f32x16{};o[1]=f32x16{};f32x16 negm=f32x16{};asm volatile("":"+v"(negm));
  #define CMASK(P0,P1,t) do{}while(0)
  bool resc=false;
  #define START(P0,P1) do{ const float rm=rowmax(P0,P1); resc=false; \
    { const float dl=rm; mhat=fadd_s(mhat,dl); \
      _Pragma("unroll") for(int r=0;r<16;++r){P0[r]=fsub_s(P0[r],dl);P1[r]=fsub_s(P1[r],dl);} \
      _Pragma("unroll") for(int r=0;r<16;++r)negm[r]=-mhat; asm volatile("":"+v"(negm)); } \
    _Pragma("unroll") for(int r=0;r<16;++r)P0[r]=__builtin_amdgcn_exp2f(P0[r]); }while(0)
  #define RESC() do{ if(resc){ asm volatile("s_waitcnt lgkmcnt(0)":::"memory"); \
      _Pragma("unroll") for(int d_=0;d_<2;++d_) _Pragma("unroll") for(int r=0;r<16;++r)o[d_][r]*=wsf[crow(r,hi)]; } }while(0)
  f32x16 pA0,pA1,pB0,pB1;
  int sl_prev=0,sl_cur=0,sl_next=SLOTB;
  #define ROT() do{sl_prev=sl_cur;sl_cur=sl_next;sl_next=(sl_next==(NSLOT-1)*SLOTB)?0:sl_next+SLOTB;}while(0)
  DMA_K(2,2*SLOTB);
  WAIT_BAR(3);
  qkt(pA0,pA1,Kbase,qr,negm,r32,hi);asm volatile("s_nop 15\n\ts_nop 7":"+v"(pA0),"+v"(pA1));CMASK(pA0,pA1,0);
  START(pA0,pA1);
  _Pragma("unroll") for(int r=0;r<16;++r)pA1[r]=__builtin_amdgcn_exp2f(pA1[r]);
  WAIT_BAR(0);
  DMA_K(3,0);DMA_V(1,SLOTB);
  ROT();
  kload8(kf,kp0+sl_cur);
  WAIT_BAR(2);
  s16x4 vlo[8],vhi[8]; u32x4 pw0,pw1,pw2,pw3;
  #define PKW(P,B) cvtpk_s(P[B],P[B+1])
  #define PAF(k) __builtin_bit_cast(bf16x8,pw##k)
  #define VFR(i) (bf16x8){vlo[i][0],vlo[i][1],vlo[i][2],vlo[i][3],vhi[i][0],vhi[i][1],vhi[i][2],vhi[i][3]}
  #define PIN(x) asm volatile("":"+v"(x))
  #define MX3(a,b,c) __builtin_fmaxf(__builtin_fmaxf((a),(b)),(c))
  #define GAPA(MF,A0,A1,A2,A3,W0,W1,PW) do{ MF; sacc+=A0; sacc+=A1; sacc+=A2; sacc+=A3; PIN(sacc); W0; W1; PIN(PW); SBAR(); }while(0)
  #define EX(v) __builtin_amdgcn_exp2f(v)
  #define GAPB(MF,X,B) do{ MF; X[B]=EX(X[B]); X[B+1]=EX(X[B+1]); X[B+2]=EX(X[B+2]); X[B+3]=EX(X[B+3]); PIN(X); SBAR(); }while(0)
  #define VRD(i) do{ vlo[i]=vtr(vp_+(((i)>>2)*4096+((i)&3)*1024)); vhi[i]=vtr(vp_+(((i)>>2)*4096+((i)&3)*1024+512)); }while(0)
  #define KRD(G,j) do{ if(G){ kload2(kf,kp0+sl_next,j); SBAR(); } }while(0)
  #define STEP(C0,C1,P0,P1,t,GK,GV,GL) do{ SBAR(); \
    const lds_cptr vp_=vp0+sl_prev; \
    VRD(0); SBAR(); float sacc=(P0[0]+P0[1]); \
    GAPA(C0=__builtin_amdgcn_mfma_f32_32x32x16_bf16(kf[0],qr[0],negm,0,0,0), P0[2],P0[3],P0[4],P0[5],     pw0[0]=PKW(P0,0), pw0[1]=PKW(P0,2), pw0); \
    VRD(4); SBAR(); GAPA(C1=__builtin_amdgcn_mfma_f32_32x32x16_bf16(kf[1],qr[0],negm,0,0,0), P0[6],P0[7],P0[8],P0[9],     pw0[2]=PKW(P0,4), pw0[3]=PKW(P0,6), pw0); \
    VRD(1); SBAR(); GAPA(C0=__builtin_amdgcn_mfma_f32_32x32x16_bf16(kf[2],qr[1],C0,0,0,0),   P0[10],P0[11],P0[12],P0[13], pw1[0]=PKW(P0,8), pw1[1]=PKW(P0,10), pw1); \
    VRD(5); SBAR(); GAPA(C1=__builtin_amdgcn_mfma_f32_32x32x16_bf16(kf[3],qr[1],C1,0,0,0),   P0[14],P0[15],P1[0],P1[1],   pw1[2]=PKW(P0,12),pw1[3]=PKW(P0,14), pw1); \
    VRD(2); SBAR(); GAPA(C0=__builtin_amdgcn_mfma_f32_32x32x16_bf16(kf[4],qr[2],C0,0,0,0),   P1[2],P1[3],P1[4],P1[5],     pw2[0]=PKW(P1,0), pw2[1]=PKW(P1,2), pw2); \
    VRD(6); SBAR(); GAPA(C1=__builtin_amdgcn_mfma_f32_32x32x16_bf16(kf[5],qr[2],C1,0,0,0),   P1[6],P1[7],P1[8],P1[9],     pw2[2]=PKW(P1,4), pw2[3]=PKW(P1,6), pw2); \
    VRD(3); SBAR(); GAPA(C0=__builtin_amdgcn_mfma_f32_32x32x16_bf16(kf[6],qr[3],C0,0,0,0),   P1[10],P1[11],P1[12],P1[13], pw3[0]=PKW(P1,8), pw3[1]=PKW(P1,10), pw3); \
    VRD(7); SBAR(); GAPA(C1=__builtin_amdgcn_mfma_f32_32x32x16_bf16(kf[7],qr[3],C1,0,0,0),   P1[14],P1[15],0.f,0.f,       pw3[2]=PKW(P1,12),pw3[3]=PKW(P1,14), pw3); \
    l_reg+=sacc; \
    if(GK){DMA_K((t)+3,sl_cur);} if(GV){DMA_V((t)+1,sl_next);} \
    CMASK(C0,C1,t); \
    { float a=MX3(C0[0],C0[1],C1[0]),b=MX3(C0[2],C0[3],C1[1]); a=MX3(a,C1[2],C1[3]); \
      _Pragma("unroll") for(int r=4;r<16;r+=4){a=MX3(a,C0[r],C0[r+1]);b=MX3(b,C0[r+2],C0[r+3]);a=MX3(a,C1[r],C1[r+1]);b=MX3(b,C1[r+2],C1[r+3]);} \
      float rm=__builtin_fmaxf(a,b); { auto rr=__builtin_amdgcn_permlane32_swap(__float_as_uint(rm),__float_as_uint(rm),false,false); rm=__builtin_fmaxf(__uint_as_float(rr[0]),__uint_as_float(rr[1])); } \
      resc=false; \
      if(__builtin_expect(__any(rm>(float)THRL),0)){ const float dl=__builtin_fmaxf(rm,0.f); mhat+=dl; \
        _Pragma("unroll") for(int r=0;r<16;++r){C0[r]-=dl;C1[r]-=dl;} \
        _Pragma("unroll") for(int r=0;r<16;++r)negm[r]=-mhat; asm volatile("":"+v"(negm)); \
        const float f=__builtin_amdgcn_exp2f(-dl); l_reg*=f; if(hi==0)wsf[r32]=f; resc=true; } } \
    SBAR(); \
    GAPB(o[0]=__builtin_amdgcn_mfma_f32_32x32x16_bf16(PAF(0),VFR(0),o[0],0,0,0), C0,0); \
    GAPB(o[1]=__builtin_amdgcn_mfma_f32_32x32x16_bf16(PAF(0),VFR(4),o[1],0,0,0), C0,4); \
    KRD(GL,0); GAPB(o[0]=__builtin_amdgcn_mfma_f32_32x32x16_bf16(PAF(1),VFR(1),o[0],0,0,0), C0,8); \
    KRD(GL,1); GAPB(o[1]=__builtin_amdgcn_mfma_f32_32x32x16_bf16(PAF(1),VFR(5),o[1],0,0,0), C0,12); \
    KRD(GL,2); GAPB(o[0]=__builtin_amdgcn_mfma_f32_32x32x16_bf16(PAF(2),VFR(2),o[0],0,0,0), C1,0); \
    KRD(GL,3); GAPB(o[1]=__builtin_amdgcn_mfma_f32_32x32x16_bf16(PAF(2),VFR(6),o[1],0,0,0), C1,4); \
    GAPB(o[0]=__builtin_amdgcn_mfma_f32_32x32x16_bf16(PAF(3),VFR(3),o[0],0,0,0), C1,8); \
    GAPB(o[1]=__builtin_amdgcn_mfma_f32_32x32x16_bf16(PAF(3),VFR(7),o[1],0,0,0), C1,12); \
    }while(0)
  int t=1;
  #undef CMASK
  #define CMASK(P0,P1,t) do{}while(0)
  for(;t+5<NT;t+=2){
    STEP(pB0,pB1,pA0,pA1,t,true,true,true);     WAIT_BAR(2); RESC(); ROT();
    STEP(pA0,pA1,pB0,pB1,t+1,true,true,true);   WAIT_BAR(2); RESC(); ROT();
  }
  #undef CMASK
  #define CMASK(P0,P1,t) do{}while(0)
  #define ENDW(tt) do{ if((tt)+3<NT){WAIT_BAR(2);} else if((tt)+2<NT){WAIT_BAR(1);} else {WAIT_BAR(0);} }while(0)
  for(;t+1<NT;t+=2){
    STEP(pB0,pB1,pA0,pA1,t,(t+3<NT),(t+1<NT),(t+1<NT));       ENDW(t);   RESC(); ROT();
    STEP(pA0,pA1,pB0,pB1,t+1,(t+4<NT),(t+2<NT),(t+2<NT));     ENDW(t+1); RESC(); ROT();
  }
  STEP(pB0,pB1,pA0,pA1,NT-1,false,false,false); RESC();
  { float sacc=pB0[0]+pB0[1]; _Pragma("unroll") for(int r=2;r<16;++r)sacc+=pB0[r]; _Pragma("unroll") for(int r=0;r<16;++r)sacc+=pB1[r]; l_reg+=sacc;
    pw0=(u32x4){PKW(pB0,0),PKW(pB0,2),PKW(pB0,4),PKW(pB0,6)};pw1=(u32x4){PKW(pB0,8),PKW(pB0,10),PKW(pB0,12),PKW(pB0,14)};pw2=(u32x4){PKW(pB1,0),PKW(pB1,2),PKW(pB1,4),PKW(pB1,6)};pw3=(u32x4){PKW(pB1,8),PKW(pB1,10),PKW(pB1,12),PKW(pB1,14)};
    SBAR(); pv(o,vb0+sl_cur,PAF(0),PAF(1),PAF(2),PAF(3)); }
  #undef PKW
  #undef PAF
  #undef VFR
  #undef PIN
  #undef MX3
  #undef GAPA
  #undef GAPB
  #undef EX
  #undef VRD
  #undef KRD
  #undef STEP
  #undef ENDW
  {auto rr=__builtin_amdgcn_permlane32_swap(__float_as_uint(l_reg),__float_as_uint(l_reg),false,false);l_reg=__uint_as_float(rr[0])+__uint_as_float(rr[1]);}
  if(hi==0)wsf[32+r32]=l_reg;asm volatile("s_waitcnt lgkmcnt(0)":::"memory");
  float rli[16];
  #pragma unroll
  for(int r=0;r<16;++r)rli[r]=__builtin_amdgcn_rcpf(wsf[32+crow(r,hi)]);
  bf16*Ow=Ou+(long)(wid*QBLK)*OP;
  { bf16*stg=(bf16*)(shm+LDS_OST)+wid*2048;
    #pragma unroll
    for(int r=0;r<16;++r){const int orow=crow(r,hi);
      #pragma unroll
      for(int d0=0;d0<2;++d0)stg[orow*64+d0*32+r32]=__float2bfloat16(o[d0][r]*rli[r]);}
    asm volatile("s_waitcnt lgkmcnt(0)":::"memory");
    #pragma unroll
    for(int i=0;i<4;++i){const int row=i*8+(lane>>3),ch=lane&7; const u32x4 v=*(const u32x4*)(stg+row*64+ch*8); ATTN_STORE16(Ow+(long)row*OP+ch*8,v);} }
  asm volatile("s_waitcnt lgkmcnt(0)\n\ts_barrier":::"memory");
  #undef DMA_K
  #undef DMA_V
  #undef CMASK
  #undef START
  #undef RESC
  #undef ROT
}
constexpr int ATTN_LDS_BYTES=LDS_BYTES;
#undef SBAR
#undef WAIT_BAR
}
#define GAS __attribute__((address_space(1)))
#define LAS __attribute__((address_space(3)))
typedef unsigned short bf16;
typedef unsigned v4u __attribute__((ext_vector_type(4)));
typedef float f32x4 __attribute__((ext_vector_type(4)));
typedef short bf16x8 __attribute__((ext_vector_type(8)));
typedef GAS unsigned gu32;
typedef GAS unsigned long long gu64;
#define RLX_AGENT __ATOMIC_RELAXED, __HIP_MEMORY_SCOPE_AGENT
#define LDS_WAIT() asm volatile("s_waitcnt lgkmcnt(0)" ::: "memory")
#define VM_WAIT() asm volatile("s_waitcnt vmcnt(0)" ::: "memory")
__device__ __forceinline__ unsigned long long rt() { return __builtin_amdgcn_s_memrealtime(); }
__device__ __forceinline__ unsigned f2bf(float f) { unsigned u = __builtin_bit_cast(unsigned, f); return (u + 0x7fffu + ((u >> 16) & 1u)) >> 16; }
__device__ __forceinline__ unsigned pk2(float lo, float hi) { return f2bf(lo) | (f2bf(hi) << 16); }

#define XB_TMO      128
#define XB_XCNT(j)  (256  + 64 * (j))
#define XB_XSUB(j)  (1280 + 64 * (j))
#define XB_XGEN(j)  (2304 + 64 * (j))
#define XB_TOP      3328
#define XB_TOPGEN   3392
#define XCD_BAR_WORDS 3456
#define XB_SPIN_CAP (1u << 18)

__device__ __forceinline__ unsigned xb_ld(unsigned* p)              { return __hip_atomic_load(p, __ATOMIC_RELAXED, __HIP_MEMORY_SCOPE_AGENT); }
__device__ __forceinline__ unsigned xb_add(unsigned* p, unsigned v) { return __hip_atomic_fetch_add(p, v, __ATOMIC_RELAXED, __HIP_MEMORY_SCOPE_AGENT); }
__device__ __forceinline__ unsigned xb_xcc_id() { return (unsigned)__builtin_amdgcn_s_getreg((3 << 11) | 20) & 0xFu; }
#define XB_SPIN(cond, bar) do { unsigned _sp = 0; while (cond) { __builtin_amdgcn_s_sleep(1); \
    if ((++_sp & 255u) == 0u) { if (xb_ld(&(bar)[XB_TMO])) break; if (_sp > XB_SPIN_CAP) { atomicAdd(&(bar)[XB_TMO], 1u); break; } } } } while (0)

struct XcdBarrier {
    unsigned* bar; unsigned x;
    volatile LAS unsigned* st;
};

__device__ __forceinline__ XcdBarrier xcd_barrier_post(unsigned* bar, volatile LAS unsigned* st) {
    XcdBarrier b; b.bar = bar; b.x = xb_xcc_id(); b.st = st;
    if (threadIdx.x == 0) (void)xb_add(&bar[XB_XCNT(b.x)], 1u);
    return b;
}
__device__ __forceinline__ void xcd_barrier_complete(unsigned* bar, unsigned x, unsigned& nloc, unsigned& nx) {
    const unsigned G = gridDim.x * gridDim.y * gridDim.z;
    unsigned sum, cnt, mine, sp = 0u;
    for (;;) {
        sum = 0u; cnt = 0u; mine = 0u;
#pragma unroll
        for (unsigned j = 0; j < 16; ++j) { const unsigned c = xb_ld(&bar[XB_XCNT(j)]); sum += c; cnt += (c > 0u) ? 1u : 0u; mine = (j == x) ? c : mine; }
        if (sum == G) break;
        __builtin_amdgcn_s_sleep(1);
        if ((++sp & 255u) == 0u) { if (xb_ld(&bar[XB_TMO])) break; if (sp > XB_SPIN_CAP) { atomicAdd(&bar[XB_TMO], 1u); break; } }
    }
    nloc = mine > 0u ? mine : 1u; nx = cnt > 0u ? cnt : 1u;
}

__device__ __forceinline__ void xcd_barrier(const XcdBarrier& b) {
    asm volatile("s_waitcnt vmcnt(0)" ::: "memory");
    __syncthreads();
    if (threadIdx.x == 0) {
        unsigned* bar = b.bar;
        __builtin_amdgcn_s_waitcnt(0);
        unsigned nloc = b.st[0], nx = b.st[1];
        if (nloc == 0u) { xcd_barrier_complete(bar, b.x, nloc, nx); b.st[0] = nloc; b.st[1] = nx; }
        const unsigned old = xb_add(&bar[XB_XSUB(b.x)], 1u);
        const unsigned gen = old / nloc;
        if (old + 1u == (gen + 1u) * nloc) {
            __builtin_amdgcn_fence(__ATOMIC_RELEASE, "agent");
            asm volatile("s_waitcnt vmcnt(0)" ::: "memory");
            const unsigned og = xb_add(&bar[XB_TOP], 1u);
            const unsigned tg = og / nx;
            if (og + 1u == (tg + 1u) * nx) xb_add(&bar[XB_TOPGEN], 1u);
            else XB_SPIN(xb_ld(&bar[XB_TOPGEN]) == tg, bar);
            __builtin_amdgcn_fence(__ATOMIC_ACQUIRE, "agent");
            xb_add(&bar[XB_XGEN(b.x)], 1u);
            asm volatile("s_waitcnt vmcnt(0)" ::: "memory");
        } else {
            XB_SPIN(xb_ld(&bar[XB_XGEN(b.x)]) == gen, bar);
            __builtin_amdgcn_fence(__ATOMIC_ACQUIRE, "agent");
            asm volatile("s_waitcnt vmcnt(0)" ::: "memory");
        }
    }
    __syncthreads();
}
constexpr int NWAVES = 8;
constexpr int DM = 1024, NB = 4, SEQ = 4096, CTXL = 256, NLAT = NB * SEQ, NCTX = NB * CTXL, NTOK = NLAT + NCTX;
constexpr int DIN = 2304, NEXP = 32, DEPTH = 2, KVLEN = SEQ + CTXL;
constexpr int CQ = 0, CK = 512, CV = 640, CHY = 768, CNQ = 1536, CNK = 1792, CNV = 2048;
constexpr int MAXSORT = 77824;
constexpr float LN_EPS = 1e-6f, DN_ALPHA = 1.41421356237f;
constexpr float C2 = 0.125f * 1.4426950408889634f;
constexpr int NPHASE = 2 + 9 * DEPTH;

constexpr size_t MiB = 1u << 20;
constexpr size_t WS_CTL = 0, CTL_ZERO_BYTES = 1 * MiB;
constexpr size_t WS_WIN = 2 * MiB, WS_WOUT = 12 * MiB, WS_W1 = 16 * MiB, WS_W2 = 272 * MiB, WS_MOD = 400 * MiB;
constexpr size_t WS_FILT = 402 * MiB, WS_FILTC = 418 * MiB, WS_X = 420 * MiB, WS_H = 488 * MiB, WS_P = 522 * MiB, WS_Q = 600 * MiB;
constexpr size_t WS_K = 618 * MiB, WS_V = 623 * MiB, WS_X0 = 628 * MiB, WS_ZT = 638 * MiB, WS_ZTC = 654 * MiB, WS_NQC = 655 * MiB, WS_YMIX = 656 * MiB;
constexpr size_t WS_Y = 690 * MiB, WS_ROUTE = 724 * MiB, WS_AS = 728 * MiB, WS_ACT = 880 * MiB, WS_Y4 = 1032 * MiB, WS_END = 1168 * MiB;
constexpr size_t RT_TOPI = 0, RT_GATE = 69632, RT_SLOTPOS = 139264, RT_CNT = 208896, RT_TT = 217088, RT_ROWSLOT = 218112;
static_assert((RT_ROWSLOT + MAXSORT) * 4 <= 4 * MiB, "route region");
constexpr int CW_BAR = 4096;

constexpr int RING_OFF = 0, RING_BYTES = 147456;
constexpr int LDSCTL_OFF = RING_BYTES, LDSCTL_BYTES = 1024;
constexpr int LDS_BYTES = RING_BYTES + LDSCTL_BYTES;

__device__ __forceinline__ float bf2f(unsigned short h) { return __uint_as_float(((unsigned)h) << 16); }
__device__ __forceinline__ float bflo(unsigned w) { return __uint_as_float(w << 16); }
__device__ __forceinline__ float bfhi(unsigned w) { return __uint_as_float(w & 0xffff0000u); }
__device__ __forceinline__ float wave_sum(float v) {
#pragma unroll
    for (int o = 1; o < 64; o <<= 1) v += __shfl_xor(v, o);
    return v;
}
__device__ __forceinline__ float wave_max(float v) {
#pragma unroll
    for (int o = 1; o < 64; o <<= 1) v = fmaxf(v, __shfl_xor(v, o));
    return v;
}

struct Frame {
    LAS unsigned char* lds;
    volatile LAS unsigned* MISC;
    gu32* ctl;
    int tid, lane, wave;
    int vcu, G;
    float* out;
    unsigned char* ws;
};
typedef __attribute__((address_space(4))) const char* kargp_t;
__device__ __forceinline__ const float* inp(int i) {
#if defined(__HIP_DEVICE_COMPILE__)
    kargp_t base = (kargp_t)__builtin_amdgcn_kernarg_segment_ptr();
    asm volatile("" : "+s"(base));
    typedef const float* cfp_t;
    return *(__attribute__((address_space(4))) const cfp_t*)(base + 8 * i);
#else
    return nullptr;
#endif
}
#define INP(i) inp(i)
#define IN_X 0
#define IN_C 1
#define IN_CTX 2
#define IN_CCTX 3
#define IN_ADAW 4
#define IN_ADAB 5
#define IN_WIN 6
#define IN_WOUT 7
#define IN_QG 8
#define IN_KG 9
#define IN_HCW 10
#define IN_HCB 11
#define IN_HW1 12
#define IN_HB1 13
#define IN_HFREQ 14
#define IN_HW2 15
#define IN_HB2 16
#define IN_HW3 17
#define IN_HB3 18
#define IN_HD 19
#define IN_RPB 20
#define IN_LN1G 21
#define IN_LN1B 22
#define IN_LN2G 23
#define IN_LN2B 24
#define IN_RW 25
#define IN_RB 26
#define IN_EW1 27
#define IN_EB1 28
#define IN_EW2 29
#define IN_EB2 30

#define WSP(T, off) ((T*)(F.ws + (off)))

__device__ __forceinline__ void p0_transpose_item(const float* W, int K, int N, bf16* WT, int row_off, LAS float* scr, int item, int lane) {
    const int nblk = N / 32, kb = item / nblk, nb = item % nblk, k0 = 64 * kb, n0 = 32 * nb;
#pragma unroll 8
    for (int i = 0; i < 32; ++i) { const int kk = 2 * i + (lane >> 5); scr[kk * 33 + (lane & 31)] = W[(size_t)(k0 + kk) * N + n0 + (lane & 31)]; }
    LDS_WAIT(); asm volatile("" ::: "memory");
    const int c = lane & 7;
#pragma unroll
    for (int j = 0; j < 4; ++j) { const int n = (lane >> 3) + 8 * j; const LAS float* s = scr + (8 * c) * 33 + n;
        v4u o; o.x = pk2(s[0 * 33], s[1 * 33]); o.y = pk2(s[2 * 33], s[3 * 33]); o.z = pk2(s[4 * 33], s[5 * 33]); o.w = pk2(s[6 * 33], s[7 * 33]);
        *(GAS v4u*)(WT + (size_t)(row_off + n0 + n) * K + k0 + 8 * c) = o; }
    LDS_WAIT(); asm volatile("" ::: "memory");
}

__device__ __forceinline__ void p0_mod_item(Frame& F, int it) {
    const int l = it / 96, cb = it % 96, col = cb * 64 + F.lane;
    const float* W = INP(IN_ADAW) + (size_t)l * DM * 6144 + col;
    const float* c = INP(IN_C); const float* cc = INP(IN_CCTX);
    float a0 = 0.f, a1 = 0.f, a2 = 0.f, a3 = 0.f, a4 = 0.f;
#pragma unroll 8
    for (int k = 0; k < DM; ++k) {
        const float w = W[(size_t)k * 6144];
        const float c0 = c[k], c1 = c[DM + k], c2 = c[2 * DM + k], c3 = c[3 * DM + k], c4 = cc[k];
        a0 += (c0 / (1.f + __expf(-c0))) * w; a1 += (c1 / (1.f + __expf(-c1))) * w; a2 += (c2 / (1.f + __expf(-c2))) * w;
        a3 += (c3 / (1.f + __expf(-c3))) * w; a4 += (c4 / (1.f + __expf(-c4))) * w;
    }
    const float bias = INP(IN_ADAB)[l * 6144 + col];
    float* MOD = WSP(float, WS_MOD) + (size_t)l * 5 * 6144 + col;
    MOD[0 * 6144] = a0 + bias; MOD[1 * 6144] = a1 + bias; MOD[2 * 6144] = a2 + bias; MOD[3 * 6144] = a3 + bias; MOD[4 * 6144] = a4 + bias;
}

__device__ __forceinline__ void p0_filter_item(Frame& F, int it) {
    const int lane = F.lane;
    const int l = it / 4352, rr = it % 4352, type = rr >= 4096 ? 1 : 0, t = type ? rr - 4096 : rr, L = type ? 256 : 4096;
    const float tn = (float)t / (float)(L - 1);
    const float w = (6.283185307179586f / (float)L) * (float)t;
    float zv = 0.f;
    if (lane == 0) zv = tn;
    else if (lane <= 16) { const float band = 1e-4f + (float)(lane - 1) * ((15.0f - 1e-4f) / 15.0f); zv = cosf(band * w); }
    else if (lane <= 32) { const float band = 1e-4f + (float)(lane - 17) * ((15.0f - 1e-4f) / 15.0f); zv = -sinf(band * w); }
    const float* w1 = INP(IN_HW1) + l * 33 * 64; const float* w2 = INP(IN_HW2) + l * 64 * 64; const float* w3 = INP(IN_HW3) + l * 64 * 512;
    float a = INP(IN_HB1)[l * 64 + lane];
#pragma unroll
    for (int k = 0; k < 33; ++k) a += __shfl(zv, k) * w1[k * 64 + lane];
    const float h1 = sinf(INP(IN_HFREQ)[l * 128 + lane] * a);
    float a2 = INP(IN_HB2)[l * 64 + lane];
#pragma unroll 16
    for (int k = 0; k < 64; ++k) a2 += __shfl(h1, k) * w2[k * 64 + lane];
    const float h2 = sinf(INP(IN_HFREQ)[l * 128 + 64 + lane] * a2);
    float o[8]; const float* b3p = INP(IN_HB3) + l * 512 + lane;
#pragma unroll
    for (int i = 0; i < 8; ++i) o[i] = b3p[64 * i];
#pragma unroll 8
    for (int k = 0; k < 64; ++k) { const float hk = __shfl(h2, k);
#pragma unroll
        for (int i = 0; i < 8; ++i) o[i] += hk * w3[k * 512 + lane + 64 * i]; }
    float* dst = type ? WSP(float, WS_FILTC) + (size_t)l * 2 * 256 * 256 : WSP(float, WS_FILT) + (size_t)l * 2 * 256 * 4096;
#pragma unroll
    for (int i = 0; i < 8; ++i) { const int c = lane + 64 * i, dir = c >> 8, ch = c & 255;
        const float ad = 3.0701134573253945f + (float)ch * ((15.350567286626973f - 3.0701134573253945f) / 255.0f);
        dst[((size_t)dir * 256 + ch) * L + t] = o[i] * expf(-tn * ad); }
}

__device__ __forceinline__ void ph_prologue(Frame& F) {
    LAS float* scr = (LAS float*)(F.lds + RING_OFF + F.wave * 16384);
    const int gw = F.vcu * NWAVES + F.wave, NGW = F.G * NWAVES;
    constexpr int I_IN = 16 * 72, I_OUT = 16 * 32, I_W1 = 32 * 16 * 64, I_W2 = 32 * 16 * 32, I_L = I_IN + I_OUT + I_W1 + I_W2;
    for (int it = gw; it < 192; it += NGW) p0_mod_item(F, it);
    for (int it = gw; it < 2 * 4352; it += NGW) p0_filter_item(F, it);
    for (int it = gw; it < 2 * I_L; it += NGW) {
        const int l = it / I_L; int r = it % I_L;
        if (r < I_IN) { p0_transpose_item(INP(IN_WIN) + (size_t)l * DM * DIN, DM, DIN, WSP(bf16, WS_WIN) + (size_t)l * DIN * DM, 0, scr, r, F.lane); continue; } r -= I_IN;
        if (r < I_OUT) { p0_transpose_item(INP(IN_WOUT) + (size_t)l * DM * DM, DM, DM, WSP(bf16, WS_WOUT) + (size_t)l * DM * DM, 0, scr, r, F.lane); continue; } r -= I_OUT;
        if (r < I_W1) { const int e = r / 1024, rr = r % 1024, nb = rr % 64, n0 = 32 * nb;
            const int drow = n0 < 1024 ? 256 * (n0 / 128) + (n0 % 128) : 256 * ((n0 - 1024) / 128) + 128 + ((n0 - 1024) % 128);
            p0_transpose_item(INP(IN_EW1) + (size_t)(l * NEXP + e) * DM * 2048, DM, 2048, WSP(bf16, WS_W1) + (size_t)(l * NEXP + e) * 2048 * DM, drow - n0, scr, rr, F.lane); continue; } r -= I_W1;
        { const int e = r / 512, rr = r % 512;
            p0_transpose_item(INP(IN_EW2) + (size_t)(l * NEXP + e) * DM * DM, DM, DM, WSP(bf16, WS_W2) + (size_t)(l * NEXP + e) * DM * DM, 0, scr, rr, F.lane); }
    }
}

__device__ __forceinline__ void row_stats(const f32x4 (&v)[4], float& mean, float& rstd) {
    float s = 0.f;
#pragma unroll
    for (int j = 0; j < 4; ++j) s += (v[j].x + v[j].y) + (v[j].z + v[j].w);
    mean = wave_sum(s) * (1.f / DM); float s2 = 0.f;
#pragma unroll
    for (int j = 0; j < 4; ++j) { const f32x4 d = v[j] - mean; s2 += (d.x * d.x + d.y * d.y) + (d.z * d.z + d.w * d.w); }
    rstd = 1.f / sqrtf(wave_sum(s2) * (1.f / DM) + LN_EPS);
}
__device__ __forceinline__ const float* modp(Frame& F, int l, int bsel, int which) { return WSP(float, WS_MOD) + ((size_t)(l * 5 + bsel) * 6 + which) * DM; }
__device__ __forceinline__ void modulate_store(Frame& F, const f32x4 (&v)[4], const float* shift, const float* scale, bf16* orow, f32x4 (&hv)[4]) {
    float mean, rstd; row_stats(v, mean, rstd);
    GAS unsigned long long* o8 = (GAS unsigned long long*)orow + F.lane;
#pragma unroll
    for (int j = 0; j < 4; ++j) { const f32x4 sc = ((const f32x4*)scale)[F.lane + 64 * j], sh = ((const f32x4*)shift)[F.lane + 64 * j];
        hv[j] = (v[j] - mean) * rstd * (sc + 1.0f) + sh;
        o8[64 * j] = (unsigned long long)pk2(hv[j].x, hv[j].y) | ((unsigned long long)pk2(hv[j].z, hv[j].w) << 32); }
}

__device__ __forceinline__ void ph_r0(Frame& F) {
    const int gw = F.vcu * NWAVES + F.wave, NGW = F.G * NWAVES;
    const float* xin = INP(IN_X); const float* cin = INP(IN_CTX);
    for (int r = gw; r < NTOK; r += NGW) {
        const int bsel = r < NLAT ? r / SEQ : 4;
        const float* src = r < NLAT ? xin + (size_t)r * DM : cin + (size_t)(r - NLAT) * DM;
        f32x4 v[4], hv[4];
#pragma unroll
        for (int j = 0; j < 4; ++j) v[j] = ((const f32x4*)src)[F.lane + 64 * j];
        modulate_store(F, v, modp(F, 0, bsel, 0), modp(F, 0, bsel, 1), WSP(bf16, WS_H) + (size_t)r * DM, hv);
    }
}

__device__ __forceinline__ void unpack8(const v4u raw, float (&x)[8]) {
    x[0] = bflo(raw.x); x[1] = bfhi(raw.x); x[2] = bflo(raw.y); x[3] = bfhi(raw.y); x[4] = bflo(raw.z); x[5] = bfhi(raw.z); x[6] = bflo(raw.w); x[7] = bfhi(raw.w);
}
__device__ __forceinline__ v4u pack8(const float (&x)[8]) { v4u o; o.x = pk2(x[0], x[1]); o.y = pk2(x[2], x[3]); o.z = pk2(x[4], x[5]); o.w = pk2(x[6], x[7]); return o; }
__device__ __forceinline__ void head_norm_rope(float (&x)[8], const float* gain, int lane, bool rope, int gr, int gc) {
    float ss = 0.f;
#pragma unroll
    for (int i = 0; i < 8; ++i) ss += x[i] * x[i];
    ss += __shfl_xor(ss, 1); ss += __shfl_xor(ss, 2); ss += __shfl_xor(ss, 4);
    const float rinv = 1.f / sqrtf(ss * (1.f / 64.f) + LN_EPS);
    const int d0 = (lane & 7) * 8;
#pragma unroll
    for (int i = 0; i < 8; ++i) x[i] = x[i] * rinv * gain[d0 + i];
    const int half = (lane >> 1) & 1, axis = (lane >> 2) & 1; const float pos = (float)(axis ? gc : gr);
#pragma unroll
    for (int i = 0; i < 8; ++i) {
        const float pv = __shfl_xor(x[i], 2);
        if (rope) { const int f = (lane & 1) * 8 + i; const float inv = exp2f(-(float)f * (13.287712379549449f / 16.0f)); const float ang = pos * inv;
            const float cs = cosf(ang), sn = sinf(ang); x[i] = x[i] * cs + (half ? pv : -pv) * sn; }
    }
}
__device__ __forceinline__ void ph_prep(Frame& F, int l) {
    const int gw = F.vcu * NWAVES + F.wave, NGW = F.G * NWAVES, lane = F.lane;
    const bf16* P = WSP(bf16, WS_P);
    const float* qg = INP(IN_QG) + l * 64; const float* kg = INP(IN_KG) + l * 64;
    for (int r = gw; r < NTOK; r += NGW) {
        const bool lat = r < NLAT; const int b = lat ? r / SEQ : (r - NLAT) / CTXL, t = lat ? r % SEQ : (r - NLAT) % CTXL, gr = t >> 6, gc = t & 63;
        const bf16* prow = P + (size_t)r * DIN;
        if (lat || l == 0) {
            float x[8]; unpack8(*(const GAS v4u*)(prow + CQ + lane * 8), x);
            head_norm_rope(x, qg, lane, lat, gr, gc);
#pragma unroll
            for (int i = 0; i < 8; ++i) x[i] *= C2;
            *(GAS v4u*)(WSP(bf16, WS_Q) + (size_t)r * 512 + lane * 8) = pack8(x);
        }
        {
            const int l32 = lane & 31;
            float x[8]; const v4u raw = *(const GAS v4u*)(prow + CK + l32 * 8); unpack8(raw, x);
            head_norm_rope(x, kg, lane, lat, gr, gc);
            const size_t krow = (size_t)b * KVLEN + (lat ? t : SEQ + t);
            if (lane < 16) *(GAS v4u*)(WSP(bf16, WS_K) + krow * 128 + lane * 8) = pack8(x);
            else if (lane < 32) *(GAS v4u*)(WSP(bf16, WS_V) + krow * 128 + (lane - 16) * 8) = raw;
        }
        if (!lat && l == 0 && lane < 32) {
            float x[8]; unpack8(*(const GAS v4u*)(prow + CNQ + lane * 8), x);
#pragma unroll
            for (int i = 0; i < 8; ++i) x[i] *= C2;
            *(GAS v4u*)(WSP(bf16, WS_NQC) + (size_t)(r - NLAT) * 256 + lane * 8) = pack8(x);
        }
    }
    LAS float* tile = (LAS float*)(F.lds + RING_OFF + F.wave * 16640);
    const int nitems = 1024 + (l == 0 ? 64 : 0);
    const float* cw = INP(IN_HCW) + l * 3 * 768; const float* cbias = INP(IN_HCB) + l * 768;
    for (int it = gw; it < nitems; it += NGW) {
        const int type = it >= 1024 ? 1 : 0, ii = type ? it - 1024 : it;
        const int L = type ? CTXL : SEQ, ntb = L / 64;
        const int cb = ii & 3, tb = (ii >> 2) % ntb, b = (ii >> 2) / ntb;
        const int rowbase = type ? NLAT + b * CTXL : b * SEQ, t0 = tb * 64, ch = cb * 64 + lane;
        float w[3][3], bs[3];
#pragma unroll
        for (int g = 0; g < 3; ++g) { bs[g] = cbias[g * 256 + ch];
#pragma unroll
            for (int j = 0; j < 3; ++j) w[j][g] = cw[j * 768 + g * 256 + ch]; }
        float prev[3], cur[3];
#pragma unroll
        for (int g = 0; g < 3; ++g) { prev[g] = t0 > 0 ? bf2f(P[(size_t)(rowbase + t0 - 1) * DIN + CHY + g * 256 + ch]) : 0.f; cur[g] = bf2f(P[(size_t)(rowbase + t0) * DIN + CHY + g * 256 + ch]); }
#pragma unroll 8
        for (int tt = 0; tt < 64; ++tt) { const int t = t0 + tt; float cv[3];
#pragma unroll
            for (int g = 0; g < 3; ++g) { const float nx = (t + 1 < L) ? bf2f(P[(size_t)(rowbase + t + 1) * DIN + CHY + g * 256 + ch]) : 0.f;
                cv[g] = prev[g] * w[0][g] + cur[g] * w[1][g] + nx * w[2][g] + bs[g]; prev[g] = cur[g]; cur[g] = nx; }
            WSP(bf16, WS_X0)[(size_t)(rowbase + t) * 256 + ch] = (bf16)f2bf(cv[0]);
            tile[tt * 65 + lane] = cv[1] * cv[2]; }
        LDS_WAIT(); asm volatile("" ::: "memory");
        float* zt = type ? WSP(float, WS_ZTC) + ((size_t)b * 256 + cb * 64) * CTXL + t0 : WSP(float, WS_ZT) + ((size_t)b * 256 + cb * 64) * SEQ + t0;
#pragma unroll 8
        for (int i = 0; i < 64; ++i) zt[(size_t)i * L + lane] = tile[lane * 65 + i];
        LDS_WAIT(); asm volatile("" ::: "memory");
    }
}

__device__ __forceinline__ void na_item(Frame& F, const float* rpb_l, int tok, int h) {
    const int lane = F.lane; const bf16* P = WSP(bf16, WS_P);
    const int b = tok >> 12, t = tok & 4095, r = t >> 6, q = t & 63;
    const int rs = min(max(r - 4, 0), 56), cs = min(max(q - 8, 0), 48);
    float qv[64];
    { const bf16* qrow = P + (size_t)tok * DIN + CNQ + h * 64;
#pragma unroll
      for (int i = 0; i < 8; ++i) { float x[8]; unpack8(*(const GAS v4u*)(qrow + i * 8), x);
#pragma unroll
          for (int j = 0; j < 8; ++j) qv[i * 8 + j] = x[j] * 0.125f; } }
    const float* rpb = rpb_l + (size_t)h * 15 * 31;
    float s[6];
#pragma unroll
    for (int si = 0; si < 6; ++si) { const int kk = lane + 64 * si; const bf16* krow; float bias = 0.f;
        if (si < 2) { const int i = kk >> 4, j = kk & 15; krow = P + (size_t)(b * SEQ + (rs + i) * 64 + cs + j) * DIN + CNK + h * 64; bias = rpb[(rs + i - r + 7) * 31 + (cs + j - q + 15)]; }
        else krow = P + (size_t)(NLAT + b * CTXL + (kk - 128)) * DIN + CNK + h * 64;
        float d = 0.f;
#pragma unroll
        for (int i = 0; i < 8; ++i) { float x[8]; unpack8(*(const GAS v4u*)(krow + i * 8), x);
#pragma unroll
            for (int j = 0; j < 8; ++j) d += qv[i * 8 + j] * x[j]; }
        s[si] = d + bias; }
    float mx = s[0];
#pragma unroll
    for (int si = 1; si < 6; ++si) mx = fmaxf(mx, s[si]);
    mx = wave_max(mx); float sm = 0.f;
#pragma unroll
    for (int si = 0; si < 6; ++si) { s[si] = __expf(s[si] - mx); sm += s[si]; }
    sm = wave_sum(sm);
    float acc = 0.f;
#pragma unroll
    for (int si = 0; si < 6; ++si) {
#pragma unroll 8
        for (int src = 0; src < 64; ++src) { const float pb = __shfl(s[si], src); const int kk = src + 64 * si; const bf16* vrow;
            if (si < 2) vrow = P + (size_t)(b * SEQ + (rs + (kk >> 4)) * 64 + cs + (kk & 15)) * DIN + CNV + h * 64;
            else vrow = P + (size_t)(NLAT + b * CTXL + (kk - 128)) * DIN + CNV + h * 64;
            acc += pb * bf2f(vrow[lane]); } }
    WSP(bf16, WS_YMIX)[(size_t)tok * DM + 768 + h * 64 + lane] = (bf16)f2bf(acc / sm);
}

constexpr int HY_OFF = 4099, HY_GN = 8196;
__device__ __forceinline__ void hy_item(Frame& F, const float* hd_l, int l, int type, int b, int c) {
    const int tid = F.tid, L = type ? CTXL : SEQ;
    LAS float* G = (LAS float*)(F.lds + RING_OFF); LAS float* Z = G + 8208; LAS float* red = Z + 4096;
    const float* hf = type ? WSP(float, WS_FILTC) + ((size_t)(l * 2 + 0) * 256 + c) * CTXL : WSP(float, WS_FILT) + ((size_t)(l * 2 + 0) * 256 + c) * SEQ;
    const float* hb = type ? WSP(float, WS_FILTC) + ((size_t)(l * 2 + 1) * 256 + c) * CTXL : WSP(float, WS_FILT) + ((size_t)(l * 2 + 1) * 256 + c) * SEQ;
    const float* zt = type ? WSP(float, WS_ZTC) + ((size_t)b * 256 + c) * CTXL : WSP(float, WS_ZT) + ((size_t)b * 256 + c) * SEQ;
    float ssq = 0.f;
    for (int idx = tid; idx < HY_GN; idx += 512) { const int lag = idx - HY_OFF; float v = 0.f;
        if (lag >= 0 && lag < L) v = hf[lag]; else if (lag < 0 && -lag < L) v = hb[-lag];
        G[idx] = v; ssq += v * v; }
    for (int idx = tid; idx < L; idx += 512) Z[idx] = zt[idx];
    ssq = wave_sum(ssq); if (F.lane == 0) red[F.wave] = ssq;
    __syncthreads();
    float tot = 0.f;
#pragma unroll
    for (int i = 0; i < 8; ++i) tot += red[i];
    const float nscale = 1.f / sqrtf(tot + LN_EPS);
    if (tid * 8 < L) {
        const int t0 = tid * 8; float acc[8], w[16];
#pragma unroll
        for (int i = 0; i < 8; ++i) acc[i] = 0.f;
#pragma unroll
        for (int m = 8; m < 15; ++m) w[m] = G[HY_OFF + t0 - 7 + m];
        for (int s0 = 0; s0 < L; s0 += 8) {
            const f32x4 g0 = *(const LAS f32x4*)(G + HY_OFF + t0 - s0 - 7), g1 = *(const LAS f32x4*)(G + HY_OFF + t0 - s0 - 3);
            w[0] = g0.x; w[1] = g0.y; w[2] = g0.z; w[3] = g0.w; w[4] = g1.x; w[5] = g1.y; w[6] = g1.z; w[7] = g1.w;
            const f32x4 z0 = *(const LAS f32x4*)(Z + s0), z1 = *(const LAS f32x4*)(Z + s0 + 4);
            const float zz[8] = {z0.x, z0.y, z0.z, z0.w, z1.x, z1.y, z1.z, z1.w};
#pragma unroll
            for (int i = 0; i < 8; ++i)
#pragma unroll
                for (int j = 0; j < 8; ++j) acc[i] += w[i - j + 7] * zz[j];
#pragma unroll
            for (int m = 14; m >= 8; --m) w[m] = w[m - 8];
        }
        const float dsk = hd_l[c]; const int rowbase = type ? NLAT + b * CTXL : b * SEQ;
#pragma unroll
        for (int i = 0; i < 8; ++i) { const int t = t0 + i; const float y = acc[i] * nscale + Z[t] * dsk;
            const float x0 = bf2f(WSP(bf16, WS_X0)[(size_t)(rowbase + t) * 256 + c]);
            WSP(bf16, WS_YMIX)[(size_t)(rowbase + t) * DM + 512 + c] = (bf16)f2bf(y * x0); }
    }
    __syncthreads();
}

__device__ __forceinline__ void ph_mixers(Frame& F, int l, char* lds_generic) {
    {
        typedef attn_body::bf16 abf;
        const abf* Qb = (const abf*)WSP(bf16, WS_Q); const abf* Kb = (const abf*)WSP(bf16, WS_K); const abf* Vb = (const abf*)WSP(bf16, WS_V);
        const abf* Pb = (const abf*)WSP(bf16, WS_P); const abf* NQ = (const abf*)WSP(bf16, WS_NQC); abf* Ym = (abf*)WSP(bf16, WS_YMIX);
        const int nunits = 512 + (l == 0 ? 48 : 0);
        for (int u = F.vcu; u < nunits; u += F.G) {
            const abf *Qu, *Kh, *Vh; abf* Ou; int QP, KP, NT;
            if (u < 512) { const int bk = u >> 6, b = bk >> 1, kvh = bk & 1, hq = (u >> 4) & 3, qb = u & 15, head = kvh * 4 + hq;
                Qu = Qb + (size_t)(b * SEQ + qb * 256) * 512 + head * 64; Kh = Kb + (size_t)b * KVLEN * 128 + kvh * 64; Vh = Vb + (size_t)b * KVLEN * 128 + kvh * 64;
                Ou = Ym + (size_t)(b * SEQ + qb * 256) * DM + head * 64; QP = 512; KP = 128; NT = KVLEN / 64; }
            else if (u < 544) { const int j = u - 512, b = j >> 3, head = j & 7, kvh = head >> 2;
                Qu = Qb + (size_t)(NLAT + b * CTXL) * 512 + head * 64; Kh = Kb + ((size_t)b * KVLEN + SEQ) * 128 + kvh * 64; Vh = Vb + ((size_t)b * KVLEN + SEQ) * 128 + kvh * 64;
                Ou = Ym + (size_t)(NLAT + b * CTXL) * DM + head * 64; QP = 512; KP = 128; NT = 4; }
            else { const int j = u - 544, b = j >> 2, h = j & 3;
                Qu = NQ + (size_t)(b * CTXL) * 256 + h * 64; Kh = Pb + (size_t)(NLAT + b * CTXL) * DIN + CNK + h * 64; Vh = Pb + (size_t)(NLAT + b * CTXL) * DIN + CNV + h * 64;
                Ou = Ym + (size_t)(NLAT + b * CTXL) * DM + 768 + h * 64; QP = 256; KP = DIN; NT = 4; }
            attn_body::attn_unit<8>(Qu, Kh, Vh, Ou, QP, KP, DM, NT, lds_generic, F.tid);
        }
    }
    __syncthreads();
    { const int gw = F.vcu * NWAVES + F.wave, NGW = F.G * NWAVES;
      const float* rpb_l = INP(IN_RPB) + (size_t)l * 4 * 15 * 31;
      for (int it = gw; it < NLAT * 4; it += NGW) na_item(F, rpb_l, it >> 2, it & 3); }
    __syncthreads();
    { const int n = 1024 + (l == 0 ? 1024 : 0); const float* hd_l = INP(IN_HD) + l * 256;
      for (int it = F.vcu; it < n; it += F.G) { const int type = it >= 1024 ? 1 : 0, ii = it & 1023; hy_item(F, hd_l, l, type, ii >> 8, ii & 255); } }
}

__device__ __forceinline__ void ph_r1(Frame& F, int l) {
    const int tid = F.tid, lane = F.lane;
    LAS float* rwT = (LAS float*)(F.lds + RING_OFF);
    volatile LAS unsigned* cntL = F.MISC + 16;
    { const float* rw = INP(IN_RW) + (size_t)l * DM * NEXP;
      for (int i = tid; i < DM * NEXP / 4; i += 512) { const f32x4 v = ((const f32x4*)rw)[i]; const int k = i >> 3, e4 = (i & 7) * 4;
          rwT[(e4 + 0) * DM + k] = v.x; rwT[(e4 + 1) * DM + k] = v.y; rwT[(e4 + 2) * DM + k] = v.z; rwT[(e4 + 3) * DM + k] = v.w; } }
    if (tid < 32) cntL[tid] = 0u;
    __syncthreads();
    const int gw = F.vcu * NWAVES + F.wave, NGW = F.G * NWAVES, nrows = l == 0 ? NTOK : NLAT;
    const float* rb = INP(IN_RB) + l * NEXP; const float* xin = INP(IN_X); const float* cin = INP(IN_CTX);
    const float* ln1g = INP(IN_LN1G) + l * DM; const float* ln1b = INP(IN_LN1B) + l * DM;
    int* topi = WSP(int, WS_ROUTE) + RT_TOPI; float* gate = WSP(float, WS_ROUTE) + RT_GATE; int* slotpos = WSP(int, WS_ROUTE) + RT_SLOTPOS;
    for (int r = gw; r < nrows; r += NGW) {
        const int bsel = r < NLAT ? r / SEQ : 4;
        const float* xsrc = l == 0 ? (r < NLAT ? xin + (size_t)r * DM : cin + (size_t)(r - NLAT) * DM) : WSP(float, WS_X) + (size_t)r * DM;
        const bf16* yrow = WSP(bf16, WS_Y) + (size_t)r * DM;
        const float* g1 = modp(F, l, bsel, 2);
        f32x4 v[4];
#pragma unroll
        for (int j = 0; j < 4; ++j) { const f32x4 xv = ((const f32x4*)xsrc)[lane + 64 * j]; const f32x4 gv = ((const f32x4*)g1)[lane + 64 * j];
            const unsigned long long yw = ((const GAS unsigned long long*)yrow)[lane + 64 * j];
            const f32x4 yv = {bflo((unsigned)yw), bfhi((unsigned)yw), bflo((unsigned)(yw >> 32)), bfhi((unsigned)(yw >> 32))};
            v[j] = xv * DN_ALPHA + gv * yv; }
        float mean, rstd; row_stats(v, mean, rstd);
        float* xdst = WSP(float, WS_X) + (size_t)r * DM;
#pragma unroll
        for (int j = 0; j < 4; ++j) { const f32x4 gg = ((const f32x4*)ln1g)[lane + 64 * j], bb = ((const f32x4*)ln1b)[lane + 64 * j];
            v[j] = (v[j] - mean) * rstd * gg + bb; ((f32x4*)xdst)[lane + 64 * j] = v[j]; }
        f32x4 hv[4];
        modulate_store(F, v, modp(F, l, bsel, 3), modp(F, l, bsel, 4), WSP(bf16, WS_H) + (size_t)r * DM, hv);
        float lg[32];
#pragma unroll
        for (int e = 0; e < 32; ++e) { float a = 0.f;
#pragma unroll
            for (int j = 0; j < 4; ++j) { const f32x4 w4 = *(const LAS f32x4*)(rwT + e * DM + 4 * lane + 256 * j); a += (hv[j].x * w4.x + hv[j].y * w4.y) + (hv[j].z * w4.z + hv[j].w * w4.w); }
            lg[e] = wave_sum(a) + rb[e]; }
        float tv[4]; int ti[4];
#pragma unroll
        for (int k = 0; k < 4; ++k) { float best = -INFINITY; int bi = 0;
#pragma unroll
            for (int e = 0; e < 32; ++e) if (lg[e] > best) { best = lg[e]; bi = e; }
            tv[k] = best; ti[k] = bi;
#pragma unroll
            for (int e = 0; e < 32; ++e) if (e == bi) lg[e] = -INFINITY; }
        const float e1 = __expf(tv[1] - tv[0]), e2 = __expf(tv[2] - tv[0]), e3 = __expf(tv[3] - tv[0]); const float inv = 1.f / (1.f + e1 + e2 + e3);
        if (lane < 4) { const int e = lane == 0 ? ti[0] : lane == 1 ? ti[1] : lane == 2 ? ti[2] : ti[3];
            const float wg = (lane == 0 ? 1.f : lane == 1 ? e1 : lane == 2 ? e2 : e3) * inv;
            const unsigned lp = __hip_atomic_fetch_add((LAS unsigned*)(cntL + e), 1u, __ATOMIC_RELAXED, __HIP_MEMORY_SCOPE_WORKGROUP);
            topi[r * 4 + lane] = e; gate[r * 4 + lane] = wg; slotpos[r * 4 + lane] = (int)lp; }
    }
    __syncthreads();
    if (tid < 32) (WSP(int, WS_ROUTE) + RT_CNT)[F.vcu * 32 + tid] = (int)cntL[tid];
}

__device__ __forceinline__ void ph_gather(Frame& F, int l) {
    const int tid = F.tid, lane = F.lane;
    volatile LAS int* sm = (volatile LAS int*)(F.lds + RING_OFF);
    const int* cnt = WSP(int, WS_ROUTE) + RT_CNT;
    { const int e = tid & 31, g = tid >> 5, per = (F.G + 15) / 16; int st = 0, sp = 0;
      for (int bb = 0; bb < per; ++bb) { const int blk = g * per + bb; if (blk < F.G) { const int v = cnt[blk * 32 + e]; st += v; if (blk < F.vcu) sp += v; } }
      sm[g * 32 + e] = st; sm[512 + g * 32 + e] = sp; }
    __syncthreads();
    if (tid < 32) { int tot = 0, pre = 0;
        for (int g = 0; g < 16; ++g) { tot += sm[g * 32 + tid]; pre += sm[512 + g * 32 + tid]; }
        sm[1024 + tid] = tot; sm[1056 + tid] = pre; }
    __syncthreads();
    if (tid == 0) { int base = 0; for (int e = 0; e < 32; ++e) { sm[1088 + e] = base; base += ((sm[1024 + e] + 255) / 256) * 256; } sm[1120] = base / 256; }
    __syncthreads();
    int* TT = WSP(int, WS_ROUTE) + RT_TT; int* rowslot = WSP(int, WS_ROUTE) + RT_ROWSLOT;
    if (F.vcu == 0) {
        if (tid == 0) TT[0] = sm[1120];
        for (int e = 0; e < 32; ++e) { const int tot = sm[1024 + e], base = sm[1088 + e], nte = (tot + 255) / 256;
            for (int i = tid; i < nte; i += 512) TT[1 + base / 256 + i] = e;
            for (int p = tot + tid; p < nte * 256; p += 512) rowslot[base + p] = -1; }
    }
    const int gw = F.vcu * NWAVES + F.wave, NGW = F.G * NWAVES, nrows = l == 0 ? NTOK : NLAT;
    const int* topi = WSP(int, WS_ROUTE) + RT_TOPI; const int* slotpos = WSP(int, WS_ROUTE) + RT_SLOTPOS;
    for (int r = gw; r < nrows; r += NGW) {
        const GAS v4u* hrow = (const GAS v4u*)(WSP(bf16, WS_H) + (size_t)r * DM);
        const v4u a0 = hrow[lane], a1 = hrow[lane + 64];
#pragma unroll
        for (int k = 0; k < 4; ++k) { const int e = topi[r * 4 + k], lp = slotpos[r * 4 + k]; const int pos = sm[1088 + e] + sm[1056 + e] + lp;
            GAS v4u* drow = (GAS v4u*)(WSP(bf16, WS_AS) + (size_t)pos * DM); drow[lane] = a0; drow[lane + 64] = a1;
            if (lane == 0) rowslot[pos] = r * 4 + k; }
    }
}

namespace pg8 {
struct GroupedOrder {
    const int* TT; int nN, G, c;
    __device__ __forceinline__ bool next(int i, Unit& u) const {
        const int ntiles = __builtin_amdgcn_readfirstlane(TT[0]);
        const long L = (long)i * G + c; if (L >= (long)ntiles * nN) return false;
        const int rt = (int)(L / nN), pn = (int)(L % nN); const int e = __builtin_amdgcn_readfirstlane(TT[1 + rt]);
        u.pm = rt; u.pn = pn; u.pe = e; u.pb = e * nN + pn; return true;
    }
    __device__ __forceinline__ void a_ready(const Unit&) const {}
    __device__ __forceinline__ void done(const Unit&) const {}
};
struct EpiSwiGLU {
    static constexpr bool PERM = true, AFTER_DRAIN = false;
    bf16_t* O; const float* b1;
    __device__ __forceinline__ void operator()(const f32x4 (&acc)[2][2][4][2], const Unit& u, int wr, int wc, int fr, int fq) const {
        const int row0 = u.pm * BM + wr * 64 + fr, cc0 = u.pn * 128 + wc * 32 + 8 * fq;
        const float* bg = b1 + (size_t)u.pe * 2048 + cc0; const float* bl = bg + 1024;
        f32x4 vg[2], vl[2];
#pragma unroll
        for (int n = 0; n < 2; ++n) { vg[n] = *(const f32x4*)(bg + 4 * n); vl[n] = *(const f32x4*)(bl + 4 * n); }
#pragma unroll
        for (int ai = 0; ai < 2; ++ai)
#pragma unroll
            for (int m = 0; m < 4; ++m) { bf16_t* rowp = O + (size_t)(row0 + ai * HALF + m * 16) * 1024 + cc0; float o[8];
#pragma unroll
                for (int n = 0; n < 2; ++n) { const f32x4 g = acc[ai][0][m][n] + vg[n], li = acc[ai][1][m][n] + vl[n];
#pragma unroll
                    for (int j = 0; j < 4; ++j) { const float gg = fminf(g[j], 7.0f), ll = fminf(fmaxf(li[j], -7.0f), 7.0f);
                        o[n * 4 + j] = gg * (1.0f / (1.0f + __expf(-1.702f * gg))) * (ll + 1.0f); } }
                u32x4 w; w.x = cvt_pk_bf16(o[0], o[1]); w.y = cvt_pk_bf16(o[2], o[3]); w.z = cvt_pk_bf16(o[4], o[5]); w.w = cvt_pk_bf16(o[6], o[7]);
                *(u32x4*)rowp = w; }
    }
};
struct EpiMoeOut {
    static constexpr bool PERM = true, AFTER_DRAIN = false;
    bf16_t* O; const float* b2; const float* gate; const int* rowslot;
    __device__ __forceinline__ void operator()(const f32x4 (&acc)[2][2][4][2], const Unit& u, int wr, int wc, int fr, int fq) const {
        const int row0 = u.pm * BM + wr * 64 + fr, col0 = u.pn * BM + wc * 32 + 8 * fq;
        f32x4 bv[2][2];
#pragma unroll
        for (int bj = 0; bj < 2; ++bj)
#pragma unroll
            for (int n = 0; n < 2; ++n) bv[bj][n] = *(const f32x4*)(b2 + (size_t)u.pe * 1024 + col0 + bj * HALF + 4 * n);
#pragma unroll
        for (int ai = 0; ai < 2; ++ai)
#pragma unroll
            for (int m = 0; m < 4; ++m) { const int slot = rowslot[row0 + ai * HALF + m * 16];
                if (slot >= 0) { const float gt = gate[slot]; bf16_t* rowp = O + (size_t)slot * 1024 + col0;
#pragma unroll
                    for (int bj = 0; bj < 2; ++bj) { const f32x4 v0 = (acc[ai][bj][m][0] + bv[bj][0]) * gt, v1 = (acc[ai][bj][m][1] + bv[bj][1]) * gt;
                        u32x4 w; w.x = cvt_pk_bf16(v0[0], v0[1]); w.y = cvt_pk_bf16(v0[2], v0[3]); w.z = cvt_pk_bf16(v1[0], v1[1]); w.w = cvt_pk_bf16(v1[2], v1[3]);
                        *(u32x4*)(rowp + bj * HALF) = w; } } }
    }
};
}

__device__ __forceinline__ void ph_r2(Frame& F, int l) {
    const int lane = F.lane, gw = F.vcu * NWAVES + F.wave, NGW = F.G * NWAVES, nrows = l == 0 ? NTOK : NLAT;
    const float* ln2g = INP(IN_LN2G) + l * DM; const float* ln2b = INP(IN_LN2B) + l * DM;
    for (int r = gw; r < nrows; r += NGW) {
        const int bsel = r < NLAT ? r / SEQ : 4;
        const float* xsrc = WSP(float, WS_X) + (size_t)r * DM; const float* g2 = modp(F, l, bsel, 5);
        const bf16* y4 = WSP(bf16, WS_Y4) + (size_t)r * 4 * DM;
        f32x4 v[4];
#pragma unroll
        for (int j = 0; j < 4; ++j) { f32x4 mo = {0.f, 0.f, 0.f, 0.f};
#pragma unroll
            for (int k = 0; k < 4; ++k) { const unsigned long long yw = ((const GAS unsigned long long*)(y4 + (size_t)k * DM))[lane + 64 * j];
                mo += (f32x4){bflo((unsigned)yw), bfhi((unsigned)yw), bflo((unsigned)(yw >> 32)), bfhi((unsigned)(yw >> 32))}; }
            v[j] = ((const f32x4*)xsrc)[lane + 64 * j] * DN_ALPHA + ((const f32x4*)g2)[lane + 64 * j] * mo; }
        float mean, rstd; row_stats(v, mean, rstd);
        float* xdst = (l == DEPTH - 1) ? F.out + (size_t)r * DM : WSP(float, WS_X) + (size_t)r * DM;
#pragma unroll
        for (int j = 0; j < 4; ++j) { const f32x4 gg = ((const f32x4*)ln2g)[lane + 64 * j], bb = ((const f32x4*)ln2b)[lane + 64 * j];
            v[j] = (v[j] - mean) * rstd * gg + bb; ((f32x4*)xdst)[lane + 64 * j] = v[j]; }
        if (l + 1 < DEPTH) { f32x4 hv[4]; modulate_store(F, v, modp(F, l + 1, bsel, 0), modp(F, l + 1, bsel, 1), WSP(bf16, WS_H) + (size_t)r * DM, hv); }
    }
}

#define PHASE_LOCAL Frame P = F; int l = l_; asm volatile("" : "+s"(P.ws), "+s"(P.out), "+v"(P.tid), "+v"(P.lane), "+s"(P.wave), "+s"(P.vcu), "+s"(P.G), "+s"(l))
#define IN(k) (lo <= (k) && (k) < hi)
#define SEAM(k) do { if (IN((k) + 1)) xcd_barrier(bar); } while (0)
template <int LAYER> __device__ __forceinline__ void layer_body(Frame& F, const XcdBarrier& bar, const int lo, const int hi, unsigned char* lds) {
    {
        constexpr int l_ = LAYER; constexpr int pb = 2 + 9 * l_;
        if (IN(pb + 0)) { PHASE_LOCAL;
            pg8::Gemm g{(const bf16*)(P.ws + WS_H), (const bf16*)(P.ws + WS_WIN) + (size_t)l * DIN * DM, NTOK, DIN, DM}; pg8::StaticOrder S; S.init(NTOK, DIN, P.G, (int)blockIdx.x);
            pg8::EpiBf16<0> E{(bf16*)(P.ws + WS_P), DIN, nullptr, 0, 0, 1.f};
            pg8::gemm_phase<pg8::EpiBf16<0>, pg8::StaticOrder, true, true>(P.lds + RING_OFF, g, S, E, P.tid);
            SEAM(pb + 0); }
        if (IN(pb + 1)) { PHASE_LOCAL; ph_prep(P, l); SEAM(pb + 1); }
        if (IN(pb + 2)) { PHASE_LOCAL; ph_mixers(P, l, (char*)lds + RING_OFF); SEAM(pb + 2); }
        if (IN(pb + 3)) { PHASE_LOCAL;
            const int M = l == 0 ? NTOK : NLAT;
            pg8::Gemm g{(const bf16*)(P.ws + WS_YMIX), (const bf16*)(P.ws + WS_WOUT) + (size_t)l * DM * DM, M, DM, DM}; pg8::StaticOrder S; S.init(M, DM, P.G, (int)blockIdx.x);
            pg8::EpiBf16<0> E{(bf16*)(P.ws + WS_Y), DM, nullptr, 0, 0, 1.f};
            pg8::gemm_phase<pg8::EpiBf16<0>, pg8::StaticOrder, true, true>(P.lds + RING_OFF, g, S, E, P.tid);
            SEAM(pb + 3); }
        if (IN(pb + 4)) { PHASE_LOCAL; ph_r1(P, l); SEAM(pb + 4); }
        if (IN(pb + 5)) { PHASE_LOCAL; ph_gather(P, l); SEAM(pb + 5); }
        if (IN(pb + 6)) { PHASE_LOCAL;
            pg8::Gemm g{(const bf16*)(P.ws + WS_AS), (const bf16*)(P.ws + WS_W1) + (size_t)l * NEXP * 2048 * DM, MAXSORT, 2048, DM};
            pg8::GroupedOrder S{(const int*)(P.ws + WS_ROUTE) + RT_TT, 8, P.G, (int)blockIdx.x};
            pg8::EpiSwiGLU E{(bf16*)(P.ws + WS_ACT), INP(IN_EB1) + (size_t)l * NEXP * 2048};
            pg8::gemm_phase<pg8::EpiSwiGLU, pg8::GroupedOrder, true, true>(P.lds + RING_OFF, g, S, E, P.tid);
            SEAM(pb + 6); }
        if (IN(pb + 7)) { PHASE_LOCAL;
            pg8::Gemm g{(const bf16*)(P.ws + WS_ACT), (const bf16*)(P.ws + WS_W2) + (size_t)l * NEXP * DM * DM, MAXSORT, DM, DM};
            pg8::GroupedOrder S{(const int*)(P.ws + WS_ROUTE) + RT_TT, 4, P.G, (int)blockIdx.x};
            pg8::EpiMoeOut E{(bf16*)(P.ws + WS_Y4), INP(IN_EB2) + (size_t)l * NEXP * DM, (const float*)(P.ws + WS_ROUTE) + RT_GATE, (const int*)(P.ws + WS_ROUTE) + RT_ROWSLOT};
            pg8::gemm_phase<pg8::EpiMoeOut, pg8::GroupedOrder, true, true>(P.lds + RING_OFF, g, S, E, P.tid);
            SEAM(pb + 7); }
        if (IN(pb + 8)) { PHASE_LOCAL; ph_r2(P, l); SEAM(pb + 8); }
    }
}
struct Args { const float* in[31]; float* out; unsigned char* ws; int ph_lo, ph_hi; };
__global__ void __launch_bounds__(NWAVES * 64, 2) mega_fwd(Args args) {
    extern __shared__ __attribute__((aligned(16))) unsigned char lds[];
    Frame F;
    F.lds = (LAS unsigned char*)lds;
    F.MISC = (volatile LAS unsigned*)(F.lds + LDSCTL_OFF);
    F.tid = threadIdx.x; F.lane = F.tid & 63; F.wave = __builtin_amdgcn_readfirstlane(F.tid >> 6);
    F.G = gridDim.x; { const int bx = blockIdx.x; F.vcu = (F.G % 8 == 0) ? (bx % 8) * (F.G / 8) + bx / 8 : bx; }
    F.ws = args.ws; F.ctl = (gu32*)(args.ws + WS_CTL); F.out = args.out;
    for (int u = F.tid; u < LDSCTL_BYTES / 4; u += NWAVES * 64) ((LAS unsigned*)(F.lds + LDSCTL_OFF))[u] = 0u;
    __syncthreads();
    const int lo = args.ph_lo, hi = args.ph_hi;
    const bool multi = (hi - lo) > 1;
    XcdBarrier bar; bar.bar = (unsigned*)(F.ctl + CW_BAR); bar.x = 0; bar.st = nullptr;
    if (multi) bar = xcd_barrier_post((unsigned*)(F.ctl + CW_BAR), F.MISC + 8);

    if (IN(0)) { ph_prologue(F); SEAM(0); }
    if (IN(1)) { ph_r0(F); SEAM(1); }
    layer_body<0>(F, bar, lo, hi, lds);
    layer_body<1>(F, bar, lo, hi, lds);
#undef IN
#undef SEAM
}

#ifndef MK_N_LAUNCHES
#define MK_N_LAUNCHES NPHASE
#endif
extern "C" void kernel_launch(void* const* d_in, const int* in_sizes, int n_in, void* d_out, int out_size, void* d_ws, size_t ws_size, hipStream_t stream) {
    static int grid = 0;
    if (grid == 0) {
        if (n_in != 31 || out_size != NLAT * DM || ws_size < WS_END) { fprintf(stderr, "kernel_launch: unexpected problem (n_in %d, out %d, ws %zu); nothing launched\n", n_in, out_size, ws_size); grid = -1; return; }
        int dev = 0, cus = 0, per_cu = 0;
        if (hipGetDevice(&dev) != hipSuccess || hipDeviceGetAttribute(&cus, hipDeviceAttributeMultiprocessorCount, dev) != hipSuccess) { grid = -1; return; }
        if (hipFuncSetAttribute((const void*)mega_fwd, hipFuncAttributeMaxDynamicSharedMemorySize, LDS_BYTES) != hipSuccess) { fprintf(stderr, "kernel_launch: hipFuncSetAttribute failed\n"); grid = -1; return; }
        if (hipOccupancyMaxActiveBlocksPerMultiprocessor(&per_cu, (const void*)mega_fwd, NWAVES * 64, LDS_BYTES) != hipSuccess || per_cu < 1)
            fprintf(stderr, "kernel_launch: note: occupancy query reports %d workgroups per CU\n", per_cu);
        (void)hipGetLastError();
        grid = cus;
        if (grid > 256) grid = 256;
    }
    if (grid < 0) return;
    if (hipMemsetAsync((char*)d_ws + WS_CTL, 0, CTL_ZERO_BYTES, stream) != hipSuccess) return;
    Args a{};
    for (int i = 0; i < 31; ++i) a.in[i] = (const float*)d_in[i];
    a.out = (float*)d_out; a.ws = (unsigned char*)d_ws;
    if (MK_N_LAUNCHES == 1) { a.ph_lo = 0; a.ph_hi = NPHASE; hipLaunchKernelGGL(mega_fwd, dim3(grid), dim3(NWAVES * 64), LDS_BYTES, stream, a); }
    else for (int k = 0; k < NPHASE; ++k) { a.ph_lo = k; a.ph_hi = k + 1; hipLaunchKernelGGL(mega_fwd, dim3(grid), dim3(NWAVES * 64), LDS_BYTES, stream, a); }
}
```

```cpp
#include <hip/hip_runtime.h>
#include <cstdio>
#include <cstdint>
namespace pg8 {
#define PG8_LAS __attribute__((address_space(3)))
typedef unsigned short bf16_t;
typedef short bf16x8 __attribute__((ext_vector_type(8)));
typedef float f32x4 __attribute__((ext_vector_type(4)));
typedef unsigned u32x4 __attribute__((ext_vector_type(4)));
constexpr int BM = 256, BK = 64, HALF = 128, HTB = HALF * BK * 2  , STAGE_BYTES = 8 * HTB, NXCD = 8, WGM = 8;

__host__ __device__ __forceinline__ int lds_byte(int r, int c) { const int st = (r >> 4) * 2 + (c >> 5), rr = r & 15, cc = c & 31, ob = rr * 64 + cc * 2; return st * 1024 + (ob ^ (((ob >> 9) & 1) << 5)); }
__host__ __device__ __forceinline__ void stage_rc(int b, int& R, int& C) { const int st = b / 1024, sb = b % 1024, swz = sb ^ (((sb >> 9) & 1) << 5); R = (st >> 1) * 16 + swz / 64; C = (st & 1) * 32 + (swz % 64) / 2; }
__host__ __device__ __forceinline__ int perm32(int rho) { const int n = rho >> 4, i = rho & 15; return 8 * (i >> 2) + 4 * n + (i & 3); }

struct Unit { int pm, pn, pb, pe; };
struct Gemm { const bf16_t* A; const bf16_t* Bt; int M, N, K; };

struct StaticOrder {
    int nM, nN, nwg, G, c;
    __host__ __device__ void init(int M, int N, int G_, int c_) { nM = M / BM; nN = N / BM; nwg = nM * nN; G = G_; c = c_; }
    __host__ __device__ bool next(int i, Unit& u) const {
        const long L = (long)i * G + c; if (L >= nwg) return false;
        int wgid = (int)L; { const int q = nwg / NXCD, r = nwg % NXCD, xcd = wgid % NXCD, off = wgid / NXCD; wgid = (xcd < r ? xcd * (q + 1) : r * (q + 1) + (xcd - r) * q) + off; }
        const int nig = WGM * nN, gid = wgid / nig, fm = gid * WGM, gsz = (nM - fm) < WGM ? (nM - fm) : WGM;
        u.pm = fm + ((wgid % nig) % gsz); u.pn = (wgid % nig) / gsz; u.pb = u.pn; u.pe = 0; return true;
    }
    __device__ __forceinline__ void a_ready(const Unit&) const {}
    __device__ __forceinline__ void done(const Unit&) const {}
};

__device__ __forceinline__ unsigned cvt_pk_bf16(float lo, float hi) { unsigned r; asm volatile("v_cvt_pk_bf16_f32 %0, %1, %2" : "=v"(r) : "v"(lo), "v"(hi)); return r; }
typedef float f32x2 __attribute__((ext_vector_type(2)));
__device__ __forceinline__ f32x2 gelu_pk(f32x2 v) {
    const f32x2 av = __builtin_elementwise_abs(v), d = av * 0.2316418882f + 1.0f;
    f32x2 t; t.x = __builtin_amdgcn_rcpf(d.x); t.y = __builtin_amdgcn_rcpf(d.y);
    f32x2 q = t * 0.5307027145f + (-0.7265760135f); q = q * t + 0.7107068705f; q = q * t + (-0.142248368f); q = q * t + 0.127414796f; q = q * t;
    const f32x2 s = (v * v) * (-0.72134752044f);
    f32x2 e; e.x = __builtin_amdgcn_exp2f(s.x); e.y = __builtin_amdgcn_exp2f(s.y);
    const f32x2 m = v * (q * e), r = v - m;
    f32x2 o; o.x = v.x < 0.f ? m.x : r.x; o.y = v.y < 0.f ? m.y : r.y; return o;
}

template <int ACT  > struct EpiBf16 {
    static constexpr bool PERM = true, AFTER_DRAIN = false; static_assert(ACT == 0 || ACT == 1, "EpiBf16: ACT is 0 (none) or 1 (gelu_pk)");
    bf16_t* O; int ldc; const float* bias; int split_cols; size_t split_stride; float scale0;
    __device__ __forceinline__ void operator()(const f32x4 (&acc)[2][2][4][2], const Unit& u, int wr, int wc, int fr, int fq) const {
        const int row0 = u.pm * BM + wr * 64 + fr; int colt = u.pn * BM; bf16_t* base = O;
        float sc = 1.f; if (split_cols) { const int t = colt / split_cols; base += (size_t)t * split_stride; colt -= t * split_cols; if (t == 0) sc = scale0; }
        const int col0 = colt + wc * 32 + 8 * fq, bcol0 = u.pn * BM + wc * 32 + 8 * fq;
        f32x4 bv[2][2];
#pragma unroll
        for (int bj = 0; bj < 2; ++bj)
#pragma unroll
            for (int n = 0; n < 2; ++n) bv[bj][n] = bias ? *(const f32x4*)(bias + bcol0 + bj * HALF + 4 * n) : (f32x4){0.f, 0.f, 0.f, 0.f};
#pragma unroll
        for (int ai = 0; ai < 2; ++ai)
#pragma unroll
            for (int m = 0; m < 4; ++m) { bf16_t* rowp = base + (size_t)(row0 + ai * HALF + m * 16) * ldc + col0;
#pragma unroll
                for (int bj = 0; bj < 2; ++bj) { f32x4 v0 = acc[ai][bj][m][0] + bv[bj][0], v1 = acc[ai][bj][m][1] + bv[bj][1];
                    if (ACT == 1) { f32x2 a = gelu_pk((f32x2){v0[0], v0[1]}), b = gelu_pk((f32x2){v0[2], v0[3]}), c = gelu_pk((f32x2){v1[0], v1[1]}), d = gelu_pk((f32x2){v1[2], v1[3]});
                        v0 = (f32x4){a.x, a.y, b.x, b.y}; v1 = (f32x4){c.x, c.y, d.x, d.y}; }
                    v0 = v0 * sc; v1 = v1 * sc; u32x4 w; w.x = cvt_pk_bf16(v0[0], v0[1]); w.y = cvt_pk_bf16(v0[2], v0[3]); w.z = cvt_pk_bf16(v1[0], v1[1]); w.w = cvt_pk_bf16(v1[2], v1[3]);
                    *(u32x4*)(rowp + bj * HALF) = w; } }
    }
};

template <class Epi, class Sched, bool ALIGN_EPI = false, bool SP2 = false, bool F8 = false, bool GATHER = false, bool I8 = false>
__device__ __forceinline__ void gemm_phase(PG8_LAS unsigned char* lds, const Gemm g, const Sched& S, const Epi& E, const int tid, const PG8_LAS int* gtab = nullptr) {
    const int wid = __builtin_amdgcn_readfirstlane(tid >> 6), lane = tid & 63, wr = wid >> 2, wc = wid & 3, fr = lane & 15, fq = lane >> 4;
    const int K = g.K, nt = K / BK;
    unsigned voffA[2], voffB[2]; int gR[2]; unsigned gC[2];
#pragma unroll
    for (int i = 0; i < 2; ++i) { int R, C; stage_rc(tid * 16 + i * 8192, R, C); const int Rb = Epi::PERM ? ((R & ~31) + perm32(R & 31)) : R;
        voffA[i] = (unsigned)(R * K + C) * 2u; voffB[i] = (unsigned)(Rb * K + C) * 2u; gR[i] = R; gC[i] = (unsigned)C * 2u; }
    unsigned vC[2][2], vN[2][2];
#define PG8_GOFF(dst, ui_) do { _Pragma("unroll") for (int h_ = 0; h_ < 2; ++h_) _Pragma("unroll") for (int p_ = 0; p_ < 2; ++p_) dst[h_][p_] = (unsigned)gtab[(ui_) * 256 + h_ * HALF + gR[p_]] * (unsigned)(K * 2) + gC[p_]; } while (0)
#define PG8_STAGE_A(bufoff, abase, half, vsel) do { if constexpr (GATHER) { PG8_STAGE(bufoff, abase, vsel[half]); } else { PG8_STAGE(bufoff, (abase) + (half) * hstep, voffA); } } while (0)
    const size_t kstep = (size_t)(BK * 2);
    const size_t hstep = (size_t)HALF * K * 2;
    const size_t tstep = 2 * hstep;
    const unsigned ldsw = (unsigned)wid * 1024u;
    const int aoff = lds_byte(wr * 64 + fr, F8 ? 16 * fq : fq * 8), boff = lds_byte(wc * 32 + fr, F8 ? 16 * fq : fq * 8);
    const int aoff1 = F8 ? lds_byte(wr * 64 + fr, 16 * fq + 8) : aoff + 1024, boff1 = F8 ? lds_byte(wc * 32 + fr, 16 * fq + 8) : boff + 1024;
    unsigned f8scale = 0x7f7f7f7fu; asm volatile("" : "+v"(f8scale));
    unsigned abase0 = (unsigned)(uintptr_t)lds + (unsigned)aoff, abase1 = (unsigned)(uintptr_t)lds + (unsigned)aoff1, bbase0 = (unsigned)(uintptr_t)lds + 4u * HTB + (unsigned)boff, bbase1 = (unsigned)(uintptr_t)lds + 4u * HTB + (unsigned)boff1;
    asm volatile("" : "+v"(abase0), "+v"(abase1), "+v"(bbase0), "+v"(bbase1));
#define PG8_SA(b, h) (((b) * 2 + (h)) * HTB)
#define PG8_SB(b, h) ((4 + (b) * 2 + (h)) * HTB)
#define PG8_STAGE(bufoff, gbase, voff) do { _Pragma("unroll") for (int _i = 0; _i < 2; ++_i) \
        __builtin_amdgcn_global_load_lds((const unsigned*)((const char*)(gbase) + (voff)[_i]), (PG8_LAS unsigned*)(lds + (bufoff) + ldsw + _i * 8192), 16, 0, 0); } while (0)
#define PG8_LDA(dst, b, h) do { _Pragma("unroll") for (int m = 0; m < 4; ++m) _Pragma("unroll") for (int k = 0; k < 2; ++k) dst[m][k] = *(const PG8_LAS bf16x8*)(uintptr_t)((k ? abase1 : abase0) + (unsigned)(PG8_SA(b, h) + m * 2048)); } while (0)
#define PG8_LDB(dst, b, h) do { _Pragma("unroll") for (int n = 0; n < 2; ++n) _Pragma("unroll") for (int k = 0; k < 2; ++k) dst[n][k] = *(const PG8_LAS bf16x8*)(uintptr_t)((k ? bbase1 : bbase0) + (unsigned)(PG8_SA(b, h) + n * 2048)); } while (0)
#define PG8_MMA(ai, bj, At, Bt) do { __builtin_amdgcn_s_setprio(1); _Pragma("unroll") for (int m = 0; m < 4; ++m) _Pragma("unroll") for (int n = 0; n < 2; ++n) { \
        if constexpr (F8) { typedef int v8i_t __attribute__((ext_vector_type(8))); typedef int v4i_t __attribute__((ext_vector_type(4))); \
            const v4i_t b0_ = __builtin_bit_cast(v4i_t, Bt[n][0]), b1_ = __builtin_bit_cast(v4i_t, Bt[n][1]), a0_ = __builtin_bit_cast(v4i_t, At[m][0]), a1_ = __builtin_bit_cast(v4i_t, At[m][1]); \
            const v8i_t bb_ = {b0_[0], b0_[1], b0_[2], b0_[3], b1_[0], b1_[1], b1_[2], b1_[3]}, aa_ = {a0_[0], a0_[1], a0_[2], a0_[3], a1_[0], a1_[1], a1_[2], a1_[3]}; \
              \
            asm volatile("v_mfma_scale_f32_16x16x128_f8f6f4 %0, %1, %2, %0, %3, %3 op_sel_hi:[0,0,0]" : "+v"(acc[ai][bj][m][n]) : "v"(bb_), "v"(aa_), "v"(f8scale)); } \
        else if constexpr (I8) { typedef int v4i_t __attribute__((ext_vector_type(4))); _Pragma("unroll") for (int k = 0; k < 2; ++k) acc[ai][bj][m][n] = __builtin_bit_cast(f32x4, __builtin_amdgcn_mfma_i32_16x16x64_i8(__builtin_bit_cast(v4i_t, Bt[n][k]), __builtin_bit_cast(v4i_t, At[m][k]), __builtin_bit_cast(v4i_t, acc[ai][bj][m][n]), 0, 0, 0)); } \
        else { _Pragma("unroll") for (int k = 0; k < 2; ++k) acc[ai][bj][m][n] = __builtin_amdgcn_mfma_f32_16x16x32_bf16(Bt[n][k], At[m][k], acc[ai][bj][m][n], 0, 0, 0); } } \
        __builtin_amdgcn_s_setprio(0); } while (0)
#define PG8_WAIT_V(n) asm volatile("s_waitcnt vmcnt(" #n ")" ::: "memory")
#define PG8_WAIT_L(n) asm volatile("s_waitcnt lgkmcnt(" #n ")" ::: "memory")
#define PG8_BAR __builtin_amdgcn_s_barrier()
#define PG8_SCHED __builtin_amdgcn_sched_barrier(0)
    Unit cur, nxt; int ui = 0;
    if (!S.next(0, cur)) return;
    f32x4 acc[2][2][4][2];
#pragma unroll
    for (int a = 0; a < 2; ++a)
#pragma unroll
        for (int b = 0; b < 2; ++b)
#pragma unroll
            for (int m = 0; m < 4; ++m)
#pragma unroll
                for (int n = 0; n < 2; ++n) acc[a][b][m][n] = (f32x4){0.f, 0.f, 0.f, 0.f};
    bf16x8 At[4][2], B0[2][2], B1[2][2];
    const char* cA = (const char*)g.A + (GATHER ? (size_t)0 : (size_t)cur.pm * tstep); const char* cB = (const char*)g.Bt + (size_t)cur.pb * tstep;
    S.a_ready(cur);
    if constexpr (GATHER) { PG8_GOFF(vC, 0); }
    if constexpr (SP2) {
        PG8_STAGE(PG8_SB(0, 0), cB, voffB); PG8_STAGE(PG8_SB(0, 1), cB + hstep, voffB); PG8_STAGE_A(PG8_SA(0, 0), cA, 0, vC); PG8_STAGE_A(PG8_SA(0, 1), cA, 1, vC);
        if (wr == 1) PG8_BAR;
        PG8_WAIT_V(2); PG8_BAR;
        PG8_STAGE(PG8_SB(1, 0), cB + kstep, voffB); PG8_STAGE_A(PG8_SA(1, 0), cA + kstep, 0, vC); PG8_STAGE(PG8_SB(1, 1), cB + hstep + kstep, voffB);
        PG8_WAIT_V(6); PG8_BAR;
    } else {
        PG8_STAGE(PG8_SB(0, 0), cB, voffB); PG8_STAGE_A(PG8_SA(0, 0), cA, 0, vC); PG8_STAGE(PG8_SB(0, 1), cB + hstep, voffB); PG8_STAGE_A(PG8_SA(0, 1), cA, 1, vC);
        if (wr == 1) PG8_BAR;
        PG8_WAIT_V(4); PG8_BAR;
        PG8_STAGE(PG8_SB(1, 0), cB + kstep, voffB); PG8_STAGE_A(PG8_SA(1, 0), cA + kstep, 0, vC); PG8_STAGE(PG8_SB(1, 1), cB + hstep + kstep, voffB);
        PG8_WAIT_V(6); PG8_BAR;
    }
    for (;;) {
        const bool has_next = S.next(ui + 1, nxt);
        const char* nA = (has_next && !GATHER) ? (const char*)g.A + (size_t)nxt.pm * tstep : cA;
        if constexpr (GATHER) { if (has_next) { PG8_GOFF(vN, ui + 1); } else { _Pragma("unroll") for (int h_ = 0; h_ < 2; ++h_) _Pragma("unroll") for (int p_ = 0; p_ < 2; ++p_) vN[h_][p_] = vC[h_][p_]; } }
        const char* nB = has_next ? (const char*)g.Bt + (size_t)nxt.pb * tstep : cB;
#pragma unroll 1
        for (int t = 0; t < nt; t += 2) {
            const bool last = (t == nt - 2);
            const char* a1 = cA + (size_t)(t + 1) * kstep;
            const char* a2 = last ? nA : cA + (size_t)(t + 2) * kstep; const char* b2 = last ? nB : cB + (size_t)(t + 2) * kstep;
            const char* a3 = a2 + kstep; const char* b3 = b2 + kstep;
            unsigned v2[2][2];
            if constexpr (GATHER) { _Pragma("unroll") for (int h_ = 0; h_ < 2; ++h_) _Pragma("unroll") for (int p_ = 0; p_ < 2; ++p_) v2[h_][p_] = last ? vN[h_][p_] : vC[h_][p_]; }
            if (last && has_next) S.a_ready(nxt);
            if constexpr (SP2) {
            PG8_LDB(B0, 0, 0); PG8_LDB(B1, 0, 1); PG8_SCHED; PG8_LDA(At, 0, 0); PG8_STAGE_A(PG8_SA(1, 1), a1, 1, vC);
            PG8_WAIT_V(8); PG8_WAIT_L(0); PG8_BAR; PG8_MMA(0, 0, At, B0); PG8_MMA(0, 1, At, B1); PG8_BAR; PG8_SCHED;
            PG8_LDA(At, 0, 1); PG8_STAGE(PG8_SB(0, 0), b2, voffB); PG8_STAGE(PG8_SB(0, 1), b2 + hstep, voffB); PG8_STAGE_A(PG8_SA(0, 0), a2, 0, v2);
            PG8_WAIT_V(8); PG8_WAIT_L(0); PG8_BAR; PG8_MMA(1, 0, At, B0); PG8_MMA(1, 1, At, B1); PG8_BAR; PG8_SCHED;
            PG8_LDB(B0, 1, 0); PG8_LDB(B1, 1, 1); PG8_SCHED; PG8_LDA(At, 1, 0); PG8_STAGE_A(PG8_SA(0, 1), a2, 1, v2);
            PG8_WAIT_V(8); PG8_WAIT_L(0); PG8_BAR; PG8_MMA(0, 0, At, B0); PG8_MMA(0, 1, At, B1); PG8_BAR; PG8_SCHED;
            PG8_LDA(At, 1, 1); PG8_STAGE(PG8_SB(1, 0), b3, voffB); PG8_STAGE(PG8_SB(1, 1), b3 + hstep, voffB); PG8_STAGE_A(PG8_SA(1, 0), a3, 0, v2);
            PG8_WAIT_V(8); PG8_WAIT_L(0); PG8_BAR; PG8_MMA(1, 0, At, B0); PG8_MMA(1, 1, At, B1); PG8_BAR; PG8_SCHED;
            } else {
            PG8_LDB(B0, 0, 0); PG8_SCHED; PG8_LDA(At, 0, 0); PG8_STAGE_A(PG8_SA(1, 1), a1, 1, vC);
            PG8_WAIT_L(8); PG8_BAR; PG8_WAIT_L(0); PG8_MMA(0, 0, At, B0); PG8_BAR; PG8_SCHED;
            PG8_LDB(B1, 0, 1); PG8_STAGE(PG8_SB(0, 0), b2, voffB);
            PG8_BAR; PG8_WAIT_L(0); PG8_MMA(0, 1, At, B1); PG8_BAR;
            PG8_LDA(At, 0, 1); PG8_STAGE_A(PG8_SA(0, 0), a2, 0, v2);
            PG8_BAR; PG8_WAIT_L(0); PG8_MMA(1, 0, At, B0); PG8_BAR; PG8_SCHED;
            PG8_STAGE(PG8_SB(0, 1), b2 + hstep, voffB);
            PG8_WAIT_V(6); PG8_BAR; PG8_MMA(1, 1, At, B1); PG8_BAR;
            PG8_LDB(B0, 1, 0); PG8_SCHED; PG8_LDA(At, 1, 0); PG8_STAGE_A(PG8_SA(0, 1), a2, 1, v2);
            PG8_WAIT_L(8); PG8_BAR; PG8_WAIT_L(0); PG8_MMA(0, 0, At, B0); PG8_BAR; PG8_SCHED;
            PG8_LDB(B1, 1, 1); PG8_STAGE(PG8_SB(1, 0), b3, voffB);
            PG8_BAR; PG8_WAIT_L(0); PG8_MMA(0, 1, At, B1); PG8_BAR;
            PG8_LDA(At, 1, 1); PG8_STAGE_A(PG8_SA(1, 0), a3, 0, v2);
            PG8_BAR; PG8_WAIT_L(0); PG8_MMA(1, 0, At, B0); PG8_BAR; PG8_SCHED;
            PG8_STAGE(PG8_SB(1, 1), b3 + hstep, voffB);
            PG8_WAIT_V(6); PG8_BAR; PG8_MMA(1, 1, At, B1); PG8_BAR;
            }
        }
        if constexpr (F8) asm volatile("s_nop 15\n\ts_nop 15" ::: "memory");
        if constexpr (ALIGN_EPI) { if (wr == 0) PG8_BAR; }
        if constexpr (I8) { typedef int v4i_t __attribute__((ext_vector_type(4))); _Pragma("unroll") for (int a = 0; a < 2; ++a) _Pragma("unroll") for (int b = 0; b < 2; ++b) _Pragma("unroll") for (int m = 0; m < 4; ++m) _Pragma("unroll") for (int n = 0; n < 2; ++n) acc[a][b][m][n] = __builtin_convertvector(__builtin_bit_cast(v4i_t, acc[a][b][m][n]), f32x4); }
        if constexpr (!Epi::AFTER_DRAIN) { E(acc, cur, wr, wc, fr, fq); S.done(cur); }
        if (!has_next) break;
#pragma unroll
        for (int a = 0; a < 2; ++a)
#pragma unroll
            for (int b = 0; b < 2; ++b)
#pragma unroll
                for (int m = 0; m < 4; ++m)
#pragma unroll
                    for (int n = 0; n < 2; ++n) acc[a][b][m][n] = (f32x4){0.f, 0.f, 0.f, 0.f};
        cur = nxt; cA = nA; cB = nB; ++ui;
        if constexpr (GATHER) { _Pragma("unroll") for (int h_ = 0; h_ < 2; ++h_) _Pragma("unroll") for (int p_ = 0; p_ < 2; ++p_) vC[h_][p_] = vN[h_][p_]; }
        if constexpr (ALIGN_EPI) { if (wr == 1) PG8_BAR; }
    }
    PG8_WAIT_V(0);
    if constexpr (!ALIGN_EPI) { if (wr == 0) PG8_BAR; }
    PG8_BAR;
    if constexpr (Epi::AFTER_DRAIN) { E.fused(acc, cur, wr, wc, fr, fq, lds, wid, lane); S.done(cur); }
#undef PG8_SA
#undef PG8_SB
#undef PG8_STAGE
#undef PG8_STAGE_A
#undef PG8_GOFF
#undef PG8_LDA
#undef PG8_LDB
#undef PG8_MMA
#undef PG8_WAIT_V
#undef PG8_WAIT_L
#undef PG8_BAR
#undef PG8_SCHED
}
}
#include <hip/hip_bf16.h>
#include <cmath>
namespace attn_body {
using bf16=__hip_bfloat16;
using bf16x8=__attribute__((ext_vector_type(8)))short;
using s16x4=__attribute__((ext_vector_type(4)))short;
using f32x16=__attribute__((ext_vector_type(16)))float;
using u32x4=__attribute__((ext_vector_type(4)))unsigned;
constexpr int D=64;
constexpr int NW=8,QBLK=32,QB=QBLK*NW,KVBLK=64;
constexpr int ATTN_UNIT_ROWS=QB;
__device__ __forceinline__ int crow(int r,int hi){return (r&3)+8*(r>>2)+4*hi;}
#define SBAR() __builtin_amdgcn_sched_barrier(0)
__device__ __forceinline__ void cmask(f32x16&p0,f32x16&p1,int jb,int qrel,int hi){
  const float NEG=-INFINITY; int kb=64*jb+4*hi;
  #pragma unroll
  for(int r=0;r<16;++r){int kv=kb+(r&3)+8*(r>>2); if(kv>qrel)p0[r]=NEG; if(kv+32>qrel)p1[r]=NEG;}
}

constexpr int NSLOT=3, SLOTB=8192;
constexpr int LDS_K=0, LDS_V=NSLOT*SLOTB, LDS_WS=2*NSLOT*SLOTB, LDS_OST=LDS_WS+NW*64*4, LDS_BYTES=LDS_OST+NW*4096;
constexpr float C2=0.125f*1.4426950408889634f;
__device__ __forceinline__ void glds16(const void*gsrc,unsigned lds_dst){unsigned keep;
  asm volatile("s_mov_b32 %0, m0\n\ts_mov_b32 m0, %2\n\ts_nop 0\n\tglobal_load_lds_dwordx4 %1, off\n\ts_mov_b32 m0, %0":"=&s"(keep):"v"(gsrc),"s"(lds_dst):"memory");}
__device__ __forceinline__ float max3f(float a,float b,float c){float r;asm("v_max3_f32 %0, %1, %2, %3":"=v"(r):"v"(a),"v"(b),"v"(c));return r;}
__device__ __forceinline__ float max2f(float a,float b){float r;asm("v_max_f32_e32 %0, %1, %2":"=v"(r):"v"(a),"v"(b));return r;}
__device__ __forceinline__ float fadd_s(float a,float b){float r;asm("v_add_f32_e32 %0, %1, %2":"=v"(r):"v"(a),"v"(b));return r;}
__device__ __forceinline__ float fsub_s(float a,float b){float r;asm("v_sub_f32_e32 %0, %1, %2":"=v"(r):"v"(a),"v"(b));return r;}
typedef float f32x2_t __attribute__((ext_vector_type(2))); typedef __bf16 bf16x2_t __attribute__((ext_vector_type(2)));
__device__ __forceinline__ unsigned cvtpk_s(float lo,float hi){f32x2_t v={lo,hi};bf16x2_t b=__builtin_convertvector(v,bf16x2_t);return __builtin_bit_cast(unsigned,b);}
#define WAIT_BAR(N) asm volatile("s_waitcnt vmcnt(" #N ") lgkmcnt(0)\n\ts_barrier":::"memory")

__device__ __forceinline__ void qkt(f32x16&p0,f32x16&p1,const char*Kslot,const bf16x8*qr,const f32x16&negm,int r32,int hi){
  const char*kb=Kslot+hi*1024+r32*16;
  #pragma unroll
  for(int d0=0;d0<4;++d0){
    const bf16x8 b0=*reinterpret_cast<const bf16x8*>(kb+d0*2048);
    const bf16x8 b1=*reinterpret_cast<const bf16x8*>(kb+d0*2048+512);
    if(d0==0){p0=__builtin_amdgcn_mfma_f32_32x32x16_bf16(b0,qr[0],negm,0,0,0);p1=__builtin_amdgcn_mfma_f32_32x32x16_bf16(b1,qr[0],negm,0,0,0);}
    else{p0=__builtin_amdgcn_mfma_f32_32x32x16_bf16(b0,qr[d0],p0,0,0,0);p1=__builtin_amdgcn_mfma_f32_32x32x16_bf16(b1,qr[d0],p1,0,0,0);}}
}
typedef __attribute__((address_space(3))) const char* lds_cptr;
typedef short v4i16_t __attribute__((ext_vector_type(4)));
__device__ __forceinline__ void kload8(bf16x8*kf,lds_cptr kp){
  kf[0]=*(const __attribute__((address_space(3))) bf16x8*)(kp);      kf[1]=*(const __attribute__((address_space(3))) bf16x8*)(kp+512);
  kf[2]=*(const __attribute__((address_space(3))) bf16x8*)(kp+2048); kf[3]=*(const __attribute__((address_space(3))) bf16x8*)(kp+2560);
  kf[4]=*(const __attribute__((address_space(3))) bf16x8*)(kp+4096); kf[5]=*(const __attribute__((address_space(3))) bf16x8*)(kp+4608);
  kf[6]=*(const __attribute__((address_space(3))) bf16x8*)(kp+6144); kf[7]=*(const __attribute__((address_space(3))) bf16x8*)(kp+6656);
}
__device__ __forceinline__ void kload2(bf16x8*kf,lds_cptr kp,int j){ kf[2*j]=*(const __attribute__((address_space(3))) bf16x8*)(kp+j*2048); kf[2*j+1]=*(const __attribute__((address_space(3))) bf16x8*)(kp+j*2048+512); }
__device__ __forceinline__ s16x4 vtr(lds_cptr p){ return __builtin_bit_cast(s16x4,__builtin_amdgcn_ds_read_tr16_b64_v4i16((__attribute__((address_space(3))) v4i16_t*)p)); }
__device__ __forceinline__ float rowmax(const f32x16&p0,const f32x16&p1){
  float a=max3f(p0[0],p0[1],p1[0]),b=max3f(p0[2],p0[3],p1[1]);a=max3f(a,p1[2],p1[3]);
  #pragma unroll
  for(int r=4;r<16;r+=4){a=max3f(a,p0[r],p0[r+1]);b=max3f(b,p0[r+2],p0[r+3]);a=max3f(a,p1[r],p1[r+1]);b=max3f(b,p1[r+2],p1[r+3]);}
  const float m=max2f(a,b);
  auto rr=__builtin_amdgcn_permlane32_swap(__float_as_uint(m),__float_as_uint(m),false,false);
  return max2f(__uint_as_float(rr[0]),__uint_as_float(rr[1]));
}
__device__ __forceinline__ void pv(f32x16*o,int vb,bf16x8 pa0,bf16x8 pa1,bf16x8 pa2,bf16x8 pa3){
  #pragma unroll
  for(int d0=0;d0<2;++d0){s16x4 lo[4],hi[4];
    #pragma unroll
    for(int ks=0;ks<4;++ks){
      asm volatile("ds_read_b64_tr_b16 %0,%1 offset:%c2":"=&v"(lo[ks]):"v"(vb),"i"(d0*4096+ks*1024):"memory");
      asm volatile("ds_read_b64_tr_b16 %0,%1 offset:%c2":"=&v"(hi[ks]):"v"(vb),"i"(d0*4096+ks*1024+512):"memory");}
    asm volatile("s_waitcnt lgkmcnt(0)":::"memory");SBAR();
    #define PK(k) (bf16x8){lo[k][0],lo[k][1],lo[k][2],lo[k][3],hi[k][0],hi[k][1],hi[k][2],hi[k][3]}
    o[d0]=__builtin_amdgcn_mfma_f32_32x32x16_bf16(pa0,PK(0),o[d0],0,0,0);
    o[d0]=__builtin_amdgcn_mfma_f32_32x32x16_bf16(pa1,PK(1),o[d0],0,0,0);
    o[d0]=__builtin_amdgcn_mfma_f32_32x32x16_bf16(pa2,PK(2),o[d0],0,0,0);
    o[d0]=__builtin_amdgcn_mfma_f32_32x32x16_bf16(pa3,PK(3),o[d0],0,0,0);
    #undef PK
  }
}

#ifndef ATTN_STORE16
#define ATTN_STORE16(p,v) (*(u32x4*)(p)=(v))
#endif
template<int THRL> __device__ __forceinline__ void attn_unit(const bf16*Qu,const bf16*__restrict__ Kh,const bf16*__restrict__ Vh,bf16*Ou,const int QP,const int KP,const int OP,const int NT,char*shm,const int tid){
  const int lane=tid&63,r32=lane&31,hi=lane>>5; const int wid=__builtin_amdgcn_readfirstlane(tid>>6);
  const bf16*Qw=Qu+(long)(wid*QBLK)*QP;
  const unsigned lds0=(unsigned)(uintptr_t)shm;
  float*wsf=(float*)(shm+LDS_WS)+wid*64;
  const bf16*ksrc=Kh+(long)lane*KP+wid*8;
  const bf16*vsrc=Vh+(long)(16*(wid&3)+(lane>>2))*KP+(wid>>2)*32+(lane&3)*8;
  const unsigned kdst=lds0+LDS_K+wid*1024, vdst=lds0+LDS_V+wid*1024;
  #define DMA_K(t,slot) glds16(ksrc+(long)(t)*KVBLK*KP,(unsigned)__builtin_amdgcn_readfirstlane(kdst+(slot)))
  #define DMA_V(t,slot) glds16(vsrc+(long)(t)*KVBLK*KP,(unsigned)__builtin_amdgcn_readfirstlane(vdst+(slot)))
  const int vb0=(int)(lds0+LDS_V)+((lane>>4)&1)*32+(lane&3)*8+(4*hi+((lane&15)>>2))*64;
  const char*Kbase=shm+LDS_K; bf16x8 kf[8];
  const lds_cptr shm3=(lds_cptr)shm; const lds_cptr kp0=shm3+LDS_K+hi*1024+r32*16; const lds_cptr vp0=shm3+LDS_V+((lane>>4)&1)*32+(lane&3)*8+(4*hi+((lane&15)>>2))*64;
  DMA_K(0,0);DMA_V(0,0);DMA_K(1,SLOTB);
  bf16x8 qr[4];
  #pragma unroll
  for(int d0=0;d0<4;++d0)qr[d0]=*reinterpret_cast<const bf16x8*>(&Qw[(long)r32*QP+d0*16+hi*8]);
  float mhat=0.f,l_reg=0.f;f32x16 o[2];o[0]=f32x16{};o[1]=f32x16{};f32x16 negm=f32x16{};asm volatile("":"+v"(negm));
  #define CMASK(P0,P1,t) do{}while(0)
  bool resc=false;
  #define START(P0,P1) do{ const float rm=rowmax(P0,P1); resc=false; \
    { const float dl=rm; mhat=fadd_s(mhat,dl); \
      _Pragma("unroll") for(int r=0;r<16;++r){P0[r]=fsub_s(P0[r],dl);P1[r]=fsub_s(P1[r],dl);} \
      _Pragma("unroll") for(int r=0;r<16;++r)negm[r]=-mhat; asm volatile("":"+v"(negm)); } \
    _Pragma("unroll") for(int r=0;r<16;++r)P0[r]=__builtin_amdgcn_exp2f(P0[r]); }while(0)
  #define RESC() do{ if(resc){ asm volatile("s_waitcnt lgkmcnt(0)":::"memory"); \
      _Pragma("unroll") for(int d_=0;d_<2;++d_) _Pragma("unroll") for(int r=0;r<16;++r)o[d_][r]*=wsf[crow(r,hi)]; } }while(0)
  f32x16 pA0,pA1,pB0,pB1;
  int sl_prev=0,sl_cur=0,sl_next=SLOTB;
  #define ROT() do{sl_prev=sl_cur;sl_cur=sl_next;sl_next=(sl_next==(NSLOT-1)*SLOTB)?0:sl_next+SLOTB;}while(0)
  DMA_K(2,2*SLOTB);
  WAIT_BAR(3);
  qkt(pA0,pA1,Kbase,qr,negm,r32,hi);asm volatile("s_nop 15\n\ts_nop 7":"+v"(pA0),"+v"(pA1));CMASK(pA0,pA1,0);
  START(pA0,pA1);
  _Pragma("unroll") for(int r=0;r<16;++r)pA1[r]=__builtin_amdgcn_exp2f(pA1[r]);
  WAIT_BAR(0);
  DMA_K(3,0);DMA_V(1,SLOTB);
  ROT();
  kload8(kf,kp0+sl_cur);
  WAIT_BAR(2);
  s16x4 vlo[8],vhi[8]; u32x4 pw0,pw1,pw2,pw3;
  #define PKW(P,B) cvtpk_s(P[B],P[B+1])
  #define PAF(k) __builtin_bit_cast(bf16x8,pw##k)
  #define VFR(i) (bf16x8){vlo[i][0],vlo[i][1],vlo[i][2],vlo[i][3],vhi[i][0],vhi[i][1],vhi[i][2],vhi[i][3]}
  #define PIN(x) asm volatile("":"+v"(x))
  #define MX3(a,b,c) __builtin_fmaxf(__builtin_fmaxf((a),(b)),(c))
  #define GAPA(MF,A0,A1,A2,A3,W0,W1,PW) do{ MF; sacc+=A0; sacc+=A1; sacc+=A2; sacc+=A3; PIN(sacc); W0; W1; PIN(PW); SBAR(); }while(0)
  #define EX(v) __builtin_amdgcn_exp2f(v)
  #define GAPB(MF,X,B) do{ MF; X[B]=EX(X[B]); X[B+1]=EX(X[B+1]); X[B+2]=EX(X[B+2]); X[B+3]=EX(X[B+3]); PIN(X); SBAR(); }while(0)
  #define VRD(i) do{ vlo[i]=vtr(vp_+(((i)>>2)*4096+((i)&3)*1024)); vhi[i]=vtr(vp_+(((i)>>2)*4096+((i)&3)*1024+512)); }while(0)
  #define KRD(G,j) do{ if(G){ kload2(kf,kp0+sl_next,j); SBAR(); } }while(0)
  #define STEP(C0,C1,P0,P1,t,GK,GV,GL) do{ SBAR(); \
    const lds_cptr vp_=vp0+sl_prev; \
    VRD(0); SBAR(); float sacc=(P0[0]+P0[1]); \
    GAPA(C0=__builtin_amdgcn_mfma_f32_32x32x16_bf16(kf[0],qr[0],negm,0,0,0), P0[2],P0[3],P0[4],P0[5],     pw0[0]=PKW(P0,0), pw0[1]=PKW(P0,2), pw0); \
    VRD(4); SBAR(); GAPA(C1=__builtin_amdgcn_mfma_f32_32x32x16_bf16(kf[1],qr[0],negm,0,0,0), P0[6],P0[7],P0[8],P0[9],     pw0[2]=PKW(P0,4), pw0[3]=PKW(P0,6), pw0); \
    VRD(1); SBAR(); GAPA(C0=__builtin_amdgcn_mfma_f32_32x32x16_bf16(kf[2],qr[1],C0,0,0,0),   P0[10],P0[11],P0[12],P0[13], pw1[0]=PKW(P0,8), pw1[1]=PKW(P0,10), pw1); \
    VRD(5); SBAR(); GAPA(C1=__builtin_amdgcn_mfma_f32_32x32x16_bf16(kf[3],qr[1],C1,0,0,0),   P0[14],P0[15],P1[0],P1[1],   pw1[2]=PKW(P0,12),pw1[3]=PKW(P0,14), pw1); \
    VRD(2); SBAR(); GAPA(C0=__builtin_amdgcn_mfma_f32_32x32x16_bf16(kf[4],qr[2],C0,0,0,0),   P1[2],P1[3],P1[4],P1[5],     pw2[0]=PKW(P1,0), pw2[1]=PKW(P1,2), pw2); \
    VRD(6); SBAR(); GAPA(C1=__builtin_amdgcn_mfma_f32_32x32x16_bf16(kf[5],qr[2],C1,0,0,0),   P1[6],P1[7],P1[8],P1[9],     pw2[2]=PKW(P1,4), pw2[3]=PKW(P1,6), pw2); \
    VRD(3); SBAR(); GAPA(C0=__builtin_amdgcn_mfma_f32_32x32x16_bf16(kf[6],qr[3],C0,0,0,0),   P1[10],P1[11],P1[12],P1[13], pw3[0]=PKW(P1,8), pw3[1]=PKW(P1,10), pw3); \
    VRD(7); SBAR(); GAPA(C1=__builtin_amdgcn_mfma_f32_32x32x16_bf16(kf[7],qr[3],C1,0,0,0),   P1[14],P1[15],0.f,0.f,       pw3[2]=PKW(P1,12),pw3[3]=PKW(P1,14), pw3); \
    l_reg+=sacc; \
    if(GK){DMA_K((t)+3,sl_cur);} if(GV){DMA_V((t)+1,sl_next);} \
    CMASK(C0,C1,t); \
    { float a=MX3(C0[0],C0[1],C1[0]),b=MX3(C0[2],C0[3],C1[1]); a=MX3(a,C1[2],C1[3]); \
      _Pragma("unroll") for(int r=4;r<16;r+=4){a=MX3(a,C0[r],C0[r+1]);b=MX3(b,C0[r+2],C0[r+3]);a=MX3(a,C1[r],C1[r+1]);b=MX3(b,C1[r+2],C1[r+3]);} \
      float rm=__builtin_fmaxf(a,b); { auto rr=__builtin_amdgcn_permlane32_swap(__float_as_uint(rm),__float_as_uint(rm),false,false); rm=__builtin_fmaxf(__uint_as_float(rr[0]),__uint_as_float(rr[1])); } \
      resc=false; \
      if(__builtin_expect(__any(rm>(float)THRL),0)){ const float dl=__builtin_fmaxf(rm,0.f); mhat+=dl; \
        _Pragma("unroll") for(int r=0;r<16;++r){C0[r]-=dl;C1[r]-=dl;} \
        _Pragma("unroll") for(int r=0;r<16;++r)negm[r]=-mhat; asm volatile("":"+v"(negm)); \
        const float f=__builtin_amdgcn_exp2f(-dl); l_reg*=f; if(hi==0)wsf[r32]=f; resc=true; } } \
    SBAR(); \
    GAPB(o[0]=__builtin_amdgcn_mfma_f32_32x32x16_bf16(PAF(0),VFR(0),o[0],0,0,0), C0,0); \
    GAPB(o[1]=__builtin_amdgcn_mfma_f32_32x32x16_bf16(PAF(0),VFR(4),o[1],0,0,0), C0,4); \
    KRD(GL,0); GAPB(o[0]=__builtin_amdgcn_mfma_f32_32x32x16_bf16(PAF(1),VFR(1),o[0],0,0,0), C0,8); \
    KRD(GL,1); GAPB(o[1]=__builtin_amdgcn_mfma_f32_32x32x16_bf16(PAF(1),VFR(5),o[1],0,0,0), C0,12); \
    KRD(GL,2); GAPB(o[0]=__builtin_amdgcn_mfma_f32_32x32x16_bf16(PAF(2),VFR(2),o[0],0,0,0), C1,0); \
    KRD(GL,3); GAPB(o[1]=__builtin_amdgcn_mfma_f32_32x32x16_bf16(PAF(2),VFR(6),o[1],0,0,0), C1,4); \
    GAPB(o[0]=__builtin_amdgcn_mfma_f32_32x32x16_bf16(PAF(3),VFR(3),o[0],0,0,0), C1,8); \
    GAPB(o[1]=__builtin_amdgcn_mfma_f32_32x32x16_bf16(PAF(3),VFR(7),o[1],0,0,0), C1,12); \
    }while(0)
  int t=1;
  #undef CMASK
  #define CMASK(P0,P1,t) do{}while(0)
  for(;t+5<NT;t+=2){
    STEP(pB0,pB1,pA0,pA1,t,true,true,true);     WAIT_BAR(2); RESC(); ROT();
    STEP(pA0,pA1,pB0,pB1,t+1,true,true,true);   WAIT_BAR(2); RESC(); ROT();
  }
  #undef CMASK
  #define CMASK(P0,P1,t) do{}while(0)
  #define ENDW(tt) do{ if((tt)+3<NT){WAIT_BAR(2);} else if((tt)+2<NT){WAIT_BAR(1);} else {WAIT_BAR(0);} }while(0)
  for(;t+1<NT;t+=2){
    STEP(pB0,pB1,pA0,pA1,t,(t+3<NT),(t+1<NT),(t+1<NT));       ENDW(t);   RESC(); ROT();
    STEP(pA0,pA1,pB0,pB1,t+1,(t+4<NT),(t+2<NT),(t+2<NT));     ENDW(t+1); RESC(); ROT();
  }
  STEP(pB0,pB1,pA0,pA1,NT-1,false,false,false); RESC();
  { float sacc=pB0[0]+pB0[1]; _Pragma("unroll") for(int r=2;r<16;++r)sacc+=pB0[r]; _Pragma("unroll") for(int r=0;r<16;++r)sacc+=pB1[r]; l_reg+=sacc;
    pw0=(u32x4){PKW(pB0,0),PKW(pB0,2),PKW(pB0,4),PKW(pB0,6)};pw1=(u32x4){PKW(pB0,8),PKW(pB0,10),PKW(pB0,12),PKW(pB0,14)};pw2=(u32x4){PKW(pB1,0),PKW(pB1,2),PKW(pB1,4),PKW(pB1,6)};pw3=(u32x4){PKW(pB1,8),PKW(pB1,10),PKW(pB1,12),PKW(pB1,14)};
    SBAR(); pv(o,vb0+sl_cur,PAF(0),PAF(1),PAF(2),PAF(3)); }
  #undef PKW
  #undef PAF
  #undef VFR
  #undef PIN
  #undef MX3
  #undef GAPA
  #undef GAPB
  #undef EX
  #undef VRD
  #undef KRD
  #undef STEP
  #undef ENDW
  {auto rr=__builtin_amdgcn_permlane32_swap(__float_as_uint(l_reg),__float_as_uint(l_reg),false,false);l_reg=__uint_as_float(rr[0])+__uint_as_float(rr[1]);}
  if(hi==0)wsf[32+r32]=l_reg;asm volatile("s_waitcnt lgkmcnt(0)":::"memory");
  float rli[16];
  #pragma unroll
  for(int r=0;r<16;++r)rli[r]=__builtin_amdgcn_rcpf(wsf[32+crow(r,hi)]);
  bf16*Ow=Ou+(long)(wid*QBLK)*OP;
  { bf16*stg=(bf16*)(shm+LDS_OST)+wid*2048;
    #pragma unroll
    for(int r=0;r<16;++r){const int orow=crow(r,hi);
      #pragma unroll
      for(int d0=0;d0<2;++d0)stg[orow*64+d0*32+r32]=__float2bfloat16(o[d0][r]*rli[r]);}
    asm volatile("s_waitcnt lgkmcnt(0)":::"memory");
    #pragma unroll
    for(int i=0;i<4;++i){const int row=i*8+(lane>>3),ch=lane&7; const u32x4 v=*(const u32x4*)(stg+row*64+ch*8); ATTN_STORE16(Ow+(long)row*OP+ch*8,v);} }
  asm volatile("s_waitcnt lgkmcnt(0)\n\ts_barrier":::"memory");
  #undef DMA_K
  #undef DMA_V
  #undef CMASK
  #undef START
  #undef RESC
  #undef ROT
}
constexpr int ATTN_LDS_BYTES=LDS_BYTES;
#undef SBAR
#undef WAIT_BAR
}
#define GAS __attribute__((address_space(1)))
#define LAS __attribute__((address_space(3)))
typedef unsigned short bf16;
typedef unsigned v4u __attribute__((ext_vector_type(4)));
typedef float f32x4 __attribute__((ext_vector_type(4)));
typedef short bf16x8 __attribute__((ext_vector_type(8)));
typedef GAS unsigned gu32;
typedef GAS unsigned long long gu64;
#define RLX_AGENT __ATOMIC_RELAXED, __HIP_MEMORY_SCOPE_AGENT
#define LDS_WAIT() asm volatile("s_waitcnt lgkmcnt(0)" ::: "memory")
#define VM_WAIT() asm volatile("s_waitcnt vmcnt(0)" ::: "memory")
__device__ __forceinline__ unsigned long long rt() { return __builtin_amdgcn_s_memrealtime(); }
__device__ __forceinline__ unsigned f2bf(float f) { unsigned u = __builtin_bit_cast(unsigned, f); return (u + 0x7fffu + ((u >> 16) & 1u)) >> 16; }
__device__ __forceinline__ unsigned pk2(float lo, float hi) { return f2bf(lo) | (f2bf(hi) << 16); }

#define XB_TMO      128
#define XB_XCNT(j)  (256  + 64 * (j))
#define XB_XSUB(j)  (1280 + 64 * (j))
#define XB_XGEN(j)  (2304 + 64 * (j))
#define XB_TOP      3328
#define XB_TOPGEN   3392
#define XCD_BAR_WORDS 3456
#define XB_SPIN_CAP (1u << 18)

__device__ __forceinline__ unsigned xb_ld(unsigned* p)              { return __hip_atomic_load(p, __ATOMIC_RELAXED, __HIP_MEMORY_SCOPE_AGENT); }
__device__ __forceinline__ unsigned xb_add(unsigned* p, unsigned v) { return __hip_atomic_fetch_add(p, v, __ATOMIC_RELAXED, __HIP_MEMORY_SCOPE_AGENT); }
__device__ __forceinline__ unsigned xb_xcc_id() { return (unsigned)__builtin_amdgcn_s_getreg((3 << 11) | 20) & 0xFu; }
#define XB_SPIN(cond, bar) do { unsigned _sp = 0; while (cond) { __builtin_amdgcn_s_sleep(1); \
    if ((++_sp & 255u) == 0u) { if (xb_ld(&(bar)[XB_TMO])) break; if (_sp > XB_SPIN_CAP) { atomicAdd(&(bar)[XB_TMO], 1u); break; } } } } while (0)

struct XcdBarrier {
    unsigned* bar; unsigned x;
    volatile LAS unsigned* st;
};

__device__ __forceinline__ XcdBarrier xcd_barrier_post(unsigned* bar, volatile LAS unsigned* st) {
    XcdBarrier b; b.bar = bar; b.x = xb_xcc_id(); b.st = st;
    if (threadIdx.x == 0) (void)xb_add(&bar[XB_XCNT(b.x)], 1u);
    return b;
}
__device__ __forceinline__ void xcd_barrier_complete(unsigned* bar, unsigned x, unsigned& nloc, unsigned& nx) {
    const unsigned G = gridDim.x * gridDim.y * gridDim.z;
    unsigned sum, cnt, mine, sp = 0u;
    for (;;) {
        sum = 0u; cnt = 0u; mine = 0u;
#pragma unroll
        for (unsigned j = 0; j < 16; ++j) { const unsigned c = xb_ld(&bar[XB_XCNT(j)]); sum += c; cnt += (c > 0u) ? 1u : 0u; mine = (j == x) ? c : mine; }
        if (sum == G) break;
        __builtin_amdgcn_s_sleep(1);
        if ((++sp & 255u) == 0u) { if (xb_ld(&bar[XB_TMO])) break; if (sp > XB_SPIN_CAP) { atomicAdd(&bar[XB_TMO], 1u); break; } }
    }
    nloc = mine > 0u ? mine : 1u; nx = cnt > 0u ? cnt : 1u;
}

__device__ __forceinline__ void xcd_barrier(const XcdBarrier& b) {
    asm volatile("s_waitcnt vmcnt(0)" ::: "memory");
    __syncthreads();
    if (threadIdx.x == 0) {
        unsigned* bar = b.bar;
        __builtin_amdgcn_s_waitcnt(0);
        unsigned nloc = b.st[0], nx = b.st[1];
        if (nloc == 0u) { xcd_barrier_complete(bar, b.x, nloc, nx); b.st[0] = nloc; b.st[1] = nx; }
        const unsigned old = xb_add(&bar[XB_XSUB(b.x)], 1u);
        const unsigned gen = old / nloc;
        if (old + 1u == (gen + 1u) * nloc) {
            __builtin_amdgcn_fence(__ATOMIC_RELEASE, "agent");
            asm volatile("s_waitcnt vmcnt(0)" ::: "memory");
            const unsigned og = xb_add(&bar[XB_TOP], 1u);
            const unsigned tg = og / nx;
            if (og + 1u == (tg + 1u) * nx) xb_add(&bar[XB_TOPGEN], 1u);
            else XB_SPIN(xb_ld(&bar[XB_TOPGEN]) == tg, bar);
            __builtin_amdgcn_fence(__ATOMIC_ACQUIRE, "agent");
            xb_add(&bar[XB_XGEN(b.x)], 1u);
            asm volatile("s_waitcnt vmcnt(0)" ::: "memory");
        } else {
            XB_SPIN(xb_ld(&bar[XB_XGEN(b.x)]) == gen, bar);
            __builtin_amdgcn_fence(__ATOMIC_ACQUIRE, "agent");
            asm volatile("s_waitcnt vmcnt(0)" ::: "memory");
        }
    }
    __syncthreads();
}
#ifndef FFT_HD
#define FFT_HD __device__ __forceinline__
#endif
struct __attribute__((aligned(8))) cpx { float x, y; };
FFT_HD cpx cadd(cpx a, cpx b) { return cpx{a.x + b.x, a.y + b.y}; }
FFT_HD cpx csub(cpx a, cpx b) { return cpx{a.x - b.x, a.y - b.y}; }
FFT_HD cpx cmul(cpx a, cpx b) { return cpx{a.x * b.x - a.y * b.y, a.x * b.y + a.y * b.x}; }
template <int SGN> FFT_HD cpx cmuli(cpx d) { return SGN > 0 ? cpx{-d.y, d.x} : cpx{d.y, -d.x}; }
template <int SGN> FFT_HD void dft4(cpx& u0, cpx& u1, cpx& u2, cpx& u3) {
    const cpx a0 = cadd(u0, u2), a1 = csub(u0, u2), b0 = cadd(u1, u3), b1 = cmuli<SGN>(csub(u1, u3));
    u0 = cadd(a0, b0); u2 = csub(a0, b0); u1 = cadd(a1, b1); u3 = csub(a1, b1);
}
template <int SGN> FFT_HD void dft8(cpx (&u)[8]) {
    dft4<SGN>(u[0], u[2], u[4], u[6]); dft4<SGN>(u[1], u[3], u[5], u[7]);
    const float H = 0.70710678118654752f;
    const cpx E0 = u[0], E1 = u[2], E2 = u[4], E3 = u[6];
    const cpx O0 = u[1], O1 = cmul(u[3], cpx{H, SGN * H}), O2 = cmuli<SGN>(u[5]), O3 = cmul(u[7], cpx{-H, SGN * H});
    u[0] = cadd(E0, O0); u[4] = csub(E0, O0); u[1] = cadd(E1, O1); u[5] = csub(E1, O1);
    u[2] = cadd(E2, O2); u[6] = csub(E2, O2); u[3] = cadd(E3, O3); u[7] = csub(E3, O3);
}
template <int SGN> FFT_HD void dft16(cpx (&u)[16]) {
    cpx e[8], o[8];
#pragma unroll
    for (int k = 0; k < 8; ++k) { e[k] = u[2 * k]; o[k] = u[2 * k + 1]; }
    dft8<SGN>(e); dft8<SGN>(o);
    const float C[8] = {1.f, 0.92387953251128674f, 0.70710678118654752f, 0.38268343236508977f, 0.f, -0.38268343236508977f, -0.70710678118654752f, -0.92387953251128674f};
    const float S[8] = {0.f, 0.38268343236508977f, 0.70710678118654752f, 0.92387953251128674f, 1.f, 0.92387953251128674f, 0.70710678118654752f, 0.38268343236508977f};
#pragma unroll
    for (int k = 0; k < 8; ++k) { const cpx t = cmul(o[k], cpx{C[k], SGN * S[k]}); u[k] = cadd(e[k], t); u[k + 8] = csub(e[k], t); }
}
FFT_HD int fpad(int n) { return n + (n >> 4); }
template <class BufPtr> FFT_HD cpx fft_ld(BufPtr buf, int i) { cpx v; v.x = buf[i].x; v.y = buf[i].y; return v; }
template <class BufPtr> FFT_HD void fft_st(BufPtr buf, int i, cpx v) { buf[i].x = v.x; buf[i].y = v.y; }
constexpr int FFT_N = 8192, FFT_BUF_ELEMS = FFT_N + FFT_N / 16;
#if defined(FFT_HOST_TEST)
static inline cpx fft_tw(float frac, int sgn) { const double a = 6.283185307179586476925 * (double)frac; return cpx{(float)cos(a), (float)(sgn * sin(a))}; }
#else
FFT_HD cpx fft_tw(float frac, int sgn) { return cpx{__builtin_amdgcn_cosf(frac), (float)sgn * __builtin_amdgcn_sinf(frac)}; }
#endif
template <int SGN, class BufPtr> FFT_HD void fft_p1_store(int tid, cpx (&u)[16], BufPtr buf) {
    dft16<SGN>(u);
#pragma unroll
    for (int r = 0; r < 16; ++r) fft_st(buf + 17 * tid, r, u[r]);
}
template <int SGN, int P, class BufPtr> FFT_HD void fft_p8_load(int tid, cpx (&u)[16], BufPtr buf) {
#pragma unroll
    for (int hlf = 0; hlf < 2; ++hlf) { const int i = tid + 512 * hlf, k = i & (P - 1);
        const cpx w1 = fft_tw((float)k * (1.0f / (float)(P * 8)), SGN), w2 = cmul(w1, w1), w3 = cmul(w2, w1), w4 = cmul(w2, w2), w5 = cmul(w4, w1), w6 = cmul(w3, w3), w7 = cmul(w4, w3);
        cpx v[8];
#pragma unroll
        for (int r = 0; r < 8; ++r) v[r] = fft_ld(buf + fpad(i), 1088 * r);
        v[1] = cmul(v[1], w1); v[2] = cmul(v[2], w2); v[3] = cmul(v[3], w3); v[4] = cmul(v[4], w4); v[5] = cmul(v[5], w5); v[6] = cmul(v[6], w6); v[7] = cmul(v[7], w7);
        dft8<SGN>(v);
#pragma unroll
        for (int r = 0; r < 8; ++r) u[8 * hlf + r] = v[r]; }
}
template <int P, class BufPtr> FFT_HD void fft_p8_store(int tid, const cpx (&u)[16], BufPtr buf) {
#pragma unroll
    for (int hlf = 0; hlf < 2; ++hlf) { const int i = tid + 512 * hlf, k = i & (P - 1), j = (i - k) * 8 + k;
#pragma unroll
        for (int r = 0; r < 8; ++r) fft_st(buf + fpad(j), r * (P + P / 16), u[8 * hlf + r]); }
}
FFT_HD void fft_regs_to_p1(const cpx (&u)[16], cpx (&v)[16]) {
#pragma unroll
    for (int r = 0; r < 8; ++r) { v[2 * r] = u[r]; v[2 * r + 1] = u[8 + r]; }
}
constexpr int NWAVES = 8;
constexpr int DM = 1024, NB = 4, SEQ = 4096, CTXL = 256, NLAT = NB * SEQ, NCTX = NB * CTXL, NTOK = NLAT + NCTX;
constexpr int DIN = 2304, NEXP = 32, DEPTH = 2, KVLEN = SEQ + CTXL;
constexpr int CQ = 0, CK = 512, CV = 640, CHY = 768, CNQ = 1536, CNK = 1792, CNV = 2048;
constexpr int MAXSORT = 77824;
constexpr float LN_EPS = 1e-6f, DN_ALPHA = 1.41421356237f;
constexpr float C2 = 0.125f * 1.4426950408889634f;
constexpr float W1_SCALE = 64.f, W2_SCALE = 128.f;
constexpr int PH_PER_LAYER = 10;
constexpr int NPHASE = 2 + PH_PER_LAYER * DEPTH;
#ifndef PROBE_MASK
#define PROBE_MASK 0
#endif
#define REPS(bit) for (int rep_ = 0; rep_ < 1 + ((PROBE_MASK >> (bit)) & 1); ++rep_)

constexpr size_t MiB = 1u << 20;
constexpr size_t WS_CTL = 0, CTL_ZERO_BYTES = 1 * MiB;
constexpr size_t WS_WIN = 2 * MiB, WS_WOUT = 12 * MiB, WS_W1 = 16 * MiB, WS_W2 = 272 * MiB, WS_MOD = 400 * MiB;
constexpr size_t WS_FILT = 402 * MiB, WS_FILTC = 418 * MiB, WS_X = 420 * MiB, WS_H = 488 * MiB, WS_P = 522 * MiB, WS_Q = 600 * MiB;
constexpr size_t WS_K = 618 * MiB, WS_V = 623 * MiB, WS_X0 = 628 * MiB, WS_ZT = 638 * MiB, WS_ZTC = 654 * MiB, WS_NQC = 655 * MiB, WS_YMIX = 656 * MiB;
constexpr size_t WS_Y = 690 * MiB, WS_ROUTE = 724 * MiB, WS_AS = 728 * MiB, WS_ACT = 880 * MiB, WS_Y4 = 1032 * MiB, WS_GF = 1168 * MiB, WS_YC = 1200 * MiB, WS_X1 = 1216 * MiB, WS_H8 = 1284 * MiB, WS_END = 1302 * MiB;
constexpr size_t RT_TOPI = 0, RT_GATE = 69632, RT_SLOTPOS = 139264, RT_CNT = 208896, RT_TT = 217088, RT_ROWSLOT = 218112;
static_assert((RT_ROWSLOT + MAXSORT) * 4 <= 4 * MiB, "route region");
constexpr int CW_BAR = 4096, CW_WCMAX = 8192;
constexpr size_t RT_SH = 300000;
static_assert((RT_SH + NTOK) * 4 <= 4 * MiB, "route region");

constexpr int RING_OFF = 0, RING_BYTES = 147456;
constexpr int LDSCTL_OFF = RING_BYTES, LDSCTL_BYTES = 4096, LDS_TT_OFF = LDSCTL_OFF + 1024;
constexpr int LDS_BYTES = RING_BYTES + LDSCTL_BYTES;

__device__ __forceinline__ float bf2f(unsigned short h) { return __uint_as_float(((unsigned)h) << 16); }
__device__ __forceinline__ float bflo(unsigned w) { return __uint_as_float(w << 16); }
__device__ __forceinline__ float bfhi(unsigned w) { return __uint_as_float(w & 0xffff0000u); }
__device__ __forceinline__ unsigned pk4_i8(float a, float b, float c, float d) {
    const int q0 = __float2int_rn(a), q1 = __float2int_rn(b), q2 = __float2int_rn(c), q3 = __float2int_rn(d);
    return (unsigned)(q0 & 255) | ((unsigned)(q1 & 255) << 8) | ((unsigned)(q2 & 255) << 16) | ((unsigned)q3 << 24);
}
__device__ __forceinline__ unsigned pk4_fp8(float a, float b, float c, float d) {
    a = fminf(fmaxf(a, -448.f), 448.f); b = fminf(fmaxf(b, -448.f), 448.f); c = fminf(fmaxf(c, -448.f), 448.f); d = fminf(fmaxf(d, -448.f), 448.f);
    unsigned w = 0u; w = (unsigned)__builtin_amdgcn_cvt_pk_fp8_f32(a, b, (int)w, false); w = (unsigned)__builtin_amdgcn_cvt_pk_fp8_f32(c, d, (int)w, true); return w;
}
__device__ __forceinline__ float wave_sum(float v) {
    v += __builtin_bit_cast(float, __builtin_amdgcn_update_dpp(0, __builtin_bit_cast(int, v), 0xB1, 0xF, 0xF, true));
    v += __builtin_bit_cast(float, __builtin_amdgcn_update_dpp(0, __builtin_bit_cast(int, v), 0x4E, 0xF, 0xF, true));
    v += __builtin_bit_cast(float, __builtin_amdgcn_update_dpp(0, __builtin_bit_cast(int, v), 0x141, 0xF, 0xF, true));
    v += __builtin_bit_cast(float, __builtin_amdgcn_update_dpp(0, __builtin_bit_cast(int, v), 0x140, 0xF, 0xF, true));
    const int vi = __builtin_bit_cast(int, v);
    const float r0 = __builtin_bit_cast(float, __builtin_amdgcn_readlane(vi, 0)), r1 = __builtin_bit_cast(float, __builtin_amdgcn_readlane(vi, 16));
    const float r2 = __builtin_bit_cast(float, __builtin_amdgcn_readlane(vi, 32)), r3 = __builtin_bit_cast(float, __builtin_amdgcn_readlane(vi, 48));
    return (r0 + r1) + (r2 + r3);
}
__device__ __forceinline__ float wave_max(float v) {
    v = fmaxf(v, __builtin_bit_cast(float, __builtin_amdgcn_update_dpp(0, __builtin_bit_cast(int, v), 0xB1, 0xF, 0xF, true)));
    v = fmaxf(v, __builtin_bit_cast(float, __builtin_amdgcn_update_dpp(0, __builtin_bit_cast(int, v), 0x4E, 0xF, 0xF, true)));
    v = fmaxf(v, __builtin_bit_cast(float, __builtin_amdgcn_update_dpp(0, __builtin_bit_cast(int, v), 0x141, 0xF, 0xF, true)));
    v = fmaxf(v, __builtin_bit_cast(float, __builtin_amdgcn_update_dpp(0, __builtin_bit_cast(int, v), 0x140, 0xF, 0xF, true)));
    const int vi = __builtin_bit_cast(int, v);
    const float r0 = __builtin_bit_cast(float, __builtin_amdgcn_readlane(vi, 0)), r1 = __builtin_bit_cast(float, __builtin_amdgcn_readlane(vi, 16));
    const float r2 = __builtin_bit_cast(float, __builtin_amdgcn_readlane(vi, 32)), r3 = __builtin_bit_cast(float, __builtin_amdgcn_readlane(vi, 48));
    return fmaxf(fmaxf(r0, r1), fmaxf(r2, r3));
}

template <int CTRL> __device__ __forceinline__ float rs_fold(float X, float Y, bool keepY) {
    const float A = keepY ? Y : X, B = keepY ? X : Y;
    return A + __builtin_bit_cast(float, __builtin_amdgcn_update_dpp(0, __builtin_bit_cast(int, B), CTRL, 0xF, 0xF, true));
}
__device__ __forceinline__ float rs64(const float (&v)[64], int lane) {
    float z1[32], z2[16], z3[8], z4[4], z5[2];
#pragma unroll
    for (int i = 0; i < 32; ++i) { const auto r = __builtin_amdgcn_permlane32_swap(__float_as_uint(v[i]), __float_as_uint(v[i + 32]), false, false); z1[i] = __uint_as_float(r[0]) + __uint_as_float(r[1]); }
#pragma unroll
    for (int i = 0; i < 16; ++i) { const auto r = __builtin_amdgcn_permlane16_swap(__float_as_uint(z1[i]), __float_as_uint(z1[i + 16]), false, false); z2[i] = __uint_as_float(r[0]) + __uint_as_float(r[1]); }
    const bool b3 = lane & 8, b2 = lane & 4, b1 = lane & 2, b0 = lane & 1;
#pragma unroll
    for (int i = 0; i < 8; ++i) z3[i] = rs_fold<0x140>(z2[i], z2[i + 8], b3);
#pragma unroll
    for (int i = 0; i < 4; ++i) z4[i] = rs_fold<0x141>(z3[i], z3[i + 4], b2);
#pragma unroll
    for (int i = 0; i < 2; ++i) z5[i] = rs_fold<0x4E>(z4[i], z4[i + 2], b1);
    return rs_fold<0xB1>(z5[0], z5[1], b0);
}

struct Frame {
    LAS unsigned char* lds;
    volatile LAS unsigned* MISC;
    gu32* ctl;
    int tid, lane, wave;
    int vcu, G;
    float* out;
    unsigned char* ws;
};
typedef __attribute__((address_space(4))) const char* kargp_t;
__device__ __forceinline__ const float* inp(int i) {
#if defined(__HIP_DEVICE_COMPILE__)
    kargp_t base = (kargp_t)__builtin_amdgcn_kernarg_segment_ptr();
    asm volatile("" : "+s"(base));
    typedef const float* cfp_t;
    return *(__attribute__((address_space(4))) const cfp_t*)(base + 8 * i);
#else
    return nullptr;
#endif
}
#define INP(i) inp(i)
#define IN_X 0
#define IN_C 1
#define IN_CTX 2
#define IN_CCTX 3
#define IN_ADAW 4
#define IN_ADAB 5
#define IN_WIN 6
#define IN_WOUT 7
#define IN_QG 8
#define IN_KG 9
#define IN_HCW 10
#define IN_HCB 11
#define IN_HW1 12
#define IN_HB1 13
#define IN_HFREQ 14
#define IN_HW2 15
#define IN_HB2 16
#define IN_HW3 17
#define IN_HB3 18
#define IN_HD 19
#define IN_RPB 20
#define IN_LN1G 21
#define IN_LN1B 22
#define IN_LN2G 23
#define IN_LN2B 24
#define IN_RW 25
#define IN_RB 26
#define IN_EW1 27
#define IN_EB1 28
#define IN_EW2 29
#define IN_EB2 30

#define WSP(T, off) ((T*)(F.ws + (off)))

__device__ __forceinline__ void p0_transpose_item(const float* W, int K, int N, bf16* WT, int row_off, LAS float* scr, int item, int lane) {
    const int nblk = N / 64, kb = item / nblk, nb = item % nblk, k0 = 64 * kb, n0 = 64 * nb;
    const int n4 = lane & 15, kr = lane >> 4;
    const float* src = W + (size_t)(k0 + kr) * N + n0 + 4 * n4;
    f32x4 v[16];
#pragma unroll
    for (int i = 0; i < 16; ++i) v[i] = __builtin_nontemporal_load((const f32x4*)(src + (size_t)(4 * i) * N));
#pragma unroll
    for (int i = 0; i < 16; ++i) { LAS float* d = scr + (4 * i + kr) * 65 + 4 * n4; d[0] = v[i].x; d[1] = v[i].y; d[2] = v[i].z; d[3] = v[i].w; }
    LDS_WAIT(); asm volatile("" ::: "memory");
    const int c = lane & 7;
#pragma unroll
    for (int j = 0; j < 8; ++j) { const int n = (lane >> 3) + 8 * j; const LAS float* s = scr + (8 * c) * 65 + n;
        v4u o; o.x = pk2(s[0 * 65], s[1 * 65]); o.y = pk2(s[2 * 65], s[3 * 65]); o.z = pk2(s[4 * 65], s[5 * 65]); o.w = pk2(s[6 * 65], s[7 * 65]);
        *(GAS v4u*)(WT + (size_t)(row_off + n0 + n) * K + k0 + 8 * c) = o; }
    LDS_WAIT(); asm volatile("" ::: "memory");
}

__device__ __forceinline__ void p0_transpose_item8(const float* W, int K, int N, unsigned char* WT, int row_off, float scale, LAS float* scr, int item, int lane) {
    const int nblk = N / 64, kb = item / nblk, nb = item % nblk, k0 = 64 * kb, n0 = 64 * nb;
    const int n4 = lane & 15, kr = lane >> 4;
    const float* src = W + (size_t)(k0 + kr) * N + n0 + 4 * n4;
    f32x4 v[16];
#pragma unroll
    for (int i = 0; i < 16; ++i) v[i] = __builtin_nontemporal_load((const f32x4*)(src + (size_t)(4 * i) * N));
#pragma unroll
    for (int i = 0; i < 16; ++i) { LAS float* d = scr + (4 * i + kr) * 65 + 4 * n4; d[0] = v[i].x; d[1] = v[i].y; d[2] = v[i].z; d[3] = v[i].w; }
    LDS_WAIT(); asm volatile("" ::: "memory");
    const int c = lane & 7;
#pragma unroll
    for (int j = 0; j < 8; ++j) { const int n = (lane >> 3) + 8 * j; const LAS float* s = scr + (8 * c) * 65 + n;
        const unsigned lo = pk4_fp8(s[0 * 65] * scale, s[1 * 65] * scale, s[2 * 65] * scale, s[3 * 65] * scale), hi = pk4_fp8(s[4 * 65] * scale, s[5 * 65] * scale, s[6 * 65] * scale, s[7 * 65] * scale);
        *(GAS unsigned long long*)(WT + (size_t)(row_off + n0 + n) * K + k0 + 8 * c) = (unsigned long long)lo | ((unsigned long long)hi << 32); }
    LDS_WAIT(); asm volatile("" ::: "memory");
}

struct XItem { const float* src; unsigned char* dst; int N; float scale; };
__device__ __forceinline__ XItem p0_xitem(Frame& F, const float* ew1, const float* ew2, int it, int lane) {
    constexpr int PER_E1 = 16 * 32, PER_E2 = 16 * 16, PER_L = NEXP * (PER_E1 + PER_E2);
    const int l = it / PER_L; int r = it % PER_L; XItem x;
    const int n4 = lane & 15, kr = lane >> 4, c = lane & 7, nrow = lane >> 3;
    if (r < NEXP * PER_E1) { const int e = r / PER_E1, rr = r % PER_E1, kb = rr / 32, nb = rr % 32, k0 = 64 * kb, n0 = 64 * nb;
        const int drow = n0 < 1024 ? 256 * (n0 / 128) + (n0 % 128) : 256 * ((n0 - 1024) / 128) + 128 + ((n0 - 1024) % 128);
        x.src = ew1 + (size_t)(l * NEXP + e) * DM * 2048 + (size_t)(k0 + kr) * 2048 + n0 + 4 * n4; x.N = 2048; x.scale = W1_SCALE;
        x.dst = WSP(unsigned char, WS_W1) + (size_t)(l * NEXP + e) * 2048 * DM + (size_t)(drow + nrow) * DM + k0 + 8 * c; }
    else { r -= NEXP * PER_E1; const int e = r / PER_E2, rr = r % PER_E2, kb = rr / 16, nb = rr % 16, k0 = 64 * kb, n0 = 64 * nb;
        x.src = ew2 + (size_t)(l * NEXP + e) * DM * DM + (size_t)(k0 + kr) * DM + n0 + 4 * n4; x.N = DM; x.scale = W2_SCALE;
        x.dst = WSP(unsigned char, WS_W2) + (size_t)(l * NEXP + e) * DM * DM + (size_t)(n0 + nrow) * DM + k0 + 8 * c; }
    return x;
}
__device__ __forceinline__ void p0_xload(const XItem& x, f32x4 (&v)[16]) {
#pragma unroll
    for (int i = 0; i < 16; ++i) v[i] = __builtin_nontemporal_load((const f32x4*)(x.src + (size_t)(4 * i) * x.N));
}
__device__ __forceinline__ void p0_xstore(const XItem& x, const f32x4 (&v)[16], LAS float* scr, int lane) {
    const int n4 = lane & 15, kr = lane >> 4, c = lane & 7;
#pragma unroll
    for (int i = 0; i < 16; ++i) { LAS float* d = scr + (4 * i + kr) * 65 + 4 * n4; d[0] = v[i].x; d[1] = v[i].y; d[2] = v[i].z; d[3] = v[i].w; }
    LDS_WAIT(); asm volatile("" ::: "memory");
    const float scale = x.scale;
#pragma unroll
    for (int j = 0; j < 8; ++j) { const LAS float* s = scr + (8 * c) * 65 + (lane >> 3) + 8 * j;
        const unsigned lo = pk4_fp8(s[0 * 65] * scale, s[1 * 65] * scale, s[2 * 65] * scale, s[3 * 65] * scale), hi = pk4_fp8(s[4 * 65] * scale, s[5 * 65] * scale, s[6 * 65] * scale, s[7 * 65] * scale);
        *(GAS unsigned long long*)(x.dst + (size_t)(8 * j) * DM) = (unsigned long long)lo | ((unsigned long long)hi << 32); }
    LDS_WAIT(); asm volatile("" ::: "memory");
}
__device__ __forceinline__ void p0_expert_weights(Frame& F, LAS float* scr, int it_lo, int it_hi) {
    const int gw = F.vcu * NWAVES + F.wave, NGW = F.G * NWAVES, lane = F.lane;
    const float* ew1 = INP(IN_EW1); const float* ew2 = INP(IN_EW2);
    int it = it_lo + gw; if (it >= it_hi) return;
    XItem cur = p0_xitem(F, ew1, ew2, it, lane); f32x4 vc[16]; p0_xload(cur, vc);
    for (;;) { const int nx = it + NGW; const bool more = nx < it_hi;
        XItem nxt = cur; f32x4 vn[16];
        if (more) { nxt = p0_xitem(F, ew1, ew2, nx, lane); p0_xload(nxt, vn); }
        p0_xstore(cur, vc, scr, lane);
        if (!more) break;
        cur = nxt; it = nx;
#pragma unroll
        for (int i = 0; i < 16; ++i) vc[i] = vn[i]; }
}

__device__ __forceinline__ void p0_wmax_item(Frame& F, int it) {
    const int l = it / 288, r = it % 288, nb = r / 8, kc = r % 8, n = nb * 64 + F.lane;
    const float* W = INP(IN_WIN) + (size_t)l * DM * DIN + (size_t)(kc * 128) * DIN + n; float mx = 0.f;
#pragma unroll 16
    for (int k = 0; k < 128; ++k) mx = fmaxf(mx, fabsf(W[(size_t)k * DIN]));
    __hip_atomic_fetch_max((int*)(F.ctl + CW_WCMAX) + l * DIN + n, __float_as_int(mx), __ATOMIC_RELAXED, __HIP_MEMORY_SCOPE_AGENT);
}
__device__ __forceinline__ void p1_win_i8_item(Frame& F, int it, LAS float* scr) {
    const int lane = F.lane, l = it / 576, r = it % 576, kb = r / 36, nb = r % 36, k0 = 64 * kb, n0 = 64 * nb;
    const int n4 = lane & 15, kr = lane >> 4;
    const float* src = INP(IN_WIN) + (size_t)l * DM * DIN + (size_t)(k0 + kr) * DIN + n0 + 4 * n4;
    f32x4 v[16];
#pragma unroll
    for (int i = 0; i < 16; ++i) v[i] = *(const f32x4*)(src + (size_t)(4 * i) * DIN);
#pragma unroll
    for (int i = 0; i < 16; ++i) { LAS float* d = scr + (4 * i + kr) * 65 + 4 * n4; d[0] = v[i].x; d[1] = v[i].y; d[2] = v[i].z; d[3] = v[i].w; }
    LDS_WAIT(); asm volatile("" ::: "memory");
    const int c = lane & 7; unsigned char* WT = WSP(unsigned char, WS_WIN) + (size_t)l * DIN * DM;
#pragma unroll
    for (int j = 0; j < 8; ++j) { const int n = (lane >> 3) + 8 * j; const LAS float* s = scr + (8 * c) * 65 + n;
        const float cm = __int_as_float(__hip_atomic_load((int*)(F.ctl + CW_WCMAX) + l * DIN + n0 + n, __ATOMIC_RELAXED, __HIP_MEMORY_SCOPE_AGENT)), sc = cm > 0.f ? 127.f / cm : 0.f;
        const unsigned lo = pk4_i8(s[0 * 65] * sc, s[1 * 65] * sc, s[2 * 65] * sc, s[3 * 65] * sc), hi = pk4_i8(s[4 * 65] * sc, s[5 * 65] * sc, s[6 * 65] * sc, s[7 * 65] * sc);
        *(GAS unsigned long long*)(WT + (size_t)(n0 + n) * DM + k0 + 8 * c) = (unsigned long long)lo | ((unsigned long long)hi << 32); }
    LDS_WAIT(); asm volatile("" ::: "memory");
}

__device__ __forceinline__ void p0_mod_item(Frame& F, int it) {
    const int l = it / 96, cb = it % 96, col = cb * 64 + F.lane, kbase = F.wave * 128;
    const float* W = INP(IN_ADAW) + (size_t)l * DM * 6144 + (size_t)kbase * 6144 + col;
    const float* c = INP(IN_C) + kbase; const float* cc = INP(IN_CCTX) + kbase;
    float a0 = 0.f, a1 = 0.f, a2 = 0.f, a3 = 0.f, a4 = 0.f;
#pragma unroll 16
    for (int k = 0; k < 128; ++k) {
        const float w = W[(size_t)k * 6144];
        const float c0 = c[k], c1 = c[DM + k], c2 = c[2 * DM + k], c3 = c[3 * DM + k], c4 = cc[k];
        a0 += (c0 / (1.f + __expf(-c0))) * w; a1 += (c1 / (1.f + __expf(-c1))) * w; a2 += (c2 / (1.f + __expf(-c2))) * w;
        a3 += (c3 / (1.f + __expf(-c3))) * w; a4 += (c4 / (1.f + __expf(-c4))) * w;
    }
    LAS float* part = (LAS float*)(F.lds + RING_OFF);
    part[(F.wave * 5 + 0) * 64 + F.lane] = a0; part[(F.wave * 5 + 1) * 64 + F.lane] = a1; part[(F.wave * 5 + 2) * 64 + F.lane] = a2;
    part[(F.wave * 5 + 3) * 64 + F.lane] = a3; part[(F.wave * 5 + 4) * 64 + F.lane] = a4;
    __syncthreads();
    if (F.wave < 5) { float s = INP(IN_ADAB)[l * 6144 + col];
#pragma unroll
        for (int w = 0; w < 8; ++w) s += part[(w * 5 + F.wave) * 64 + F.lane];
        WSP(float, WS_MOD)[(size_t)(l * 5 + F.wave) * 6144 + col] = s; }
    __syncthreads();
}

__device__ __forceinline__ void p0_filter_item(Frame& F, int it) {
    const int lane = F.lane;
    const int l = it / 4352, rr = it % 4352, type = rr >= 4096 ? 1 : 0, t = type ? rr - 4096 : rr, L = type ? 256 : 4096;
    const float tn = (float)t / (float)(L - 1);
    const float w = (6.283185307179586f / (float)L) * (float)t;
    float zv = 0.f;
    if (lane == 0) zv = tn;
    else if (lane <= 16) { const float band = 1e-4f + (float)(lane - 1) * ((15.0f - 1e-4f) / 15.0f); zv = cosf(band * w); }
    else if (lane <= 32) { const float band = 1e-4f + (float)(lane - 17) * ((15.0f - 1e-4f) / 15.0f); zv = -sinf(band * w); }
    const float* w1 = INP(IN_HW1) + l * 33 * 64; const float* w2 = INP(IN_HW2) + l * 64 * 64; const float* w3 = INP(IN_HW3) + l * 64 * 512;
    float a = INP(IN_HB1)[l * 64 + lane];
#pragma unroll
    for (int k = 0; k < 33; ++k) a += __shfl(zv, k) * w1[k * 64 + lane];
    const float h1 = sinf(INP(IN_HFREQ)[l * 128 + lane] * a);
    float a2 = INP(IN_HB2)[l * 64 + lane];
#pragma unroll 16
    for (int k = 0; k < 64; ++k) a2 += __shfl(h1, k) * w2[k * 64 + lane];
    const float h2 = sinf(INP(IN_HFREQ)[l * 128 + 64 + lane] * a2);
    float o[8]; const float* b3p = INP(IN_HB3) + l * 512 + lane;
#pragma unroll
    for (int i = 0; i < 8; ++i) o[i] = b3p[64 * i];
#pragma unroll 8
    for (int k = 0; k < 64; ++k) { const float hk = __shfl(h2, k);
#pragma unroll
        for (int i = 0; i < 8; ++i) o[i] += hk * w3[k * 512 + lane + 64 * i]; }
    float* dst = type ? WSP(float, WS_FILTC) + (size_t)l * 2 * 256 * 256 : WSP(float, WS_FILT) + (size_t)l * 2 * 256 * 4096;
#pragma unroll
    for (int i = 0; i < 8; ++i) { const int c = lane + 64 * i, dir = c >> 8, ch = c & 255;
        const float ad = 3.0701134573253945f + (float)ch * ((15.350567286626973f - 3.0701134573253945f) / 255.0f);
        dst[((size_t)dir * 256 + ch) * L + t] = o[i] * expf(-tn * ad); }
}

__device__ __forceinline__ void ph_prologue(Frame& F) {
    LAS float* scr = (LAS float*)(F.lds + RING_OFF + F.wave * 16640);
    const int gw = F.vcu * NWAVES + F.wave, NGW = F.G * NWAVES;
    constexpr int I_IN = 16 * 36, I_OUT = 16 * 16, I_W1 = 32 * 16 * 32, I_W2 = 32 * 16 * 16, I_L = I_IN + I_OUT + I_W1 + I_W2;
    for (int it = F.vcu; it < 192; it += F.G) p0_mod_item(F, it);
    for (int it = gw; it < 2 * 4352; it += NGW) p0_filter_item(F, it);
    for (int it = gw; it < 2 * 288; it += NGW) p0_wmax_item(F, it);
    for (int it = gw; it < 2 * I_OUT; it += NGW) p0_transpose_item(INP(IN_WOUT) + (size_t)(it / I_OUT) * DM * DM, DM, DM, WSP(bf16, WS_WOUT) + (size_t)(it / I_OUT) * DM * DM, 0, scr, it % I_OUT, F.lane);
    p0_expert_weights(F, scr, 0, 2 * NEXP * (16 * 32 + 16 * 16));
}

__device__ __forceinline__ void row_stats(const f32x4 (&v)[4], float& mean, float& rstd) {
    float s = 0.f;
#pragma unroll
    for (int j = 0; j < 4; ++j) s += (v[j].x + v[j].y) + (v[j].z + v[j].w);
    mean = wave_sum(s) * (1.f / DM); float s2 = 0.f;
#pragma unroll
    for (int j = 0; j < 4; ++j) { const f32x4 d = v[j] - mean; s2 += (d.x * d.x + d.y * d.y) + (d.z * d.z + d.w * d.w); }
    rstd = 1.f / sqrtf(wave_sum(s2) * (1.f / DM) + LN_EPS);
}
__device__ __forceinline__ const float* modp(Frame& F, int l, int bsel, int which) { return WSP(float, WS_MOD) + ((size_t)(l * 5 + bsel) * 6 + which) * DM; }
__device__ __forceinline__ void modulate_store(Frame& F, const f32x4 (&v)[4], const f32x4 (&sh)[4], const f32x4 (&sc)[4], bf16* orow, f32x4 (&hv)[4]) {
    float mean, rstd; row_stats(v, mean, rstd);
    GAS unsigned long long* o8 = (GAS unsigned long long*)orow + F.lane;
#pragma unroll
    for (int j = 0; j < 4; ++j) { hv[j] = (v[j] - mean) * rstd * (sc[j] + 1.0f) + sh[j];
        o8[64 * j] = (unsigned long long)pk2(hv[j].x, hv[j].y) | ((unsigned long long)pk2(hv[j].z, hv[j].w) << 32); }
}
__device__ __forceinline__ void modulate_store8(Frame& F, const f32x4 (&v)[4], const f32x4 (&sh)[4], const f32x4 (&sc)[4], unsigned char* orow, f32x4 (&hv)[4]) {
    float mean, rstd; row_stats(v, mean, rstd);
    GAS unsigned* o4 = (GAS unsigned*)orow + F.lane;
#pragma unroll
    for (int j = 0; j < 4; ++j) { hv[j] = (v[j] - mean) * rstd * (sc[j] + 1.0f) + sh[j]; o4[64 * j] = pk4_fp8(hv[j].x, hv[j].y, hv[j].z, hv[j].w); }
}
__device__ __forceinline__ void modulate_store_i8(Frame& F, const f32x4 (&v)[4], const f32x4 (&sh)[4], const f32x4 (&sc)[4], unsigned char* orow, float* srow) {
    float mean, rstd; row_stats(v, mean, rstd); f32x4 hv[4]; float mx = 0.f;
#pragma unroll
    for (int j = 0; j < 4; ++j) { hv[j] = (v[j] - mean) * rstd * (sc[j] + 1.0f) + sh[j]; mx = fmaxf(mx, fmaxf(fmaxf(fabsf(hv[j].x), fabsf(hv[j].y)), fmaxf(fabsf(hv[j].z), fabsf(hv[j].w)))); }
    mx = wave_max(mx); const float q = mx > 0.f ? 127.f / mx : 0.f;
    GAS unsigned* o4 = (GAS unsigned*)orow + F.lane;
#pragma unroll
    for (int j = 0; j < 4; ++j) o4[64 * j] = pk4_i8(hv[j].x * q, hv[j].y * q, hv[j].z * q, hv[j].w * q);
    if (F.lane == 0) *srow = mx * (1.f / 127.f);
}
__device__ __forceinline__ void ldvec(const float* p, int lane, f32x4 (&d)[4]) {
#pragma unroll
    for (int j = 0; j < 4; ++j) d[j] = ((const f32x4*)p)[lane + 64 * j];
}
__device__ __forceinline__ void ph_r0(Frame& F) {
    const int gw = F.vcu * NWAVES + F.wave, NGW = F.G * NWAVES, lane = F.lane;
    const float* xin = INP(IN_X); const float* cin = INP(IN_CTX);
    for (int rA = gw; rA < NTOK; rA += 2 * NGW) {
        f32x4 v[2][4], sh[2][4], sc[2][4];
#pragma unroll
        for (int q = 0; q < 2; ++q) { const int r0 = rA + q * NGW, r = r0 < NTOK ? r0 : rA; const int bsel = r < NLAT ? r / SEQ : 4;
            ldvec(r < NLAT ? xin + (size_t)r * DM : cin + (size_t)(r - NLAT) * DM, lane, v[q]); ldvec(modp(F, 0, bsel, 0), lane, sh[q]); ldvec(modp(F, 0, bsel, 1), lane, sc[q]); }
#pragma unroll
        for (int q = 0; q < 2; ++q) { const int r = rA + q * NGW; if (r < NTOK) modulate_store_i8(F, v[q], sh[q], sc[q], WSP(unsigned char, WS_H) + (size_t)r * DM, WSP(float, WS_ROUTE) + RT_SH + r); }
    }
}

__device__ __forceinline__ void unpack8(const v4u raw, float (&x)[8]) {
    x[0] = bflo(raw.x); x[1] = bfhi(raw.x); x[2] = bflo(raw.y); x[3] = bfhi(raw.y); x[4] = bflo(raw.z); x[5] = bfhi(raw.z); x[6] = bflo(raw.w); x[7] = bfhi(raw.w);
}
__device__ __forceinline__ v4u pack8(const float (&x)[8]) { v4u o; o.x = pk2(x[0], x[1]); o.y = pk2(x[2], x[3]); o.z = pk2(x[4], x[5]); o.w = pk2(x[6], x[7]); return o; }
__device__ __forceinline__ void head_norm_rope(float (&x)[8], const float* gain, int lane, bool rope, const f32x4 (&cs4)[2], const f32x4 (&sn4)[2]) {
    float ss = 0.f;
#pragma unroll
    for (int i = 0; i < 8; ++i) ss += x[i] * x[i];
    ss += __shfl_xor(ss, 1); ss += __shfl_xor(ss, 2); ss += __shfl_xor(ss, 4);
    const float rinv = 1.f / sqrtf(ss * (1.f / 64.f) + LN_EPS);
    const int d0 = (lane & 7) * 8;
#pragma unroll
    for (int i = 0; i < 8; ++i) x[i] = x[i] * rinv * gain[d0 + i];
    const int half = (lane >> 1) & 1;
#pragma unroll
    for (int i = 0; i < 8; ++i) {
        const float pv = __shfl_xor(x[i], 2);
        if (rope) { const float cs = cs4[i >> 2][i & 3], sn = sn4[i >> 2][i & 3]; x[i] = x[i] * cs + (half ? pv : -pv) * sn; }
    }
}
__device__ __forceinline__ void ph_prep(Frame& F, int l) {
    const int gw = F.vcu * NWAVES + F.wave, NGW = F.G * NWAVES, lane = F.lane;
    const bf16* P = WSP(bf16, WS_P);
    const float* qg = INP(IN_QG) + l * 64; const float* kg = INP(IN_KG) + l * 64;
    LAS float* tabc = (LAS float*)(F.lds + RING_OFF + 8 * 16640); LAS float* tabs = tabc + 1024;
    for (int idx = F.tid; idx < 1024; idx += 512) { const float ang = (float)(idx >> 4) * exp2f(-(float)(idx & 15) * (13.287712379549449f / 16.0f)); tabc[idx] = cosf(ang); tabs[idx] = sinf(ang); }
    __syncthreads();
    v4u rq_n = {0u, 0u, 0u, 0u}, rk_n = {0u, 0u, 0u, 0u};
    if (gw < NTOK) { const bf16* prow = P + (size_t)gw * DIN; rq_n = *(const GAS v4u*)(prow + CQ + lane * 8); rk_n = *(const GAS v4u*)(prow + CK + (lane & 31) * 8); }
    for (int r = gw; r < NTOK; r += NGW) {
        const bool lat = r < NLAT; const int b = lat ? r / SEQ : (r - NLAT) / CTXL, t = lat ? r % SEQ : (r - NLAT) % CTXL, gr = t >> 6, gc = t & 63;
        const v4u rq = rq_n, raw = rk_n;
        if (r + NGW < NTOK) { const bf16* pn = P + (size_t)(r + NGW) * DIN; rq_n = *(const GAS v4u*)(pn + CQ + lane * 8); rk_n = *(const GAS v4u*)(pn + CK + (lane & 31) * 8); }
        f32x4 cs4[2], sn4[2];
        { const int pos = ((lane >> 2) & 1) ? gc : gr; const LAS f32x4* pc = (const LAS f32x4*)(tabc + pos * 16 + (lane & 1) * 8); const LAS f32x4* ps = (const LAS f32x4*)(tabs + pos * 16 + (lane & 1) * 8);
          cs4[0] = pc[0]; cs4[1] = pc[1]; sn4[0] = ps[0]; sn4[1] = ps[1]; }
        if (lat || l == 0) {
            float x[8]; unpack8(rq, x);
            head_norm_rope(x, qg, lane, lat, cs4, sn4);
#pragma unroll
            for (int i = 0; i < 8; ++i) x[i] *= C2;
            *(GAS v4u*)(WSP(bf16, WS_Q) + (size_t)r * 512 + lane * 8) = pack8(x);
        }
        {
            float x[8]; unpack8(raw, x);
            head_norm_rope(x, kg, lane, lat, cs4, sn4);
            const size_t krow = (size_t)b * KVLEN + (lat ? t : SEQ + t);
            if (lane < 16) *(GAS v4u*)(WSP(bf16, WS_K) + krow * 128 + lane * 8) = pack8(x);
            else if (lane < 32) *(GAS v4u*)(WSP(bf16, WS_V) + krow * 128 + (lane - 16) * 8) = raw;
        }
    }
    LAS float* tile = (LAS float*)(F.lds + RING_OFF + F.wave * 16640);
    const int nitems = 1024 + (l == 0 ? 64 : 0);
    const float* cw = INP(IN_HCW) + l * 3 * 768; const float* cbias = INP(IN_HCB) + l * 768;
    for (int it = gw; it < nitems; it += NGW) {
        const int type = it >= 1024 ? 1 : 0, ii = type ? it - 1024 : it;
        const int L = type ? CTXL : SEQ, ntb = L / 64;
        const int cb = ii & 3, tb = (ii >> 2) % ntb, b = (ii >> 2) / ntb;
        const int rowbase = type ? NLAT + b * CTXL : b * SEQ, t0 = tb * 64, ch = cb * 64 + lane;
        float w[3][3], bs[3];
#pragma unroll
        for (int g = 0; g < 3; ++g) { bs[g] = cbias[g * 256 + ch];
#pragma unroll
            for (int j = 0; j < 3; ++j) w[j][g] = cw[j * 768 + g * 256 + ch]; }
        float inn[3][18];
#define CONV_LOAD(ck_) do { const int tb0_ = t0 + 16 * (ck_); _Pragma("unroll") for (int g = 0; g < 3; ++g) { const bf16* pg = P + (size_t)(rowbase + tb0_) * DIN + CHY + g * 256 + ch; \
            inn[g][0] = tb0_ > 0 ? bf2f(pg[-(ptrdiff_t)DIN]) : 0.f; _Pragma("unroll") for (int q = 0; q < 16; ++q) inn[g][1 + q] = bf2f(pg[(size_t)q * DIN]); \
            inn[g][17] = (tb0_ + 16 < L) ? bf2f(pg[(size_t)16 * DIN]) : 0.f; } } while (0)
        CONV_LOAD(0);
#pragma unroll 1
        for (int ck = 0; ck < 4; ++ck) { const int tb0 = t0 + 16 * ck; float in[3][18];
#pragma unroll
            for (int g = 0; g < 3; ++g)
#pragma unroll
                for (int q = 0; q < 18; ++q) in[g][q] = inn[g][q];
            if (ck < 3) CONV_LOAD(ck + 1);
#pragma unroll
            for (int q = 0; q < 16; ++q) { float cv[3];
#pragma unroll
                for (int g = 0; g < 3; ++g) cv[g] = in[g][q] * w[0][g] + in[g][q + 1] * w[1][g] + in[g][q + 2] * w[2][g] + bs[g];
                WSP(bf16, WS_X0)[(size_t)(rowbase + tb0 + q) * 256 + ch] = (bf16)f2bf(cv[0]);
                tile[(16 * ck + q) * 65 + lane] = cv[1] * cv[2]; } }
        LDS_WAIT(); asm volatile("" ::: "memory");
        float* zt = type ? WSP(float, WS_ZTC) + ((size_t)b * 256 + cb * 64) * CTXL + t0 : WSP(float, WS_ZT) + ((size_t)b * 256 + cb * 64) * SEQ + t0;
#pragma unroll 8
        for (int i = 0; i < 64; ++i) zt[(size_t)i * L + lane] = tile[lane * 65 + i];
        LDS_WAIT(); asm volatile("" ::: "memory");
    }
}

typedef float f32x16 __attribute__((ext_vector_type(16)));
__device__ __forceinline__ int crow16(int r, int hi) { return (r & 3) + 8 * (r >> 2) + 4 * hi; }
__device__ __forceinline__ void na_wave_unit(Frame& F, const float* rpb_lh, int b, int h, int qr, int half, LAS unsigned char* wl) {
    const int lane = F.lane, r32 = lane & 31, hi = lane >> 5;
    const bf16* P = WSP(bf16, WS_P);
    LAS unsigned short* Vl = (LAS unsigned short*)wl;
    LAS float* tab = (LAS float*)(wl + 9216 + 512);
    LAS float* sc = (LAS float*)(wl + 12800);
    for (int i = lane; i < 465; i += 64) tab[i] = rpb_lh[i] * 1.4426950408889634f;
    const int qc = 32 * half + r32, rsq = min(max(qr - 4, 0), 56), csq = min(max(qc - 8, 0), 48);
    const int qtok = b * SEQ + qr * 64 + 32 * half;
    bf16x8 qf[4];
#pragma unroll
    for (int s = 0; s < 4; ++s) qf[s] = *(const bf16x8*)(P + (size_t)(qtok + r32) * DIN + CNQ + h * 64 + 16 * s + 8 * hi);
    f32x16 o0, o1;
#pragma unroll
    for (int i = 0; i < 16; ++i) { o0[i] = 0.f; o1[i] = 0.f; }
    float mrun = -INFINITY, lsum = 0.f;
    const size_t koff = (size_t)r32 * DIN + CNK + h * 64 + 8 * hi;
    const size_t voff = (size_t)(lane >> 2) * DIN + CNV + h * 64 + (lane & 3) * 8;
    typedef short v4i16_t __attribute__((ext_vector_type(4)));
    const LAS unsigned char* vtrb = (const LAS unsigned char*)Vl + ((lane >> 4) & 1) * 32 + (lane & 3) * 8 + (4 * hi + ((lane & 15) >> 2)) * 64;
    bf16x8 kn[2][4]; v4u vn[8];
    { const bf16* rb = P + (size_t)(NLAT + b * CTXL) * DIN;
#pragma unroll
      for (int kb = 0; kb < 2; ++kb)
#pragma unroll
          for (int s = 0; s < 4; ++s) kn[kb][s] = *(const bf16x8*)(rb + koff + (size_t)kb * 32 * DIN + 16 * s);
#pragma unroll
      for (int i = 0; i < 8; ++i) vn[i] = *(const GAS v4u*)(rb + voff + (size_t)(16 * (i & 3)) * DIN + 32 * (i >> 2)); }
    for (int t = 0; t < 12; ++t) {
        bf16x8 kc[2][4]; v4u vc[8];
#pragma unroll
        for (int kb = 0; kb < 2; ++kb)
#pragma unroll
            for (int s = 0; s < 4; ++s) kc[kb][s] = kn[kb][s];
#pragma unroll
        for (int i = 0; i < 8; ++i) { vc[i] = vn[i]; *(LAS v4u*)((LAS unsigned char*)Vl + i * 1024 + lane * 16) = vc[i]; }
        if (t + 1 < 12) { const int tn = t + 1; const int krow0 = tn < 4 ? NLAT + b * CTXL + 64 * tn : b * SEQ + (rsq + tn - 4) * 64; const bf16* rb = P + (size_t)krow0 * DIN;
#pragma unroll
            for (int kb = 0; kb < 2; ++kb)
#pragma unroll
                for (int s = 0; s < 4; ++s) kn[kb][s] = *(const bf16x8*)(rb + koff + (size_t)kb * 32 * DIN + 16 * s);
#pragma unroll
            for (int i = 0; i < 8; ++i) vn[i] = *(const GAS v4u*)(rb + voff + (size_t)(16 * (i & 3)) * DIN + 32 * (i >> 2)); }
        f32x16 s0, s1;
#pragma unroll
        for (int i = 0; i < 16; ++i) { s0[i] = 0.f; s1[i] = 0.f; }
#pragma unroll
        for (int s = 0; s < 4; ++s) { s0 = __builtin_amdgcn_mfma_f32_32x32x16_bf16(kc[0][s], qf[s], s0, 0, 0, 0); s1 = __builtin_amdgcn_mfma_f32_32x32x16_bf16(kc[1][s], qf[s], s1, 0, 0, 0); }
        if (t >= 4) { const int kr = rsq + t - 4; const LAS float* br = tab + (kr - qr + 7) * 31 + 15 - qc + 4 * hi; const int d0 = 4 * hi - csq;
#pragma unroll
            for (int i = 0; i < 16; ++i) { const int c = (i & 3) + 8 * (i >> 2);
                s0[i] = ((unsigned)(c + d0) < 16u) ? s0[i] + br[c] : -INFINITY;
                s1[i] = ((unsigned)(c + 32 + d0) < 16u) ? s1[i] + br[c + 32] : -INFINITY; } }
        float mx = fmaxf(s0[0], s1[0]);
#pragma unroll
        for (int i = 1; i < 16; ++i) mx = fmaxf(mx, fmaxf(s0[i], s1[i]));
        mx = fmaxf(mx, __shfl_xor(mx, 32));
        if (__any(mx > mrun)) {
            const float mn = fmaxf(mrun, mx), alpha = __builtin_amdgcn_exp2f(mrun - mn); mrun = mn; lsum *= alpha;
            if (hi == 0) sc[r32] = alpha;
#pragma unroll
            for (int i = 0; i < 16; ++i) { const float a = sc[crow16(i, hi)]; o0[i] *= a; o1[i] *= a; } }
        float psum = 0.f;
#pragma unroll
        for (int i = 0; i < 16; ++i) { s0[i] = __builtin_amdgcn_exp2f(s0[i] - mrun); s1[i] = __builtin_amdgcn_exp2f(s1[i] - mrun); psum += s0[i] + s1[i]; }
        lsum += psum;
#pragma unroll
        for (int ks = 0; ks < 4; ++ks) {
            v4u pw;
            if (ks == 0) { pw.x = pg8::cvt_pk_bf16(s0[0], s0[1]); pw.y = pg8::cvt_pk_bf16(s0[2], s0[3]); pw.z = pg8::cvt_pk_bf16(s0[4], s0[5]); pw.w = pg8::cvt_pk_bf16(s0[6], s0[7]); }
            else if (ks == 1) { pw.x = pg8::cvt_pk_bf16(s0[8], s0[9]); pw.y = pg8::cvt_pk_bf16(s0[10], s0[11]); pw.z = pg8::cvt_pk_bf16(s0[12], s0[13]); pw.w = pg8::cvt_pk_bf16(s0[14], s0[15]); }
            else if (ks == 2) { pw.x = pg8::cvt_pk_bf16(s1[0], s1[1]); pw.y = pg8::cvt_pk_bf16(s1[2], s1[3]); pw.z = pg8::cvt_pk_bf16(s1[4], s1[5]); pw.w = pg8::cvt_pk_bf16(s1[6], s1[7]); }
            else { pw.x = pg8::cvt_pk_bf16(s1[8], s1[9]); pw.y = pg8::cvt_pk_bf16(s1[10], s1[11]); pw.z = pg8::cvt_pk_bf16(s1[12], s1[13]); pw.w = pg8::cvt_pk_bf16(s1[14], s1[15]); }
            const bf16x8 pf = __builtin_bit_cast(bf16x8, pw);
#pragma unroll
            for (int dh = 0; dh < 2; ++dh) { const LAS unsigned char* vp = vtrb + dh * 4096 + ks * 1024;
                const v4i16_t lo = __builtin_amdgcn_ds_read_tr16_b64_v4i16((LAS v4i16_t*)vp), hv_ = __builtin_amdgcn_ds_read_tr16_b64_v4i16((LAS v4i16_t*)(vp + 512));
                const bf16x8 vf = {lo[0], lo[1], lo[2], lo[3], hv_[0], hv_[1], hv_[2], hv_[3]};
                if (dh == 0) o0 = __builtin_amdgcn_mfma_f32_32x32x16_bf16(pf, vf, o0, 0, 0, 0); else o1 = __builtin_amdgcn_mfma_f32_32x32x16_bf16(pf, vf, o1, 0, 0, 0); }
        }
    }
    lsum += __shfl_xor(lsum, 32);
    if (hi == 0) sc[32 + r32] = lsum;
    LAS unsigned short* stg = Vl;
#pragma unroll
    for (int i = 0; i < 16; ++i) { const int q = crow16(i, hi); const float rl = 1.0f / sc[32 + q];
        stg[q * 64 + r32] = (unsigned short)f2bf(o0[i] * rl); stg[q * 64 + 32 + r32] = (unsigned short)f2bf(o1[i] * rl); }
    bf16* Ow = WSP(bf16, WS_YMIX) + (size_t)qtok * DM + 768 + h * 64;
#pragma unroll
    for (int i = 0; i < 4; ++i) { const int row = i * 8 + (lane >> 3), ch = lane & 7; const v4u v = *(const LAS v4u*)(stg + row * 64 + ch * 8); *(GAS v4u*)(Ow + (size_t)row * DM + ch * 8) = v; }
}

constexpr int HY_OFF = 4099, HY_GN = 8196;
__device__ __forceinline__ void hy_item(Frame& F, const float* hd_l, int l, int type, int b, int c) {
    const int tid = F.tid, L = type ? CTXL : SEQ;
    LAS float* G = (LAS float*)(F.lds + RING_OFF); LAS float* Z = G + 8208; LAS float* red = Z + 4096;
    const float* hf = type ? WSP(float, WS_FILTC) + ((size_t)(l * 2 + 0) * 256 + c) * CTXL : WSP(float, WS_FILT) + ((size_t)(l * 2 + 0) * 256 + c) * SEQ;
    const float* hb = type ? WSP(float, WS_FILTC) + ((size_t)(l * 2 + 1) * 256 + c) * CTXL : WSP(float, WS_FILT) + ((size_t)(l * 2 + 1) * 256 + c) * SEQ;
    const float* zt = type ? WSP(float, WS_ZTC) + ((size_t)b * 256 + c) * CTXL : WSP(float, WS_ZT) + ((size_t)b * 256 + c) * SEQ;
    float ssq = 0.f;
    for (int idx = tid; idx < HY_GN; idx += 512) { const int lag = idx - HY_OFF; float v = 0.f;
        if (lag >= 0 && lag < L) v = hf[lag]; else if (lag < 0 && -lag < L) v = hb[-lag];
        G[idx] = v; ssq += v * v; }
    for (int idx = tid; idx < L; idx += 512) Z[idx] = zt[idx];
    ssq = wave_sum(ssq); if (F.lane == 0) red[F.wave] = ssq;
    __syncthreads();
    float tot = 0.f;
#pragma unroll
    for (int i = 0; i < 8; ++i) tot += red[i];
    const float nscale = 1.f / sqrtf(tot + LN_EPS);
    if (tid * 8 < L) {
        const int t0 = tid * 8; float acc[8], w[16];
#pragma unroll
        for (int i = 0; i < 8; ++i) acc[i] = 0.f;
#pragma unroll
        for (int m = 8; m < 15; ++m) w[m] = G[HY_OFF + t0 - 7 + m];
        for (int s0 = 0; s0 < L; s0 += 8) {
            const f32x4 g0 = *(const LAS f32x4*)(G + HY_OFF + t0 - s0 - 7), g1 = *(const LAS f32x4*)(G + HY_OFF + t0 - s0 - 3);
            w[0] = g0.x; w[1] = g0.y; w[2] = g0.z; w[3] = g0.w; w[4] = g1.x; w[5] = g1.y; w[6] = g1.z; w[7] = g1.w;
            const f32x4 z0 = *(const LAS f32x4*)(Z + s0), z1 = *(const LAS f32x4*)(Z + s0 + 4);
            const float zz[8] = {z0.x, z0.y, z0.z, z0.w, z1.x, z1.y, z1.z, z1.w};
#pragma unroll
            for (int i = 0; i < 8; ++i)
#pragma unroll
                for (int j = 0; j < 8; ++j) acc[i] += w[i - j + 7] * zz[j];
#pragma unroll
            for (int m = 14; m >= 8; --m) w[m] = w[m - 8];
        }
        const float dsk = hd_l[c]; const int rowbase = type ? NLAT + b * CTXL : b * SEQ;
#pragma unroll
        for (int i = 0; i < 8; ++i) { const int t = t0 + i; const float y = acc[i] * nscale + Z[t] * dsk;
            const float x0 = bf2f(WSP(bf16, WS_X0)[(size_t)(rowbase + t) * 256 + c]);
            WSP(bf16, WS_YMIX)[(size_t)(rowbase + t) * DM + 512 + c] = (bf16)f2bf(y * x0); }
    }
    __syncthreads();
}

__device__ __forceinline__ void hy_ctx_item(Frame& F, const float* hd_l, int l, int c) {
    const int tid = F.tid; constexpr int L = CTXL;
    LAS float* G = (LAS float*)(F.lds + RING_OFF); LAS float* Z = G + 8208; LAS float* red = Z + 4096;
    const float* hf = WSP(float, WS_FILTC) + ((size_t)(l * 2 + 0) * 256 + c) * CTXL; const float* hb = WSP(float, WS_FILTC) + ((size_t)(l * 2 + 1) * 256 + c) * CTXL;
    float ssq = 0.f;
    for (int idx = HY_OFF - 272 + tid; idx < HY_OFF + 272; idx += 512) { const int lag = idx - HY_OFF; float v = 0.f;
        if (lag >= 0 && lag < L) v = hf[lag]; else if (lag < 0 && -lag < L) v = hb[-lag];
        G[idx] = v; ssq += v * v; }
    for (int idx = tid; idx < 4 * L; idx += 512) Z[idx] = (WSP(float, WS_ZTC) + ((size_t)(idx >> 8) * 256 + c) * CTXL)[idx & 255];
    ssq = wave_sum(ssq); if (F.lane == 0) red[F.wave] = ssq;
    __syncthreads();
    float tot = 0.f;
#pragma unroll
    for (int i = 0; i < 8; ++i) tot += red[i];
    const float nscale = 1.f / sqrtf(tot + LN_EPS);
    if (tid < 128) {
        const int b = tid >> 5, t0 = (tid & 31) * 8; const LAS float* Zb = Z + b * L; float acc[8], w[16];
#pragma unroll
        for (int i = 0; i < 8; ++i) acc[i] = 0.f;
#pragma unroll
        for (int m = 8; m < 15; ++m) w[m] = G[HY_OFF + t0 - 7 + m];
        for (int s0 = 0; s0 < L; s0 += 8) {
            const f32x4 g0 = *(const LAS f32x4*)(G + HY_OFF + t0 - s0 - 7), g1 = *(const LAS f32x4*)(G + HY_OFF + t0 - s0 - 3);
            w[0] = g0.x; w[1] = g0.y; w[2] = g0.z; w[3] = g0.w; w[4] = g1.x; w[5] = g1.y; w[6] = g1.z; w[7] = g1.w;
            const f32x4 z0 = *(const LAS f32x4*)(Zb + s0), z1 = *(const LAS f32x4*)(Zb + s0 + 4);
            const float zz[8] = {z0.x, z0.y, z0.z, z0.w, z1.x, z1.y, z1.z, z1.w};
#pragma unroll
            for (int i = 0; i < 8; ++i)
#pragma unroll
                for (int j = 0; j < 8; ++j) acc[i] += w[i - j + 7] * zz[j];
#pragma unroll
            for (int m = 14; m >= 8; --m) w[m] = w[m - 8];
        }
        const float dsk = hd_l[c]; const int rowbase = NLAT + b * CTXL;
#pragma unroll
        for (int i = 0; i < 8; ++i) { const int t = t0 + i; const float y = acc[i] * nscale + Zb[t] * dsk;
            const float x0 = bf2f(WSP(bf16, WS_X0)[(size_t)(rowbase + t) * 256 + c]);
            WSP(bf16, WS_YMIX)[(size_t)(rowbase + t) * DM + 512 + c] = (bf16)f2bf(y * x0); }
    }
    __syncthreads();
}
#define FFT_SYNC() __syncthreads()
template <class T> __device__ __forceinline__ T* sgpr_ptr(T* p) { asm volatile("" : "+s"(p)); return p; }
template <int SGN> __device__ __forceinline__ void fft_mid_passes(int tid, cpx (&u)[16], LAS cpx* buf) {
    int t1 = tid; asm volatile("" : "+v"(t1)); FFT_SYNC(); fft_p8_load<SGN, 16>(t1, u, buf); FFT_SYNC(); fft_p8_store<16>(t1, u, buf);
    int t2 = tid; asm volatile("" : "+v"(t2)); FFT_SYNC(); fft_p8_load<SGN, 128>(t2, u, buf); FFT_SYNC(); fft_p8_store<128>(t2, u, buf);
    int t3 = tid; asm volatile("" : "+v"(t3)); FFT_SYNC(); fft_p8_load<SGN, 1024>(t3, u, buf);
}
__device__ __forceinline__ void hy_spectrum_item(Frame& F, int l, int c) {
    const int tid = F.tid; LAS cpx* buf = (LAS cpx*)(F.lds + RING_OFF); LAS float* red = (LAS float*)(F.lds + RING_OFF + FFT_BUF_ELEMS * 8);
    const float* hf = WSP(float, WS_FILT) + ((size_t)(l * 2 + 0) * 256 + c) * SEQ; const float* hb = WSP(float, WS_FILT) + ((size_t)(l * 2 + 1) * 256 + c) * SEQ;
    cpx u[16]; float ssq = 0.f;
#pragma unroll
    for (int r = 0; r < 16; ++r) { const int n = tid + 512 * r; float g;
        if (r < 8) g = sgpr_ptr(hf + 512 * r)[tid]; else g = (n == SEQ) ? 0.f : sgpr_ptr(hb + 2 * SEQ - 512 * r)[-tid];
        u[r] = cpx{g, 0.f}; ssq += g * g; }
    ssq = wave_sum(ssq); if (F.lane == 0) red[F.wave] = ssq;
    fft_p1_store<-1>(tid, u, buf);
    fft_mid_passes<-1>(tid, u, buf);
    float tot = 0.f;
#pragma unroll
    for (int i = 0; i < 8; ++i) tot += red[i];
    const float sc = (1.f / sqrtf(tot + LN_EPS)) * (1.f / (float)FFT_N);
    cpx* gf = WSP(cpx, WS_GF) + (size_t)(l * 256 + c) * FFT_N;
#pragma unroll
    for (int hlf = 0; hlf < 2; ++hlf)
#pragma unroll
        for (int r = 0; r < 8; ++r) sgpr_ptr(gf + 512 * hlf + 1024 * r)[tid] = cpx{u[8 * hlf + r].x * sc, u[8 * hlf + r].y * sc};
    FFT_SYNC();
}
__device__ __forceinline__ void hy_fft_item(Frame& F, const float* hd_l, int l, int c, int bp) {
    const int tid = F.tid; LAS cpx* buf = (LAS cpx*)(F.lds + RING_OFF);
    const float* z0 = WSP(float, WS_ZT) + ((size_t)(2 * bp) * 256 + c) * SEQ; const float* z1 = z0 + (size_t)256 * SEQ;
    cpx zin[8], u[16];
#pragma unroll
    for (int m8 = 0; m8 < 8; ++m8) { zin[m8] = cpx{sgpr_ptr(z0 + 512 * m8)[tid], sgpr_ptr(z1 + 512 * m8)[tid]}; u[m8] = zin[m8]; u[8 + m8] = cpx{0.f, 0.f}; }
    fft_p1_store<-1>(tid, u, buf);
    fft_mid_passes<-1>(tid, u, buf);
    const cpx* gf = WSP(cpx, WS_GF) + (size_t)(l * 256 + c) * FFT_N;
#pragma unroll
    for (int hlf = 0; hlf < 2; ++hlf)
#pragma unroll
        for (int r = 0; r < 8; ++r) u[8 * hlf + r] = cmul(u[8 * hlf + r], sgpr_ptr(gf + 512 * hlf + 1024 * r)[tid]);
    cpx v[16]; fft_regs_to_p1(u, v);
    FFT_SYNC();
    fft_p1_store<1>(tid, v, buf);
    fft_mid_passes<1>(tid, v, buf);
    const float dsk = hd_l[c];
    float* y0 = WSP(float, WS_YC) + ((size_t)(2 * bp) * 256 + c) * SEQ; float* y1 = y0 + (size_t)256 * SEQ;
#pragma unroll
    for (int hlf = 0; hlf < 2; ++hlf)
#pragma unroll
        for (int r = 0; r < 4; ++r) { const int m8 = hlf + 2 * r; sgpr_ptr(y0 + 512 * m8)[tid] = v[8 * hlf + r].x + zin[m8].x * dsk; sgpr_ptr(y1 + 512 * m8)[tid] = v[8 * hlf + r].y + zin[m8].y * dsk; }
    FFT_SYNC();
}
__device__ __forceinline__ void ph_hy_post(Frame& F) {
    const int gw = F.vcu * NWAVES + F.wave, NGW = F.G * NWAVES, lane = F.lane;
    LAS float* tile = (LAS float*)(F.lds + RING_OFF + F.wave * 16640);
    for (int it = gw; it < 1024; it += NGW) {
        const int cb = it & 3, tb = (it >> 2) & 63, b = it >> 8, t0 = tb * 64, c0 = cb * 64;
        const float* yc = WSP(float, WS_YC) + ((size_t)b * 256 + c0) * SEQ + t0;
#pragma unroll 1
        for (int ck = 0; ck < 4; ++ck) { float tv[16];
#pragma unroll
            for (int i = 0; i < 16; ++i) tv[i] = yc[(size_t)(16 * ck + i) * SEQ + lane];
#pragma unroll
            for (int i = 0; i < 16; ++i) tile[(16 * ck + i) * 65 + lane] = tv[i]; }
        LDS_WAIT(); asm volatile("" ::: "memory");
        const bf16* x0 = WSP(bf16, WS_X0) + (size_t)(b * SEQ + t0) * 256 + c0 + lane; bf16* ym = WSP(bf16, WS_YMIX) + (size_t)(b * SEQ + t0) * DM + 512 + c0 + lane;
#pragma unroll 1
        for (int ck = 0; ck < 4; ++ck) { float xv[16];
#pragma unroll
            for (int q = 0; q < 16; ++q) xv[q] = bf2f(x0[(size_t)(16 * ck + q) * 256]);
#pragma unroll
            for (int q = 0; q < 16; ++q) ym[(size_t)(16 * ck + q) * DM] = (bf16)f2bf(tile[lane * 65 + 16 * ck + q] * xv[q]); }
        LDS_WAIT(); asm volatile("" ::: "memory");
    }
}

__device__ __forceinline__ void ph_mixers(Frame& F, int l, char* lds_generic) {
    {
        typedef attn_body::bf16 abf;
        const abf* Qb = (const abf*)WSP(bf16, WS_Q); const abf* Kb = (const abf*)WSP(bf16, WS_K); const abf* Vb = (const abf*)WSP(bf16, WS_V);
        const abf* Pb = (const abf*)WSP(bf16, WS_P); abf* Ym = (abf*)WSP(bf16, WS_YMIX);
        const int nunits = 512 + (l == 0 ? 48 : 0);
        REPS(20) for (int u = F.vcu; u < nunits; u += F.G) {
            const abf *Qu, *Kh, *Vh; abf* Ou; int QP, KP, NT;
            if (u < 512) { const int bk = u >> 6, b = bk >> 1, kvh = bk & 1, hq = (u >> 4) & 3, qb = u & 15, head = kvh * 4 + hq;
                Qu = Qb + (size_t)(b * SEQ + qb * 256) * 512 + head * 64; Kh = Kb + (size_t)b * KVLEN * 128 + kvh * 64; Vh = Vb + (size_t)b * KVLEN * 128 + kvh * 64;
                Ou = Ym + (size_t)(b * SEQ + qb * 256) * DM + head * 64; QP = 512; KP = 128; NT = KVLEN / 64; }
            else if (u < 544) { const int j = u - 512, b = j >> 3, head = j & 7, kvh = head >> 2;
                Qu = Qb + (size_t)(NLAT + b * CTXL) * 512 + head * 64; Kh = Kb + ((size_t)b * KVLEN + SEQ) * 128 + kvh * 64; Vh = Vb + ((size_t)b * KVLEN + SEQ) * 128 + kvh * 64;
                Ou = Ym + (size_t)(NLAT + b * CTXL) * DM + head * 64; QP = 512; KP = 128; NT = 4; }
            else { const int j = u - 544, b = j >> 2, h = j & 3;
                Qu = Pb + (size_t)(NLAT + b * CTXL) * DIN + CNQ + h * 64; Kh = Pb + (size_t)(NLAT + b * CTXL) * DIN + CNK + h * 64; Vh = Pb + (size_t)(NLAT + b * CTXL) * DIN + CNV + h * 64;
                Ou = Ym + (size_t)(NLAT + b * CTXL) * DM + 768 + h * 64; QP = DIN; KP = DIN; NT = 4; }
            attn_body::attn_unit<8>(Qu, Kh, Vh, Ou, QP, KP, DM, NT, lds_generic, F.tid);
        }
    }
    __syncthreads();
    { Frame Fn = F; asm volatile("" : "+s"(Fn.ws), "+v"(Fn.tid), "+v"(Fn.lane), "+s"(Fn.wave));
      const int gw = Fn.vcu * NWAVES + Fn.wave, NGW = Fn.G * NWAVES;
      const float* rpb_l = INP(IN_RPB) + (size_t)l * 4 * 15 * 31;
      REPS(21) for (int w = gw; w < 2048; w += NGW) { const int h = (w >> 7) & 3; na_wave_unit(Fn, rpb_l + h * 15 * 31, w >> 9, h, (w >> 1) & 63, w & 1, Fn.lds + RING_OFF + Fn.wave * 16384); } }
    __syncthreads();
    { Frame Fh = F; asm volatile("" : "+s"(Fh.ws), "+v"(Fh.tid), "+v"(Fh.lane), "+s"(Fh.wave));
      const float* hd_l = INP(IN_HD) + l * 256;
      REPS(22) { for (int it = Fh.vcu; it < 512; it += Fh.G) hy_fft_item(Fh, hd_l, l, it >> 1, it & 1);
        if (l == 0) for (int it = Fh.vcu; it < 256; it += Fh.G) hy_ctx_item(Fh, hd_l, l, it); } }
}

__device__ __forceinline__ void ph_r1(Frame& F, int l) {
    const int tid = F.tid, lane = F.lane;
    LAS float* rwT = (LAS float*)(F.lds + RING_OFF);
    volatile LAS unsigned* cntL = F.MISC + 16;
    { const float* rw = INP(IN_RW) + (size_t)l * DM * NEXP;
      for (int i = tid; i < DM * NEXP / 4; i += 512) { const f32x4 v = ((const f32x4*)rw)[i]; const int k = i >> 3, e4 = (i & 7) * 4;
          rwT[(e4 + 0) * DM + k] = v.x; rwT[(e4 + 1) * DM + k] = v.y; rwT[(e4 + 2) * DM + k] = v.z; rwT[(e4 + 3) * DM + k] = v.w; } }
    LAS float* lnl = rwT + DM * NEXP;
    { const float* ln1g = INP(IN_LN1G) + l * DM; const float* ln1b = INP(IN_LN1B) + l * DM; for (int i = tid; i < DM; i += 512) { lnl[i] = ln1g[i]; lnl[DM + i] = ln1b[i]; } }
    if (tid < 32) cntL[tid] = 0u;
    __syncthreads();
    const int gw = F.vcu * NWAVES + F.wave, NGW = F.G * NWAVES, nrows = l == 0 ? NTOK : NLAT;
    const float* rb = INP(IN_RB) + l * NEXP; const float* xin = INP(IN_X); const float* cin = INP(IN_CTX);
    int* topi = WSP(int, WS_ROUTE) + RT_TOPI; float* gate = WSP(float, WS_ROUTE) + RT_GATE; int* slotpos = WSP(int, WS_ROUTE) + RT_SLOTPOS;
    const int myq = lane >> 5, mye = lane & 31; const float mybias = rb[mye];
    for (int rA = gw; rA < nrows; rA += 2 * NGW) {
        f32x4 hv[2][4];
        { f32x4 v[2][4];
#pragma unroll
          for (int q = 0; q < 2; ++q) { const int r0 = rA + q * NGW, r = r0 < nrows ? r0 : rA; const int bsel = r < NLAT ? r / SEQ : 4;
              const float* xsrc = l == 0 ? (r < NLAT ? xin + (size_t)r * DM : cin + (size_t)(r - NLAT) * DM) : WSP(float, WS_X) + (size_t)r * DM;
              const bf16* yrow = WSP(bf16, WS_Y) + (size_t)r * DM; const float* g1 = modp(F, l, bsel, 2);
#pragma unroll
              for (int j = 0; j < 4; ++j) { const f32x4 xv = ((const f32x4*)xsrc)[lane + 64 * j]; const f32x4 gv = ((const f32x4*)g1)[lane + 64 * j];
                  const unsigned long long yw = ((const GAS unsigned long long*)yrow)[lane + 64 * j];
                  const f32x4 yv = {bflo((unsigned)yw), bfhi((unsigned)yw), bflo((unsigned)(yw >> 32)), bfhi((unsigned)(yw >> 32))};
                  v[q][j] = xv * DN_ALPHA + gv * yv; }
              }
#pragma unroll
          for (int q = 0; q < 2; ++q) { const int r = rA + q * NGW;
              if (r < nrows) { float mean, rstd; row_stats(v[q], mean, rstd);
                  float* xdst = WSP(float, WS_X1) + (size_t)r * DM;
#pragma unroll
                  for (int j = 0; j < 4; ++j) { const f32x4 gg = ((const LAS f32x4*)lnl)[lane + 64 * j], bb = ((const LAS f32x4*)(lnl + DM))[lane + 64 * j];
                      v[q][j] = (v[q][j] - mean) * rstd * gg + bb; ((f32x4*)xdst)[lane + 64 * j] = v[q][j]; }
                  { const int bsel = r < NLAT ? r / SEQ : 4; f32x4 sh[4], sc[4]; ldvec(modp(F, l, bsel, 3), lane, sh); ldvec(modp(F, l, bsel, 4), lane, sc);
                    modulate_store8(F, v[q], sh, sc, WSP(unsigned char, WS_H8) + (size_t)r * DM, hv[q]); } }
              else {
#pragma unroll
                  for (int j = 0; j < 4; ++j) hv[q][j] = (f32x4){0.f, 0.f, 0.f, 0.f}; } } }
        typedef float f32x2r __attribute__((ext_vector_type(2)));
        unsigned rbase0 = (unsigned)(uintptr_t)rwT + 16u * (unsigned)lane, rbase1 = rbase0 + 65536u; asm volatile("" : "+v"(rbase0), "+v"(rbase1));
        float pv[64];
#pragma unroll
        for (int e = 0; e < 32; ++e) { f32x2r a0 = {0.f, 0.f}, a1 = {0.f, 0.f};
#pragma unroll
            for (int j = 0; j < 4; ++j) { const f32x4 w4 = *(const LAS f32x4*)(uintptr_t)((e < 16 ? rbase0 : rbase1) + (unsigned)((e & 15) * 4096 + 1024 * j));
                const f32x2r wl = {w4.x, w4.y}, wh = {w4.z, w4.w};
                a0 += (f32x2r){hv[0][j].x, hv[0][j].y} * wl; a0 += (f32x2r){hv[0][j].z, hv[0][j].w} * wh;
                a1 += (f32x2r){hv[1][j].x, hv[1][j].y} * wl; a1 += (f32x2r){hv[1][j].z, hv[1][j].w} * wh; }
            pv[e] = a0.x + a0.y; pv[32 + e] = a1.x + a1.y;
            if ((e & 3) == 3) asm volatile("" ::: "memory"); }
        const float mylg = rs64(pv, lane) + mybias;
        { const int fb = __float_as_int(mylg); int key = ((fb ^ ((fb >> 31) & 0x7fffffff)) & ~31) | (31 - mye);
          int te[2][4];
#pragma unroll
          for (int k = 0; k < 4; ++k) { int mk = key;
              mk = max(mk, __builtin_amdgcn_update_dpp(0, mk, 0xB1, 0xF, 0xF, true)); mk = max(mk, __builtin_amdgcn_update_dpp(0, mk, 0x4E, 0xF, 0xF, true));
              mk = max(mk, __builtin_amdgcn_update_dpp(0, mk, 0x141, 0xF, 0xF, true)); mk = max(mk, __builtin_amdgcn_update_dpp(0, mk, 0x140, 0xF, 0xF, true));
              const int mA = max(__builtin_amdgcn_readlane(mk, 0), __builtin_amdgcn_readlane(mk, 16)), mB = max(__builtin_amdgcn_readlane(mk, 32), __builtin_amdgcn_readlane(mk, 48));
              te[0][k] = 31 - (mA & 31); te[1][k] = 31 - (mB & 31);
              if (key == (myq ? mB : mA)) key = (int)0x80000000; }
#pragma unroll
          for (int q = 0; q < 2; ++q) { const int r = rA + q * NGW;
              if (r < nrows) { const int mli = __float_as_int(mylg);
                  const float t0 = __int_as_float(__builtin_amdgcn_readlane(mli, 32 * q + te[q][0])), t1 = __int_as_float(__builtin_amdgcn_readlane(mli, 32 * q + te[q][1]));
                  const float t2 = __int_as_float(__builtin_amdgcn_readlane(mli, 32 * q + te[q][2])), t3 = __int_as_float(__builtin_amdgcn_readlane(mli, 32 * q + te[q][3]));
                  const float e1 = __expf(t1 - t0), e2 = __expf(t2 - t0), e3 = __expf(t3 - t0); const float inv = 1.f / (1.f + e1 + e2 + e3);
                  if (lane < 4) { const int e = lane == 0 ? te[q][0] : lane == 1 ? te[q][1] : lane == 2 ? te[q][2] : te[q][3];
                      const float wg = (lane == 0 ? 1.f : lane == 1 ? e1 : lane == 2 ? e2 : e3) * inv;
                      const unsigned lp = __hip_atomic_fetch_add((LAS unsigned*)(cntL + e), 1u, __ATOMIC_RELAXED, __HIP_MEMORY_SCOPE_WORKGROUP);
                      topi[r * 4 + lane] = e; gate[r * 4 + lane] = wg; slotpos[r * 4 + lane] = (int)lp; } } } }
    }
    __syncthreads();
    if (tid < 32) (WSP(int, WS_ROUTE) + RT_CNT)[F.vcu * 32 + tid] = (int)cntL[tid];
}

__device__ __forceinline__ void ph_gather(Frame& F, int l) {
    const int tid = F.tid, lane = F.lane;
    volatile LAS int* sm = (volatile LAS int*)(F.lds + RING_OFF);
    const int* cnt = WSP(int, WS_ROUTE) + RT_CNT;
    { const int e = tid & 31, g = tid >> 5, per = (F.G + 15) / 16; int st = 0, sp = 0;
      for (int bb = 0; bb < per; ++bb) { const int blk = g * per + bb; if (blk < F.G) { const int v = cnt[blk * 32 + e]; st += v; if (blk < F.vcu) sp += v; } }
      sm[g * 32 + e] = st; sm[512 + g * 32 + e] = sp; }
    __syncthreads();
    if (tid < 32) { int tot = 0, pre = 0;
        for (int g = 0; g < 16; ++g) { tot += sm[g * 32 + tid]; pre += sm[512 + g * 32 + tid]; }
        sm[1024 + tid] = tot; sm[1056 + tid] = pre; }
    __syncthreads();
    if (tid == 0) { int base = 0; for (int e = 0; e < 32; ++e) { sm[1088 + e] = base; base += ((sm[1024 + e] + 255) / 256) * 256; } sm[1120] = base / 256; }
    __syncthreads();
    int* TT = WSP(int, WS_ROUTE) + RT_TT; int* rowslot = WSP(int, WS_ROUTE) + RT_ROWSLOT;
    if (F.vcu == 0) {
        if (tid == 0) TT[0] = sm[1120];
        for (int e = 0; e < 32; ++e) { const int tot = sm[1024 + e], base = sm[1088 + e], nte = (tot + 255) / 256;
            for (int i = tid; i < nte; i += 512) TT[1 + base / 256 + i] = e;
            for (int p = tot + tid; p < nte * 256; p += 512) rowslot[base + p] = -1; }
    }
    const int NGW = F.G * NWAVES, nrows = l == 0 ? NTOK : NLAT;
    const int* topi = WSP(int, WS_ROUTE) + RT_TOPI; const int* slotpos = WSP(int, WS_ROUTE) + RT_SLOTPOS;
    for (int s = tid; s < ((nrows + NGW - 1) / NGW) * 32; s += 512) { const int k = s & 3, w = (s >> 2) & 7, i = s >> 5, r = F.vcu * NWAVES + w + i * NGW;
        if (r < nrows) { const int e = topi[r * 4 + k], lp = slotpos[r * 4 + k]; rowslot[sm[1088 + e] + sm[1056 + e] + lp] = r * 4 + k; }
    }
}

namespace pg8 {
struct EpiBf16S {
    static constexpr bool PERM = true, AFTER_DRAIN = false;
    bf16_t* O; int ldc; int stile; float sval;
    __device__ __forceinline__ void operator()(const f32x4 (&acc)[2][2][4][2], const Unit& u, int wr, int wc, int fr, int fq) const {
        const int row0 = u.pm * BM + wr * 64 + fr, col0 = u.pn * BM + wc * 32 + 8 * fq; const float sc = (u.pn == stile) ? sval : 1.f;
#pragma unroll
        for (int ai = 0; ai < 2; ++ai)
#pragma unroll
            for (int m = 0; m < 4; ++m) { bf16_t* rowp = O + (size_t)(row0 + ai * HALF + m * 16) * ldc + col0;
#pragma unroll
                for (int bj = 0; bj < 2; ++bj) { const f32x4 v0 = acc[ai][bj][m][0] * sc, v1 = acc[ai][bj][m][1] * sc;
                    u32x4 w; w.x = cvt_pk_bf16(v0[0], v0[1]); w.y = cvt_pk_bf16(v0[2], v0[3]); w.z = cvt_pk_bf16(v1[0], v1[1]); w.w = cvt_pk_bf16(v1[2], v1[3]);
                    *(u32x4*)(rowp + bj * HALF) = w; } }
    }
};
}
namespace pg8 {
struct EpiI8S {
    static constexpr bool PERM = true, AFTER_DRAIN = false;
    bf16_t* O; int ldc; int stile; float sval; const float* srow; const int* cmaxbits;
    __device__ __forceinline__ void operator()(const f32x4 (&acc)[2][2][4][2], const Unit& u, int wr, int wc, int fr, int fq) const {
        const int row0 = u.pm * BM + wr * 64 + fr, col0 = u.pn * BM + wc * 32 + 8 * fq; const float sc = ((u.pn == stile) ? sval : 1.f) * (1.f / 127.f);
        f32x4 cs[2][2];
#pragma unroll
        for (int bj = 0; bj < 2; ++bj)
#pragma unroll
            for (int n = 0; n < 2; ++n) { const int* cb = cmaxbits + col0 + bj * HALF + 4 * n; cs[bj][n] = (f32x4){__int_as_float(cb[0]), __int_as_float(cb[1]), __int_as_float(cb[2]), __int_as_float(cb[3])} * sc; }
#pragma unroll
        for (int ai = 0; ai < 2; ++ai)
#pragma unroll
            for (int m = 0; m < 4; ++m) { const int row = row0 + ai * HALF + m * 16; const float rs = srow[row]; bf16_t* rowp = O + (size_t)row * ldc + col0;
#pragma unroll
                for (int bj = 0; bj < 2; ++bj) { const f32x4 v0 = acc[ai][bj][m][0] * cs[bj][0] * rs, v1 = acc[ai][bj][m][1] * cs[bj][1] * rs;
                    u32x4 w; w.x = cvt_pk_bf16(v0[0], v0[1]); w.y = cvt_pk_bf16(v0[2], v0[3]); w.z = cvt_pk_bf16(v1[0], v1[1]); w.w = cvt_pk_bf16(v1[2], v1[3]);
                    *(u32x4*)(rowp + bj * HALF) = w; } }
    }
};
}
namespace pg8 {
struct GroupedOrder {
    const PG8_LAS int* TT; int nN, G, c;
    __device__ __forceinline__ bool tile_of(int i, int& rt, int& pn) const {
        const int T = __builtin_amdgcn_readfirstlane(TT[0]);
        if ((G & 7) == 0) { const int x = c & 7, j = c >> 3, W = G >> 3, lo = (x * T) >> 3, hi = ((x + 1) * T) >> 3, uu = i * W + j;
            if (uu >= (hi - lo) * nN) return false; rt = lo + uu / nN; pn = uu % nN; }
        else { const long L = (long)i * G + c; if (L >= (long)T * nN) return false; rt = (int)(L / nN); pn = (int)(L % nN); }
        return true;
    }
    __device__ __forceinline__ bool next(int i, Unit& u) const {
        int rt, pn; if (!tile_of(i, rt, pn)) return false;
        const int e = __builtin_amdgcn_readfirstlane(TT[1 + rt]);
        u.pm = rt; u.pn = pn; u.pe = e; u.pb = e * nN + pn; return true;
    }
    __device__ __forceinline__ void a_ready(const Unit&) const {}
    __device__ __forceinline__ void done(const Unit&) const {}
};
struct EpiSwiGLU {
    static constexpr bool PERM = true, AFTER_DRAIN = false;
    unsigned char* O; const float* b1;
    __device__ __forceinline__ void operator()(const f32x4 (&acc)[2][2][4][2], const Unit& u, int wr, int wc, int fr, int fq) const {
        const int row0 = u.pm * BM + wr * 64 + fr, cc0 = u.pn * 128 + wc * 32 + 8 * fq;
        const float* bg = b1 + (size_t)u.pe * 2048 + cc0; const float* bl = bg + 1024;
        f32x4 vg[2], vl[2];
#pragma unroll
        for (int n = 0; n < 2; ++n) { vg[n] = *(const f32x4*)(bg + 4 * n); vl[n] = *(const f32x4*)(bl + 4 * n); }
#pragma unroll
        for (int ai = 0; ai < 2; ++ai)
#pragma unroll
            for (int m = 0; m < 4; ++m) { unsigned char* rowp = O + (size_t)(row0 + ai * HALF + m * 16) * 1024 + cc0; float o[8];
#pragma unroll
                for (int n = 0; n < 2; ++n) { const f32x4 g = acc[ai][0][m][n] * (1.0f / W1_SCALE) + vg[n], li = acc[ai][1][m][n] * (1.0f / W1_SCALE) + vl[n];
#pragma unroll
                    for (int j = 0; j < 4; ++j) { const float gg = fminf(g[j], 7.0f), ll = fminf(fmaxf(li[j], -7.0f), 7.0f);
                        o[n * 4 + j] = gg * (1.0f / (1.0f + __expf(-1.702f * gg))) * (ll + 1.0f); } }
                *(unsigned long long*)rowp = (unsigned long long)pk4_fp8(o[0], o[1], o[2], o[3]) | ((unsigned long long)pk4_fp8(o[4], o[5], o[6], o[7]) << 32); }
    }
};
struct EpiMoeOut {
    static constexpr bool PERM = true, AFTER_DRAIN = false;
    unsigned char* O; const float* b2; const float* gate; const int* rowslot;
    __device__ __forceinline__ void operator()(const f32x4 (&acc)[2][2][4][2], const Unit& u, int wr, int wc, int fr, int fq) const {
        const int row0 = u.pm * BM + wr * 64 + fr, col0 = u.pn * BM + wc * 32 + 8 * fq;
        f32x4 bv[2][2];
#pragma unroll
        for (int bj = 0; bj < 2; ++bj)
#pragma unroll
            for (int n = 0; n < 2; ++n) bv[bj][n] = *(const f32x4*)(b2 + (size_t)u.pe * 1024 + col0 + bj * HALF + 4 * n);
#pragma unroll
        for (int ai = 0; ai < 2; ++ai)
#pragma unroll
            for (int m = 0; m < 4; ++m) { const int slot = rowslot[row0 + ai * HALF + m * 16];
                if (slot >= 0) { const float gt = gate[slot]; unsigned char* rowp = O + (size_t)slot * 1024 + col0;
#pragma unroll
                    for (int bj = 0; bj < 2; ++bj) { const f32x4 v0 = (acc[ai][bj][m][0] * (1.0f / W2_SCALE) + bv[bj][0]) * gt, v1 = (acc[ai][bj][m][1] * (1.0f / W2_SCALE) + bv[bj][1]) * gt;
                        *(unsigned long long*)(rowp + bj * HALF) = (unsigned long long)pk4_fp8(v0[0], v0[1], v0[2], v0[3]) | ((unsigned long long)pk4_fp8(v1[0], v1[1], v1[2], v1[3]) << 32); } } }
    }
};
}

__device__ __forceinline__ void ph_r2(Frame& F, int l) {
    const int lane = F.lane, tid = F.tid, gw = F.vcu * NWAVES + F.wave, NGW = F.G * NWAVES, nrows = l == 0 ? NTOK : NLAT;
    LAS float* Lv = (LAS float*)(F.lds + RING_OFF);
    { const float* ln2g = INP(IN_LN2G) + l * DM; const float* ln2b = INP(IN_LN2B) + l * DM; const int ln = l + 1 < DEPTH ? l + 1 : l;
      for (int i = tid; i < DM; i += 512) { Lv[i] = ln2g[i]; Lv[DM + i] = ln2b[i];
#pragma unroll
          for (int b = 0; b < 5; ++b) { Lv[(2 + b) * DM + i] = modp(F, l, b, 5)[i]; Lv[(7 + b) * DM + i] = modp(F, ln, b, 0)[i]; Lv[(12 + b) * DM + i] = modp(F, ln, b, 1)[i]; } } }
    __syncthreads();
    for (int rA = gw; rA < nrows; rA += 2 * NGW) {
        f32x4 xv[2][4]; unsigned yw[2][4][4];
#pragma unroll
        for (int q = 0; q < 2; ++q) { const int r0 = rA + q * NGW, r = r0 < nrows ? r0 : rA;
            const float* xsrc = WSP(float, WS_X1) + (size_t)r * DM; const unsigned char* y4 = WSP(unsigned char, WS_Y4) + (size_t)r * 4 * DM;
#pragma unroll
            for (int j = 0; j < 4; ++j) { xv[q][j] = ((const f32x4*)xsrc)[lane + 64 * j];
#pragma unroll
                for (int k = 0; k < 4; ++k) yw[q][j][k] = ((const GAS unsigned*)(y4 + (size_t)k * DM))[lane + 64 * j]; } }
#pragma unroll
        for (int q = 0; q < 2; ++q) { const int r = rA + q * NGW;
            if (r < nrows) { const int bsel = r < NLAT ? r / SEQ : 4; f32x4 v[4];
#pragma unroll
                for (int j = 0; j < 4; ++j) { f32x4 mo = {0.f, 0.f, 0.f, 0.f}; typedef float f32x2c __attribute__((ext_vector_type(2)));
#pragma unroll
                    for (int k = 0; k < 4; ++k) { const int w = (int)yw[q][j][k]; const f32x2c lo = __builtin_amdgcn_cvt_pk_f32_fp8(w, false), hi = __builtin_amdgcn_cvt_pk_f32_fp8(w, true); mo += (f32x4){lo.x, lo.y, hi.x, hi.y}; }
                    v[j] = xv[q][j] * DN_ALPHA + ((const LAS f32x4*)(Lv + (2 + bsel) * DM))[lane + 64 * j] * mo; }
                float mean, rstd; row_stats(v, mean, rstd);
                float* xdst = (l == DEPTH - 1) ? F.out + (size_t)r * DM : WSP(float, WS_X) + (size_t)r * DM;
#pragma unroll
                for (int j = 0; j < 4; ++j) { const f32x4 gg = ((const LAS f32x4*)Lv)[lane + 64 * j], bb = ((const LAS f32x4*)(Lv + DM))[lane + 64 * j];
                    v[j] = (v[j] - mean) * rstd * gg + bb; ((f32x4*)xdst)[lane + 64 * j] = v[j]; }
                if (l + 1 < DEPTH) { f32x4 sh[4], sc[4];
#pragma unroll
                    for (int j = 0; j < 4; ++j) { sh[j] = ((const LAS f32x4*)(Lv + (7 + bsel) * DM))[lane + 64 * j]; sc[j] = ((const LAS f32x4*)(Lv + (12 + bsel) * DM))[lane + 64 * j]; }
                    modulate_store_i8(F, v, sh, sc, WSP(unsigned char, WS_H) + (size_t)r * DM, WSP(float, WS_ROUTE) + RT_SH + r); } } }
    }
}

#define PHASE_LOCAL Frame P = F; int l = l_; asm volatile("" : "+s"(P.ws), "+s"(P.out), "+v"(P.tid), "+v"(P.lane), "+s"(P.wave), "+s"(P.vcu), "+s"(P.G), "+s"(l))
#define IN(k) (lo <= (k) && (k) < hi)
#define SEAM(k) do { if (IN((k) + 1)) xcd_barrier(bar); } while (0)
template <int LAYER> __device__ __forceinline__ void layer_body(Frame& F, const XcdBarrier& bar, const int lo, const int hi, unsigned char* lds) {
    {
        constexpr int l_ = LAYER; constexpr int pb = 2 + PH_PER_LAYER * l_;
        if (IN(pb + 0)) { PHASE_LOCAL;
            pg8::Gemm g{(const bf16*)(P.ws + WS_H), (const bf16*)(P.ws + WS_WIN + (size_t)l * DIN * DM), NTOK, DIN, DM / 2}; pg8::StaticOrder S; S.init(NTOK, DIN, P.G, (int)blockIdx.x);
            pg8::EpiI8S E{(bf16*)(P.ws + WS_P), DIN, CNQ / 256, C2, (const float*)(P.ws + WS_ROUTE) + RT_SH, (const int*)(F.ctl + CW_WCMAX) + l * DIN};
            REPS(2) pg8::gemm_phase<pg8::EpiI8S, pg8::StaticOrder, true, true, false, false, true>(P.lds + RING_OFF, g, S, E, P.tid);
            SEAM(pb + 0); }
        if (IN(pb + 1)) { PHASE_LOCAL; REPS(3) ph_prep(P, l); SEAM(pb + 1); }
        if (IN(pb + 2)) { PHASE_LOCAL; ph_mixers(P, l, (char*)lds + RING_OFF); SEAM(pb + 2); }
        if (IN(pb + 3)) { PHASE_LOCAL; REPS(4) ph_hy_post(P); SEAM(pb + 3); }
        if (IN(pb + 4)) { PHASE_LOCAL;
            const int M = l == 0 ? NTOK : NLAT;
            pg8::Gemm g{(const bf16*)(P.ws + WS_YMIX), (const bf16*)(P.ws + WS_WOUT) + (size_t)l * DM * DM, M, DM, DM}; pg8::StaticOrder S; S.init(M, DM, P.G, (int)blockIdx.x);
            pg8::EpiBf16<0> E{(bf16*)(P.ws + WS_Y), DM, nullptr, 0, 0, 1.f};
            REPS(5) pg8::gemm_phase<pg8::EpiBf16<0>, pg8::StaticOrder, true, true>(P.lds + RING_OFF, g, S, E, P.tid);
            SEAM(pb + 4); }
        if (IN(pb + 5)) { PHASE_LOCAL; REPS(6) ph_r1(P, l); SEAM(pb + 5); }
        if (IN(pb + 6)) { PHASE_LOCAL; REPS(7) ph_gather(P, l); SEAM(pb + 6); }
        if (IN(pb + 7)) { PHASE_LOCAL;
            pg8::Gemm g{(const bf16*)(P.ws + WS_H8), (const bf16*)(P.ws + WS_W1 + (size_t)l * NEXP * 2048 * DM), MAXSORT, 2048, DM / 2};
            LAS int* TTl = (LAS int*)(P.lds + LDS_TT_OFF); { const int* TTg = (const int*)(P.ws + WS_ROUTE) + RT_TT; if (P.tid < 320) TTl[P.tid] = TTg[P.tid]; __syncthreads(); }
            pg8::GroupedOrder S{TTl, 8, P.G, (int)blockIdx.x};
            pg8::EpiSwiGLU E{(unsigned char*)(P.ws + WS_ACT), INP(IN_EB1) + (size_t)l * NEXP * 2048};
            LAS int* gtab = (LAS int*)(P.lds + RING_OFF + pg8::STAGE_BYTES);
            { const int* rowslot = (const int*)(P.ws + WS_ROUTE) + RT_ROWSLOT; pg8::Unit uu;
              { const int half = P.tid >> 8, r = P.tid & 255;
#pragma unroll
                for (int i0 = 0; i0 < 16; i0 += 2) { int rt, pn; if (S.tile_of(i0 + half, rt, pn)) { const int slot = rowslot[rt * 256 + r]; gtab[(i0 + half) * 256 + r] = slot < 0 ? 0 : slot >> 2; } } }
              (void)uu;
              __syncthreads(); }
            REPS(8) pg8::gemm_phase<pg8::EpiSwiGLU, pg8::GroupedOrder, true, true, true, true>(P.lds + RING_OFF, g, S, E, P.tid, gtab);
            SEAM(pb + 7); }
        if (IN(pb + 8)) { PHASE_LOCAL;
            pg8::Gemm g{(const bf16*)(P.ws + WS_ACT), (const bf16*)(P.ws + WS_W2 + (size_t)l * NEXP * DM * DM), MAXSORT, DM, DM / 2};
            LAS int* TTl = (LAS int*)(P.lds + LDS_TT_OFF); { const int* TTg = (const int*)(P.ws + WS_ROUTE) + RT_TT; if (P.tid < 320) TTl[P.tid] = TTg[P.tid]; __syncthreads(); }
            pg8::GroupedOrder S{TTl, 4, P.G, (int)blockIdx.x};
            pg8::EpiMoeOut E{(unsigned char*)(P.ws + WS_Y4), INP(IN_EB2) + (size_t)l * NEXP * DM, (const float*)(P.ws + WS_ROUTE) + RT_GATE, (const int*)(P.ws + WS_ROUTE) + RT_ROWSLOT};
            REPS(9) pg8::gemm_phase<pg8::EpiMoeOut, pg8::GroupedOrder, true, true, true>(P.lds + RING_OFF, g, S, E, P.tid);
            SEAM(pb + 8); }
        if (IN(pb + 9)) { PHASE_LOCAL; REPS(10) ph_r2(P, l); SEAM(pb + 9); if ((PROBE_MASK >> 12) & 1) { for (int xb = 0; xb < 10; ++xb) xcd_barrier(bar); } }
    }
}
struct Args { const float* in[31]; float* out; unsigned char* ws; int ph_lo, ph_hi; };
__global__ void __launch_bounds__(NWAVES * 64, 2) mega_fwd(Args args) {
    extern __shared__ __attribute__((aligned(16))) unsigned char lds[];
    Frame F;
    F.lds = (LAS unsigned char*)lds;
    F.MISC = (volatile LAS unsigned*)(F.lds + LDSCTL_OFF);
    F.tid = threadIdx.x; F.lane = F.tid & 63; F.wave = __builtin_amdgcn_readfirstlane(F.tid >> 6);
    F.G = gridDim.x; { const int bx = blockIdx.x; F.vcu = (F.G % 8 == 0) ? (bx % 8) * (F.G / 8) + bx / 8 : bx; }
    F.ws = args.ws; F.ctl = (gu32*)(args.ws + WS_CTL); F.out = args.out;
    for (int u = F.tid; u < 1024 / 4; u += NWAVES * 64) ((LAS unsigned*)(F.lds + LDSCTL_OFF))[u] = 0u;
    __syncthreads();
    const int lo = args.ph_lo, hi = args.ph_hi;
    const bool multi = (hi - lo) > 1;
    XcdBarrier bar; bar.bar = (unsigned*)(F.ctl + CW_BAR); bar.x = 0; bar.st = nullptr;
    if (multi) bar = xcd_barrier_post((unsigned*)(F.ctl + CW_BAR), F.MISC + 8);

    if (IN(0)) { REPS(0) ph_prologue(F); SEAM(0); }
    if (IN(1)) { REPS(1) { ph_r0(F); { LAS float* scr = (LAS float*)(F.lds + RING_OFF + F.wave * 16640); const int gw = F.vcu * NWAVES + F.wave, NGW = F.G * NWAVES; for (int it = gw; it < 2 * 576; it += NGW) p1_win_i8_item(F, it, scr); } __syncthreads(); { Frame Fs = F; asm volatile("" : "+s"(Fs.ws), "+v"(Fs.tid), "+v"(Fs.lane), "+s"(Fs.wave)); for (int it = Fs.vcu; it < 512; it += Fs.G) hy_spectrum_item(Fs, it >> 8, it & 255); } } SEAM(1); }
    layer_body<0>(F, bar, lo, hi, lds);
    layer_body<1>(F, bar, lo, hi, lds);
#undef IN
#undef SEAM
}

#ifndef MK_N_LAUNCHES
#define MK_N_LAUNCHES 1
#endif
extern "C" void kernel_launch(void* const* d_in, const int* in_sizes, int n_in, void* d_out, int out_size, void* d_ws, size_t ws_size, hipStream_t stream) {
    static int grid = 0;
    if (grid == 0) {
        if (n_in != 31 || out_size != NLAT * DM || ws_size < WS_END) { fprintf(stderr, "kernel_launch: unexpected problem (n_in %d, out %d, ws %zu); nothing launched\n", n_in, out_size, ws_size); grid = -1; return; }
        int dev = 0, cus = 0, per_cu = 0;
        if (hipGetDevice(&dev) != hipSuccess || hipDeviceGetAttribute(&cus, hipDeviceAttributeMultiprocessorCount, dev) != hipSuccess) { grid = -1; return; }
        if (hipFuncSetAttribute((const void*)mega_fwd, hipFuncAttributeMaxDynamicSharedMemorySize, LDS_BYTES) != hipSuccess) { fprintf(stderr, "kernel_launch: hipFuncSetAttribute failed\n"); grid = -1; return; }
        if (hipOccupancyMaxActiveBlocksPerMultiprocessor(&per_cu, (const void*)mega_fwd, NWAVES * 64, LDS_BYTES) != hipSuccess || per_cu < 1)
            fprintf(stderr, "kernel_launch: note: occupancy query reports %d workgroups per CU\n", per_cu);
        (void)hipGetLastError();
        grid = cus;
        if (grid > 256) grid = 256;
    }
    if (grid < 0) return;
    if (hipMemsetAsync((char*)d_ws + WS_CTL, 0, CTL_ZERO_BYTES, stream) != hipSuccess) return;
    Args a{};
    for (int i = 0; i < 31; ++i) a.in[i] = (const float*)d_in[i];
    a.out = (float*)d_out; a.ws = (unsigned char*)d_ws;
    if (MK_N_LAUNCHES == 1) { a.ph_lo = 0; a.ph_hi = NPHASE; hipLaunchKernelGGL(mega_fwd, dim3(grid), dim3(NWAVES * 64), LDS_BYTES, stream, a); }
    else for (int k = 0; k < NPHASE; ++k) { a.ph_lo = k; a.ph_hi = k + 1; hipLaunchKernelGGL(mega_fwd, dim3(grid), dim3(NWAVES * 64), LDS_BYTES, stream, a); }
}
```

```cpp
#include <hip/hip_runtime.h>
#include <cstdio>
#include <cstdint>
namespace pg8 {
#define PG8_LAS __attribute__((address_space(3)))
typedef unsigned short bf16_t;
typedef short bf16x8 __attribute__((ext_vector_type(8)));
typedef float f32x4 __attribute__((ext_vector_type(4)));
typedef unsigned u32x4 __attribute__((ext_vector_type(4)));
constexpr int BM = 256, BK = 64, HALF = 128, HTB = HALF * BK * 2  , STAGE_BYTES = 8 * HTB, NXCD = 8, WGM = 8;

__host__ __device__ __forceinline__ int lds_byte(int r, int c) { const int st = (r >> 4) * 2 + (c >> 5), rr = r & 15, cc = c & 31, ob = rr * 64 + cc * 2; return st * 1024 + (ob ^ (((ob >> 9) & 1) << 5)); }
__host__ __device__ __forceinline__ void stage_rc(int b, int& R, int& C) { const int st = b / 1024, sb = b % 1024, swz = sb ^ (((sb >> 9) & 1) << 5); R = (st >> 1) * 16 + swz / 64; C = (st & 1) * 32 + (swz % 64) / 2; }
__host__ __device__ __forceinline__ int perm32(int rho) { const int n = rho >> 4, i = rho & 15; return 8 * (i >> 2) + 4 * n + (i & 3); }

struct Unit { int pm, pn, pb, pe; };
struct Gemm { const bf16_t* A; const bf16_t* Bt; int M, N, K; };

struct StaticOrder {
    int nM, nN, nwg, G, c;
    __host__ __device__ void init(int M, int N, int G_, int c_) { nM = M / BM; nN = N / BM; nwg = nM * nN; G = G_; c = c_; }
    __host__ __device__ bool next(int i, Unit& u) const {
        const long L = (long)i * G + c; if (L >= nwg) return false;
        int wgid = (int)L; { const int q = nwg / NXCD, r = nwg % NXCD, xcd = wgid % NXCD, off = wgid / NXCD; wgid = (xcd < r ? xcd * (q + 1) : r * (q + 1) + (xcd - r) * q) + off; }
        const int nig = WGM * nN, gid = wgid / nig, fm = gid * WGM, gsz = (nM - fm) < WGM ? (nM - fm) : WGM;
        u.pm = fm + ((wgid % nig) % gsz); u.pn = (wgid % nig) / gsz; u.pb = u.pn; u.pe = 0; return true;
    }
    __device__ __forceinline__ void a_ready(const Unit&) const {}
    __device__ __forceinline__ void done(const Unit&) const {}
};

__device__ __forceinline__ unsigned cvt_pk_bf16(float lo, float hi) { unsigned r; asm volatile("v_cvt_pk_bf16_f32 %0, %1, %2" : "=v"(r) : "v"(lo), "v"(hi)); return r; }
typedef float f32x2 __attribute__((ext_vector_type(2)));
__device__ __forceinline__ f32x2 gelu_pk(f32x2 v) {
    const f32x2 av = __builtin_elementwise_abs(v), d = av * 0.2316418882f + 1.0f;
    f32x2 t; t.x = __builtin_amdgcn_rcpf(d.x); t.y = __builtin_amdgcn_rcpf(d.y);
    f32x2 q = t * 0.5307027145f + (-0.7265760135f); q = q * t + 0.7107068705f; q = q * t + (-0.142248368f); q = q * t + 0.127414796f; q = q * t;
    const f32x2 s = (v * v) * (-0.72134752044f);
    f32x2 e; e.x = __builtin_amdgcn_exp2f(s.x); e.y = __builtin_amdgcn_exp2f(s.y);
    const f32x2 m = v * (q * e), r = v - m;
    f32x2 o; o.x = v.x < 0.f ? m.x : r.x; o.y = v.y < 0.f ? m.y : r.y; return o;
}

template <int ACT  > struct EpiBf16 {
    static constexpr bool PERM = true, AFTER_DRAIN = false; static_assert(ACT == 0 || ACT == 1, "EpiBf16: ACT is 0 (none) or 1 (gelu_pk)");
    bf16_t* O; int ldc; const float* bias; int split_cols; size_t split_stride; float scale0;
    __device__ __forceinline__ void operator()(const f32x4 (&acc)[2][2][4][2], const Unit& u, int wr, int wc, int fr, int fq) const {
        const int row0 = u.pm * BM + wr * 64 + fr; int colt = u.pn * BM; bf16_t* base = O;
        float sc = 1.f; if (split_cols) { const int t = colt / split_cols; base += (size_t)t * split_stride; colt -= t * split_cols; if (t == 0) sc = scale0; }
        const int col0 = colt + wc * 32 + 8 * fq, bcol0 = u.pn * BM + wc * 32 + 8 * fq;
        f32x4 bv[2][2];
#pragma unroll
        for (int bj = 0; bj < 2; ++bj)
#pragma unroll
            for (int n = 0; n < 2; ++n) bv[bj][n] = bias ? *(const f32x4*)(bias + bcol0 + bj * HALF + 4 * n) : (f32x4){0.f, 0.f, 0.f, 0.f};
#pragma unroll
        for (int ai = 0; ai < 2; ++ai)
#pragma unroll
            for (int m = 0; m < 4; ++m) { bf16_t* rowp = base + (size_t)(row0 + ai * HALF + m * 16) * ldc + col0;
#pragma unroll
                for (int bj = 0; bj < 2; ++bj) { f32x4 v0 = acc[ai][bj][m][0] + bv[bj][0], v1 = acc[ai][bj][m][1] + bv[bj][1];
                    if (ACT == 1) { f32x2 a = gelu_pk((f32x2){v0[0], v0[1]}), b = gelu_pk((f32x2){v0[2], v0[3]}), c = gelu_pk((f32x2){v1[0], v1[1]}), d = gelu_pk((f32x2){v1[2], v1[3]});
                        v0 = (f32x4){a.x, a.y, b.x, b.y}; v1 = (f32x4){c.x, c.y, d.x, d.y}; }
                    v0 = v0 * sc; v1 = v1 * sc; u32x4 w; w.x = cvt_pk_bf16(v0[0], v0[1]); w.y = cvt_pk_bf16(v0[2], v0[3]); w.z = cvt_pk_bf16(v1[0], v1[1]); w.w = cvt_pk_bf16(v1[2], v1[3]);
                    *(u32x4*)(rowp + bj * HALF) = w; } }
    }
};

template <class Epi, class Sched, bool ALIGN_EPI = false, bool SP2 = false, bool F8 = false, bool GATHER = false, bool I8 = false>
__device__ __forceinline__ void gemm_phase(PG8_LAS unsigned char* lds, const Gemm g, const Sched& S, const Epi& E, const int tid, const PG8_LAS int* gtab = nullptr) {
    const int wid = __builtin_amdgcn_readfirstlane(tid >> 6), lane = tid & 63, wr = wid >> 2, wc = wid & 3, fr = lane & 15, fq = lane >> 4;
    const int K = g.K, nt = K / BK;
    unsigned voffA[2], voffB[2]; int gR[2]; unsigned gC[2];
#pragma unroll
    for (int i = 0; i < 2; ++i) { int R, C; stage_rc(tid * 16 + i * 8192, R, C); const int Rb = Epi::PERM ? ((R & ~31) + perm32(R & 31)) : R;
        voffA[i] = (unsigned)(R * K + C) * 2u; voffB[i] = (unsigned)(Rb * K + C) * 2u; gR[i] = R; gC[i] = (unsigned)C * 2u; }
    unsigned vC[2][2], vN[2][2];
#define PG8_GOFF(dst, ui_) do { _Pragma("unroll") for (int h_ = 0; h_ < 2; ++h_) _Pragma("unroll") for (int p_ = 0; p_ < 2; ++p_) dst[h_][p_] = (unsigned)gtab[(ui_) * 256 + h_ * HALF + gR[p_]] * (unsigned)(K * 2) + gC[p_]; } while (0)
#define PG8_STAGE_A(bufoff, abase, half, vsel) do { if constexpr (GATHER) { PG8_STAGE(bufoff, abase, vsel[half]); } else { PG8_STAGE(bufoff, (abase) + (half) * hstep, voffA); } } while (0)
    const size_t kstep = (size_t)(BK * 2);
    const size_t hstep = (size_t)HALF * K * 2;
    const size_t tstep = 2 * hstep;
    const unsigned ldsw = (unsigned)wid * 1024u;
    const int aoff = lds_byte(wr * 64 + fr, F8 ? 16 * fq : fq * 8), boff = lds_byte(wc * 32 + fr, F8 ? 16 * fq : fq * 8);
    const int aoff1 = F8 ? lds_byte(wr * 64 + fr, 16 * fq + 8) : aoff + 1024, boff1 = F8 ? lds_byte(wc * 32 + fr, 16 * fq + 8) : boff + 1024;
    unsigned f8scale = 0x7f7f7f7fu; asm volatile("" : "+v"(f8scale));
    unsigned abase0 = (unsigned)(uintptr_t)lds + (unsigned)aoff, abase1 = (unsigned)(uintptr_t)lds + (unsigned)aoff1, bbase0 = (unsigned)(uintptr_t)lds + 4u * HTB + (unsigned)boff, bbase1 = (unsigned)(uintptr_t)lds + 4u * HTB + (unsigned)boff1;
    asm volatile("" : "+v"(abase0), "+v"(abase1), "+v"(bbase0), "+v"(bbase1));
#define PG8_SA(b, h) (((b) * 2 + (h)) * HTB)
#define PG8_SB(b, h) ((4 + (b) * 2 + (h)) * HTB)
#define PG8_STAGE(bufoff, gbase, voff) do { _Pragma("unroll") for (int _i = 0; _i < 2; ++_i) \
        __builtin_amdgcn_global_load_lds((const unsigned*)((const char*)(gbase) + (voff)[_i]), (PG8_LAS unsigned*)(lds + (bufoff) + ldsw + _i * 8192), 16, 0, 0); } while (0)
#define PG8_LDA(dst, b, h) do { _Pragma("unroll") for (int m = 0; m < 4; ++m) _Pragma("unroll") for (int k = 0; k < 2; ++k) dst[m][k] = *(const PG8_LAS bf16x8*)(uintptr_t)((k ? abase1 : abase0) + (unsigned)(PG8_SA(b, h) + m * 2048)); } while (0)
#define PG8_LDB(dst, b, h) do { _Pragma("unroll") for (int n = 0; n < 2; ++n) _Pragma("unroll") for (int k = 0; k < 2; ++k) dst[n][k] = *(const PG8_LAS bf16x8*)(uintptr_t)((k ? bbase1 : bbase0) + (unsigned)(PG8_SA(b, h) + n * 2048)); } while (0)
#define PG8_MMA(ai, bj, At, Bt) do { __builtin_amdgcn_s_setprio(1); _Pragma("unroll") for (int m = 0; m < 4; ++m) _Pragma("unroll") for (int n = 0; n < 2; ++n) { \
        if constexpr (F8) { typedef int v8i_t __attribute__((ext_vector_type(8))); typedef int v4i_t __attribute__((ext_vector_type(4))); \
            const v4i_t b0_ = __builtin_bit_cast(v4i_t, Bt[n][0]), b1_ = __builtin_bit_cast(v4i_t, Bt[n][1]), a0_ = __builtin_bit_cast(v4i_t, At[m][0]), a1_ = __builtin_bit_cast(v4i_t, At[m][1]); \
            const v8i_t bb_ = {b0_[0], b0_[1], b0_[2], b0_[3], b1_[0], b1_[1], b1_[2], b1_[3]}, aa_ = {a0_[0], a0_[1], a0_[2], a0_[3], a1_[0], a1_[1], a1_[2], a1_[3]}; \
              \
            asm volatile("v_mfma_scale_f32_16x16x128_f8f6f4 %0, %1, %2, %0, %3, %3 op_sel_hi:[0,0,0]" : "+v"(acc[ai][bj][m][n]) : "v"(bb_), "v"(aa_), "v"(f8scale)); } \
        else if constexpr (I8) { typedef int v4i_t __attribute__((ext_vector_type(4))); _Pragma("unroll") for (int k = 0; k < 2; ++k) acc[ai][bj][m][n] = __builtin_bit_cast(f32x4, __builtin_amdgcn_mfma_i32_16x16x64_i8(__builtin_bit_cast(v4i_t, Bt[n][k]), __builtin_bit_cast(v4i_t, At[m][k]), __builtin_bit_cast(v4i_t, acc[ai][bj][m][n]), 0, 0, 0)); } \
        else { _Pragma("unroll") for (int k = 0; k < 2; ++k) acc[ai][bj][m][n] = __builtin_amdgcn_mfma_f32_16x16x32_bf16(Bt[n][k], At[m][k], acc[ai][bj][m][n], 0, 0, 0); } } \
        __builtin_amdgcn_s_setprio(0); } while (0)
#define PG8_WAIT_V(n) asm volatile("s_waitcnt vmcnt(" #n ")" ::: "memory")
#define PG8_WAIT_L(n) asm volatile("s_waitcnt lgkmcnt(" #n ")" ::: "memory")
#define PG8_BAR __builtin_amdgcn_s_barrier()
#define PG8_SCHED __builtin_amdgcn_sched_barrier(0)
    Unit cur, nxt; int ui = 0;
    if (!S.next(0, cur)) return;
    f32x4 acc[2][2][4][2];
#pragma unroll
    for (int a = 0; a < 2; ++a)
#pragma unroll
        for (int b = 0; b < 2; ++b)
#pragma unroll
            for (int m = 0; m < 4; ++m)
#pragma unroll
                for (int n = 0; n < 2; ++n) acc[a][b][m][n] = (f32x4){0.f, 0.f, 0.f, 0.f};
    bf16x8 At[4][2], B0[2][2], B1[2][2];
    const char* cA = (const char*)g.A + (GATHER ? (size_t)0 : (size_t)cur.pm * tstep); const char* cB = (const char*)g.Bt + (size_t)cur.pb * tstep;
    S.a_ready(cur);
    if constexpr (GATHER) { PG8_GOFF(vC, 0); }
    if constexpr (SP2) {
        PG8_STAGE(PG8_SB(0, 0), cB, voffB); PG8_STAGE(PG8_SB(0, 1), cB + hstep, voffB); PG8_STAGE_A(PG8_SA(0, 0), cA, 0, vC); PG8_STAGE_A(PG8_SA(0, 1), cA, 1, vC);
        if (wr == 1) PG8_BAR;
        PG8_WAIT_V(2); PG8_BAR;
        PG8_STAGE(PG8_SB(1, 0), cB + kstep, voffB); PG8_STAGE_A(PG8_SA(1, 0), cA + kstep, 0, vC); PG8_STAGE(PG8_SB(1, 1), cB + hstep + kstep, voffB);
        PG8_WAIT_V(6); PG8_BAR;
    } else {
        PG8_STAGE(PG8_SB(0, 0), cB, voffB); PG8_STAGE_A(PG8_SA(0, 0), cA, 0, vC); PG8_STAGE(PG8_SB(0, 1), cB + hstep, voffB); PG8_STAGE_A(PG8_SA(0, 1), cA, 1, vC);
        if (wr == 1) PG8_BAR;
        PG8_WAIT_V(4); PG8_BAR;
        PG8_STAGE(PG8_SB(1, 0), cB + kstep, voffB); PG8_STAGE_A(PG8_SA(1, 0), cA + kstep, 0, vC); PG8_STAGE(PG8_SB(1, 1), cB + hstep + kstep, voffB);
        PG8_WAIT_V(6); PG8_BAR;
    }
    for (;;) {
        const bool has_next = S.next(ui + 1, nxt);
        const char* nA = (has_next && !GATHER) ? (const char*)g.A + (size_t)nxt.pm * tstep : cA;
        if constexpr (GATHER) { if (has_next) { PG8_GOFF(vN, ui + 1); } else { _Pragma("unroll") for (int h_ = 0; h_ < 2; ++h_) _Pragma("unroll") for (int p_ = 0; p_ < 2; ++p_) vN[h_][p_] = vC[h_][p_]; } }
        const char* nB = has_next ? (const char*)g.Bt + (size_t)nxt.pb * tstep : cB;
#pragma unroll 1
        for (int t = 0; t < nt; t += 2) {
            const bool last = (t == nt - 2);
            const char* a1 = cA + (size_t)(t + 1) * kstep;
            const char* a2 = last ? nA : cA + (size_t)(t + 2) * kstep; const char* b2 = last ? nB : cB + (size_t)(t + 2) * kstep;
            const char* a3 = a2 + kstep; const char* b3 = b2 + kstep;
            unsigned v2[2][2];
            if constexpr (GATHER) { _Pragma("unroll") for (int h_ = 0; h_ < 2; ++h_) _Pragma("unroll") for (int p_ = 0; p_ < 2; ++p_) v2[h_][p_] = last ? vN[h_][p_] : vC[h_][p_]; }
            if (last && has_next) S.a_ready(nxt);
            if constexpr (SP2) {
            PG8_LDB(B0, 0, 0); PG8_LDB(B1, 0, 1); PG8_SCHED; PG8_LDA(At, 0, 0); PG8_STAGE_A(PG8_SA(1, 1), a1, 1, vC);
            PG8_WAIT_V(8); PG8_WAIT_L(0); PG8_BAR; PG8_MMA(0, 0, At, B0); PG8_MMA(0, 1, At, B1); PG8_BAR; PG8_SCHED;
            PG8_LDA(At, 0, 1); PG8_STAGE(PG8_SB(0, 0), b2, voffB); PG8_STAGE(PG8_SB(0, 1), b2 + hstep, voffB); PG8_STAGE_A(PG8_SA(0, 0), a2, 0, v2);
            PG8_WAIT_V(8); PG8_WAIT_L(0); PG8_BAR; PG8_MMA(1, 0, At, B0); PG8_MMA(1, 1, At, B1); PG8_BAR; PG8_SCHED;
            PG8_LDB(B0, 1, 0); PG8_LDB(B1, 1, 1); PG8_SCHED; PG8_LDA(At, 1, 0); PG8_STAGE_A(PG8_SA(0, 1), a2, 1, v2);
            PG8_WAIT_V(8); PG8_WAIT_L(0); PG8_BAR; PG8_MMA(0, 0, At, B0); PG8_MMA(0, 1, At, B1); PG8_BAR; PG8_SCHED;
            PG8_LDA(At, 1, 1); PG8_STAGE(PG8_SB(1, 0), b3, voffB); PG8_STAGE(PG8_SB(1, 1), b3 + hstep, voffB); PG8_STAGE_A(PG8_SA(1, 0), a3, 0, v2);
            PG8_WAIT_V(8); PG8_WAIT_L(0); PG8_BAR; PG8_MMA(1, 0, At, B0); PG8_MMA(1, 1, At, B1); PG8_BAR; PG8_SCHED;
            } else {
            PG8_LDB(B0, 0, 0); PG8_SCHED; PG8_LDA(At, 0, 0); PG8_STAGE_A(PG8_SA(1, 1), a1, 1, vC);
            PG8_WAIT_L(8); PG8_BAR; PG8_WAIT_L(0); PG8_MMA(0, 0, At, B0); PG8_BAR; PG8_SCHED;
            PG8_LDB(B1, 0, 1); PG8_STAGE(PG8_SB(0, 0), b2, voffB);
            PG8_BAR; PG8_WAIT_L(0); PG8_MMA(0, 1, At, B1); PG8_BAR;
            PG8_LDA(At, 0, 1); PG8_STAGE_A(PG8_SA(0, 0), a2, 0, v2);
            PG8_BAR; PG8_WAIT_L(0); PG8_MMA(1, 0, At, B0); PG8_BAR; PG8_SCHED;
            PG8_STAGE(PG8_SB(0, 1), b2 + hstep, voffB);
            PG8_WAIT_V(6); PG8_BAR; PG8_MMA(1, 1, At, B1); PG8_BAR;
            PG8_LDB(B0, 1, 0); PG8_SCHED; PG8_LDA(At, 1, 0); PG8_STAGE_A(PG8_SA(0, 1), a2, 1, v2);
            PG8_WAIT_L(8); PG8_BAR; PG8_WAIT_L(0); PG8_MMA(0, 0, At, B0); PG8_BAR; PG8_SCHED;
            PG8_LDB(B1, 1, 1); PG8_STAGE(PG8_SB(1, 0), b3, voffB);
            PG8_BAR; PG8_WAIT_L(0); PG8_MMA(0, 1, At, B1); PG8_BAR;
            PG8_LDA(At, 1, 1); PG8_STAGE_A(PG8_SA(1, 0), a3, 0, v2);
            PG8_BAR; PG8_WAIT_L(0); PG8_MMA(1, 0, At, B0); PG8_BAR; PG8_SCHED;
            PG8_STAGE(PG8_SB(1, 1), b3 + hstep, voffB);
            PG8_WAIT_V(6); PG8_BAR; PG8_MMA(1, 1, At, B1); PG8_BAR;
            }
        }
        if constexpr (F8) asm volatile("s_nop 15\n\ts_nop 15" ::: "memory");
        if constexpr (ALIGN_EPI) { if (wr == 0) PG8_BAR; }
        if constexpr (I8) { typedef int v4i_t __attribute__((ext_vector_type(4))); _Pragma("unroll") for (int a = 0; a < 2; ++a) _Pragma("unroll") for (int b = 0; b < 2; ++b) _Pragma("unroll") for (int m = 0; m < 4; ++m) _Pragma("unroll") for (int n = 0; n < 2; ++n) acc[a][b][m][n] = __builtin_convertvector(__builtin_bit_cast(v4i_t, acc[a][b][m][n]), f32x4); }
        if constexpr (!Epi::AFTER_DRAIN) { E(acc, cur, wr, wc, fr, fq); S.done(cur); }
        if (!has_next) break;
#pragma unroll
        for (int a = 0; a < 2; ++a)
#pragma unroll
            for (int b = 0; b < 2; ++b)
#pragma unroll
                for (int m = 0; m < 4; ++m)
#pragma unroll
                    for (int n = 0; n < 2; ++n) acc[a][b][m][n] = (f32x4){0.f, 0.f, 0.f, 0.f};
        cur = nxt; cA = nA; cB = nB; ++ui;
        if constexpr (GATHER) { _Pragma("unroll") for (int h_ = 0; h_ < 2; ++h_) _Pragma("unroll") for (int p_ = 0; p_ < 2; ++p_) vC[h_][p_] = vN[h_][p_]; }
        if constexpr (ALIGN_EPI) { if (wr == 1) PG8_BAR; }
    }
    PG8_WAIT_V(0);
    if constexpr (!ALIGN_EPI) { if (wr == 0) PG8_BAR; }
    PG8_BAR;
    if constexpr (Epi::AFTER_DRAIN) { E.fused(acc, cur, wr, wc, fr, fq, lds, wid, lane); S.done(cur); }
#undef PG8_SA
#undef PG8_SB
#undef PG8_STAGE
#undef PG8_STAGE_A
#undef PG8_GOFF
#undef PG8_LDA
#undef PG8_LDB
#undef PG8_MMA
#undef PG8_WAIT_V
#undef PG8_WAIT_L
#undef PG8_BAR
#undef PG8_SCHED
}
}
#include <hip/hip_bf16.h>
#include <cmath>
namespace attn_body {
using bf16=__hip_bfloat16;
using bf16x8=__attribute__((ext_vector_type(8)))short;
using s16x4=__attribute__((ext_vector_type(4)))short;
using f32x16=__attribute__((ext_vector_type(16)))float;
using u32x4=__attribute__((ext_vector_type(4)))unsigned;
constexpr int D=64;
constexpr int NW=8,QBLK=32,QB=QBLK*NW,KVBLK=64;
constexpr int ATTN_UNIT_ROWS=QB;
__device__ __forceinline__ int crow(int r,int hi){return (r&3)+8*(r>>2)+4*hi;}
#define SBAR() __builtin_amdgcn_sched_barrier(0)
__device__ __forceinline__ void cmask(f32x16&p0,f32x16&p1,int jb,int qrel,int hi){
  const float NEG=-INFINITY; int kb=64*jb+4*hi;
  #pragma unroll
  for(int r=0;r<16;++r){int kv=kb+(r&3)+8*(r>>2); if(kv>qrel)p0[r]=NEG; if(kv+32>qrel)p1[r]=NEG;}
}

constexpr int NSLOT=3, SLOTB=8192;
constexpr int LDS_K=0, LDS_V=NSLOT*SLOTB, LDS_WS=2*NSLOT*SLOTB, LDS_OST=LDS_WS+NW*64*4, LDS_BYTES=LDS_OST+NW*4096;
constexpr float C2=0.125f*1.4426950408889634f;
__device__ __forceinline__ void glds16(const void*gsrc,unsigned lds_dst){unsigned keep;
  asm volatile("s_mov_b32 %0, m0\n\ts_mov_b32 m0, %2\n\ts_nop 0\n\tglobal_load_lds_dwordx4 %1, off\n\ts_mov_b32 m0, %0":"=&s"(keep):"v"(gsrc),"s"(lds_dst):"memory");}
__device__ __forceinline__ float max3f(float a,float b,float c){float r;asm("v_max3_f32 %0, %1, %2, %3":"=v"(r):"v"(a),"v"(b),"v"(c));return r;}
__device__ __forceinline__ float max2f(float a,float b){float r;asm("v_max_f32_e32 %0, %1, %2":"=v"(r):"v"(a),"v"(b));return r;}
__device__ __forceinline__ float fadd_s(float a,float b){float r;asm("v_add_f32_e32 %0, %1, %2":"=v"(r):"v"(a),"v"(b));return r;}
__device__ __forceinline__ float fsub_s(float a,float b){float r;asm("v_sub_f32_e32 %0, %1, %2":"=v"(r):"v"(a),"v"(b));return r;}
typedef float f32x2_t __attribute__((ext_vector_type(2))); typedef __bf16 bf16x2_t __attribute__((ext_vector_type(2)));
__device__ __forceinline__ unsigned cvtpk_s(float lo,float hi){f32x2_t v={lo,hi};bf16x2_t b=__builtin_convertvector(v,bf16x2_t);return __builtin_bit_cast(unsigned,b);}
#define WAIT_BAR(N) asm volatile("s_waitcnt vmcnt(" #N ") lgkmcnt(0)\n\ts_barrier":::"memory")

__device__ __forceinline__ void qkt(f32x16&p0,f32x16&p1,const char*Kslot,const bf16x8*qr,const f32x16&negm,int r32,int hi){
  const char*kb=Kslot+hi*1024+r32*16;
  #pragma unroll
  for(int d0=0;d0<4;++d0){
    const bf16x8 b0=*reinterpret_cast<const bf16x8*>(kb+d0*2048);
    const bf16x8 b1=*reinterpret_cast<const bf16x8*>(kb+d0*2048+512);
    if(d0==0){p0=__builtin_amdgcn_mfma_f32_32x32x16_bf16(b0,qr[0],negm,0,0,0);p1=__builtin_amdgcn_mfma_f32_32x32x16_bf16(b1,qr[0],negm,0,0,0);}
    else{p0=__builtin_amdgcn_mfma_f32_32x32x16_bf16(b0,qr[d0],p0,0,0,0);p1=__builtin_amdgcn_mfma_f32_32x32x16_bf16(b1,qr[d0],p1,0,0,0);}}
}
typedef __attribute__((address_space(3))) const char* lds_cptr;
typedef short v4i16_t __attribute__((ext_vector_type(4)));
__device__ __forceinline__ void kload8(bf16x8*kf,lds_cptr kp){
  kf[0]=*(const __attribute__((address_space(3))) bf16x8*)(kp);      kf[1]=*(const __attribute__((address_space(3))) bf16x8*)(kp+512);
  kf[2]=*(const __attribute__((address_space(3))) bf16x8*)(kp+2048); kf[3]=*(const __attribute__((address_space(3))) bf16x8*)(kp+2560);
  kf[4]=*(const __attribute__((address_space(3))) bf16x8*)(kp+4096); kf[5]=*(const __attribute__((address_space(3))) bf16x8*)(kp+4608);
  kf[6]=*(const __attribute__((address_space(3))) bf16x8*)(kp+6144); kf[7]=*(const __attribute__((address_space(3))) bf16x8*)(kp+6656);
}
__device__ __forceinline__ void kload2(bf16x8*kf,lds_cptr kp,int j){ kf[2*j]=*(const __attribute__((address_space(3))) bf16x8*)(kp+j*2048); kf[2*j+1]=*(const __attribute__((address_space(3))) bf16x8*)(kp+j*2048+512); }
__device__ __forceinline__ s16x4 vtr(lds_cptr p){ return __builtin_bit_cast(s16x4,__builtin_amdgcn_ds_read_tr16_b64_v4i16((__attribute__((address_space(3))) v4i16_t*)p)); }
__device__ __forceinline__ float rowmax(const f32x16&p0,const f32x16&p1){
  float a=max3f(p0[0],p0[1],p1[0]),b=max3f(p0[2],p0[3],p1[1]);a=max3f(a,p1[2],p1[3]);
  #pragma unroll
  for(int r=4;r<16;r+=4){a=max3f(a,p0[r],p0[r+1]);b=max3f(b,p0[r+2],p0[r+3]);a=max3f(a,p1[r],p1[r+1]);b=max3f(b,p1[r+2],p1[r+3]);}
  const float m=max2f(a,b);
  auto rr=__builtin_amdgcn_permlane32_swap(__float_as_uint(m),__float_as_uint(m),false,false);
  return max2f(__uint_as_float(rr[0]),__uint_as_float(rr[1]));
}
__device__ __forceinline__ void pv(f32x16*o,int vb,bf16x8 pa0,bf16x8 pa1,bf16x8 pa2,bf16x8 pa3){
  #pragma unroll
  for(int d0=0;d0<2;++d0){s16x4 lo[4],hi[4];
    #pragma unroll
    for(int ks=0;ks<4;++ks){
      asm volatile("ds_read_b64_tr_b16 %0,%1 offset:%c2":"=&v"(lo[ks]):"v"(vb),"i"(d0*4096+ks*1024):"memory");
      asm volatile("ds_read_b64_tr_b16 %0,%1 offset:%c2":"=&v"(hi[ks]):"v"(vb),"i"(d0*4096+ks*1024+512):"memory");}
    asm volatile("s_waitcnt lgkmcnt(0)":::"memory");SBAR();
    #define PK(k) (bf16x8){lo[k][0],lo[k][1],lo[k][2],lo[k][3],hi[k][0],hi[k][1],hi[k][2],hi[k][3]}
    o[d0]=__builtin_amdgcn_mfma_f32_32x32x16_bf16(pa0,PK(0),o[d0],0,0,0);
    o[d0]=__builtin_amdgcn_mfma_f32_32x32x16_bf16(pa1,PK(1),o[d0],0,0,0);
    o[d0]=__builtin_amdgcn_mfma_f32_32x32x16_bf16(pa2,PK(2),o[d0],0,0,0);
    o[d0]=__builtin_amdgcn_mfma_f32_32x32x16_bf16(pa3,PK(3),o[d0],0,0,0);
    #undef PK
  }
}

#ifndef ATTN_STORE16
#define ATTN_STORE16(p,v) (*(u32x4*)(p)=(v))
#endif
template<int THRL> __device__ __forceinline__ void attn_unit(const bf16*Qu,const bf16*__restrict__ Kh,const bf16*__restrict__ Vh,bf16*Ou,const int QP,const int KP,const int OP,const int NT,char*shm,const int tid){
  const int lane=tid&63,r32=lane&31,hi=lane>>5; const int wid=__builtin_amdgcn_readfirstlane(tid>>6);
  const bf16*Qw=Qu+(long)(wid*QBLK)*QP;
  const unsigned lds0=(unsigned)(uintptr_t)shm;
  float*wsf=(float*)(shm+LDS_WS)+wid*64;
  const bf16*ksrc=Kh+(long)lane*KP+wid*8;
  const bf16*vsrc=Vh+(long)(16*(wid&3)+(lane>>2))*KP+(wid>>2)*32+(lane&3)*8;
  const unsigned kdst=lds0+LDS_K+wid*1024, vdst=lds0+LDS_V+wid*1024;
  #define DMA_K(t,slot) glds16(ksrc+(long)(t)*KVBLK*KP,(unsigned)__builtin_amdgcn_readfirstlane(kdst+(slot)))
  #define DMA_V(t,slot) glds16(vsrc+(long)(t)*KVBLK*KP,(unsigned)__builtin_amdgcn_readfirstlane(vdst+(slot)))
  const int vb0=(int)(lds0+LDS_V)+((lane>>4)&1)*32+(lane&3)*8+(4*hi+((lane&15)>>2))*64;
  const char*Kbase=shm+LDS_K; bf16x8 kf[8];
  const lds_cptr shm3=(lds_cptr)shm; const lds_cptr kp0=shm3+LDS_K+hi*1024+r32*16; const lds_cptr vp0=shm3+LDS_V+((lane>>4)&1)*32+(lane&3)*8+(4*hi+((lane&15)>>2))*64;
  DMA_K(0,0);DMA_V(0,0);DMA_K(1,SLOTB);
  bf16x8 qr[4];
  #pragma unroll
  for(int d0=0;d0<4;++d0)qr[d0]=*reinterpret_cast<const bf16x8*>(&Qw[(long)r32*QP+d0*16+hi*8]);
  float mhat=0.f,l_reg=0.f;f32x16 o[2];o[0]=f32x16{};o[1]=f32x16{};f32x16 negm=f32x16{};asm volatile("":"+v"(negm));
  #define CMASK(P0,P1,t) do{}while(0)
  bool resc=false;
  #define START(P0,P1) do{ const float rm=rowmax(P0,P1); resc=false; \
    { const float dl=rm; mhat=fadd_s(mhat,dl); \
      _Pragma("unroll") for(int r=0;r<16;++r){P0[r]=fsub_s(P0[r],dl);P1[r]=fsub_s(P1[r],dl);} \
      _Pragma("unroll") for(int r=0;r<16;++r)negm[r]=-mhat; asm volatile("":"+v"(negm)); } \
    _Pragma("unroll") for(int r=0;r<16;++r)P0[r]=__builtin_amdgcn_exp2f(P0[r]); }while(0)
  #define RESC() do{ if(resc){ asm volatile("s_waitcnt lgkmcnt(0)":::"memory"); \
      _Pragma("unroll") for(int d_=0;d_<2;++d_) _Pragma("unroll") for(int r=0;r<16;++r)o[d_][r]*=wsf[crow(r,hi)]; } }while(0)
  f32x16 pA0,pA1,pB0,pB1;
  int sl_prev=0,sl_cur=0,sl_next=SLOTB;
  #define ROT() do{sl_prev=sl_cur;sl_cur=sl_next;sl_next=(sl_next==(NSLOT-1)*SLOTB)?0:sl_next+SLOTB;}while(0)
  DMA_K(2,2*SLOTB);
  WAIT_BAR(3);
  qkt(pA0,pA1,Kbase,qr,negm,r32,hi);asm volatile("s_nop 15\n\ts_nop 7":"+v"(pA0),"+v"(pA1));CMASK(pA0,pA1,0);
  START(pA0,pA1);
  _Pragma("unroll") for(int r=0;r<16;++r)pA1[r]=__builtin_amdgcn_exp2f(pA1[r]);
  WAIT_BAR(0);
  DMA_K(3,0);DMA_V(1,SLOTB);
  ROT();
  kload8(kf,kp0+sl_cur);
  WAIT_BAR(2);
  s16x4 vlo[8],vhi[8]; u32x4 pw0,pw1,pw2,pw3;
  #define PKW(P,B) cvtpk_s(P[B],P[B+1])
  #define PAF(k) __builtin_bit_cast(bf16x8,pw##k)
  #define VFR(i) (bf16x8){vlo[i][0],vlo[i][1],vlo[i][2],vlo[i][3],vhi[i][0],vhi[i][1],vhi[i][2],vhi[i][3]}
  #define PIN(x) asm volatile("":"+v"(x))
  #define MX3(a,b,c) __builtin_fmaxf(__builtin_fmaxf((a),(b)),(c))
  #define GAPA(MF,A0,A1,A2,A3,W0,W1,PW) do{ MF; sacc+=A0; sacc+=A1; sacc+=A2; sacc+=A3; PIN(sacc); W0; W1; PIN(PW); SBAR(); }while(0)
  #define EX(v) __builtin_amdgcn_exp2f(v)
  #define GAPB(MF,X,B) do{ MF; X[B]=EX(X[B]); X[B+1]=EX(X[B+1]); X[B+2]=EX(X[B+2]); X[B+3]=EX(X[B+3]); PIN(X); SBAR(); }while(0)
  #define VRD(i) do{ vlo[i]=vtr(vp_+(((i)>>2)*4096+((i)&3)*1024)); vhi[i]=vtr(vp_+(((i)>>2)*4096+((i)&3)*1024+512)); }while(0)
  #define KRD(G,j) do{ if(G){ kload2(kf,kp0+sl_next,j); SBAR(); } }while(0)
  #define STEP(C0,C1,P0,P1,t,GK,GV,GL) do{ SBAR(); \
    const lds_cptr vp_=vp0+sl_prev; \
    VRD(0); SBAR(); float sacc=(P0[0]+P0[1]); \
    GAPA(C0=__builtin_amdgcn_mfma_f32_32x32x16_bf16(kf[0],qr[0],negm,0,0,0), P0[2],P0[3],P0[4],P0[5],     pw0[0]=PKW(P0,0), pw0[1]=PKW(P0,2), pw0); \
    VRD(4); SBAR(); GAPA(C1=__builtin_amdgcn_mfma_f32_32x32x16_bf16(kf[1],qr[0],negm,0,0,0), P0[6],P0[7],P0[8],P0[9],     pw0[2]=PKW(P0,4), pw0[3]=PKW(P0,6), pw0); \
    VRD(1); SBAR(); GAPA(C0=__builtin_amdgcn_mfma_f32_32x32x16_bf16(kf[2],qr[1],C0,0,0,0),   P0[10],P0[11],P0[12],P0[13], pw1[0]=PKW(P0,8), pw1[1]=PKW(P0,10), pw1); \
    VRD(5); SBAR(); GAPA(C1=__builtin_amdgcn_mfma_f32_32x32x16_bf16(kf[3],qr[1],C1,0,0,0),   P0[14],P0[15],P1[0],P1[1],   pw1[2]=PKW(P0,12),pw1[3]=PKW(P0,14), pw1); \
    VRD(2); SBAR(); GAPA(C0=__builtin_amdgcn_mfma_f32_32x32x16_bf16(kf[4],qr[2],C0,0,0,0),   P1[2],P1[3],P1[4],P1[5],     pw2[0]=PKW(P1,0), pw2[1]=PKW(P1,2), pw2); \
    VRD(6); SBAR(); GAPA(C1=__builtin_amdgcn_mfma_f32_32x32x16_bf16(kf[5],qr[2],C1,0,0,0),   P1[6],P1[7],P1[8],P1[9],     pw2[2]=PKW(P1,4), pw2[3]=PKW(P1,6), pw2); \
    VRD(3); SBAR(); GAPA(C0=__builtin_amdgcn_mfma_f32_32x32x16_bf16(kf[6],qr[3],C0,0,0,0),   P1[10],P1[11],P1[12],P1[13], pw3[0]=PKW(P1,8), pw3[1]=PKW(P1,10), pw3); \
    VRD(7); SBAR(); GAPA(C1=__builtin_amdgcn_mfma_f32_32x32x16_bf16(kf[7],qr[3],C1,0,0,0),   P1[14],P1[15],0.f,0.f,       pw3[2]=PKW(P1,12),pw3[3]=PKW(P1,14), pw3); \
    l_reg+=sacc; \
    if(GK){DMA_K((t)+3,sl_cur);} if(GV){DMA_V((t)+1,sl_next);} \
    CMASK(C0,C1,t); \
    { float a=MX3(C0[0],C0[1],C1[0]),b=MX3(C0[2],C0[3],C1[1]); a=MX3(a,C1[2],C1[3]); \
      _Pragma("unroll") for(int r=4;r<16;r+=4){a=MX3(a,C0[r],C0[r+1]);b=MX3(b,C0[r+2],C0[r+3]);a=MX3(a,C1[r],C1[r+1]);b=MX3(b,C1[r+2],C1[r+3]);} \
      float rm=__builtin_fmaxf(a,b); { auto rr=__builtin_amdgcn_permlane32_swap(__float_as_uint(rm),__float_as_uint(rm),false,false); rm=__builtin_fmaxf(__uint_as_float(rr[0]),__uint_as_float(rr[1])); } \
      resc=false; \
      if(__builtin_expect(__any(rm>(float)THRL),0)){ const float dl=__builtin_fmaxf(rm,0.f); mhat+=dl; \
        _Pragma("unroll") for(int r=0;r<16;++r){C0[r]-=dl;C1[r]-=dl;} \
        _Pragma("unroll") for(int r=0;r<16;++r)negm[r]=-mhat; asm volatile("":"+v"(negm)); \
        const float f=__builtin_amdgcn_exp2f(-dl); l_reg*=f; if(hi==0)wsf[r32]=f; resc=true; } } \
    SBAR(); \
    GAPB(o[0]=__builtin_amdgcn_mfma_f32_32x32x16_bf16(PAF(0),VFR(0),o[0],0,0,0), C0,0); \
    GAPB(o[1]=__builtin_amdgcn_mfma_f32_32x32x16_bf16(PAF(0),VFR(4),o[1],0,0,0), C0,4); \
    KRD(GL,0); GAPB(o[0]=__builtin_amdgcn_mfma_f32_32x32x16_bf16(PAF(1),VFR(1),o[0],0,0,0), C0,8); \
    KRD(GL,1); GAPB(o[1]=__builtin_amdgcn_mfma_f32_32x32x16_bf16(PAF(1),VFR(5),o[1],0,0,0), C0,12); \
    KRD(GL,2); GAPB(o[0]=__builtin_amdgcn_mfma_f32_32x32x16_bf16(PAF(2),VFR(2),o[0],0,0,0), C1,0); \
    KRD(GL,3); GAPB(o[1]=__builtin_amdgcn_mfma_f32_32x32x16_bf16(PAF(2),VFR(6),o[1],0,0,0), C1,4); \
    GAPB(o[0]=__builtin_amdgcn_mfma_f32_32x32x16_bf16(PAF(3),VFR(3),o[0],0,0,0), C1,8); \
    GAPB(o[1]=__builtin_amdgcn_mfma_f32_32x32x16_bf16(PAF(3),VFR(7),o[1],0,0,0), C1,12); \
    }while(0)
  int t=1;
  #undef CMASK
  #define CMASK(P0,P1,t) do{}while(0)
  for(;t+5<NT;t+=2){
    STEP(pB0,pB1,pA0,pA1,t,true,true,true);     WAIT_BAR(2); RESC(); ROT();
    STEP(pA0,pA1,pB0,pB1,t+1,true,true,true);   WAIT_BAR(2); RESC(); ROT();
  }
  #undef CMASK
  #define CMASK(P0,P1,t) do{}while(0)
  #define ENDW(tt) do{ if((tt)+3<NT){WAIT_BAR(2);} else if((tt)+2<NT){WAIT_BAR(1);} else {WAIT_BAR(0);} }while(0)
  for(;t+1<NT;t+=2){
    STEP(pB0,pB1,pA0,pA1,t,(t+3<NT),(t+1<NT),(t+1<NT));       ENDW(t);   RESC(); ROT();
    STEP(pA0,pA1,pB0,pB1,t+1,(t+4<NT),(t+2<NT),(t+2<NT));     ENDW(t+1); RESC(); ROT();
  }
  STEP(pB0,pB1,pA0,pA1,NT-1,false,false,false); RESC();
  { float sacc=pB0[0]+pB0[1]; _Pragma("unroll") for(int r=2;r<16;++r)sacc+=pB0[r]; _Pragma("unroll") for(int r=0;r<16;++r)sacc+=pB1[r]; l_reg+=sacc;
    pw0=(u32x4){PKW(pB0,0),PKW(pB0,2),PKW(pB0,4),PKW(pB0,6)};pw1=(u32x4){PKW(pB0,8),PKW(pB0,10),PKW(pB0,12),PKW(pB0,14)};pw2=(u32x4){PKW(pB1,0),PKW(pB1,2),PKW(pB1,4),PKW(pB1,6)};pw3=(u32x4){PKW(pB1,8),PKW(pB1,10),PKW(pB1,12),PKW(pB1,14)};
    SBAR(); pv(o,vb0+sl_cur,PAF(0),PAF(1),PAF(2),PAF(3)); }
  #undef PKW
  #undef PAF
  #undef VFR
  #undef PIN
  #undef MX3
  #undef GAPA
  #undef GAPB
  #undef EX
  #undef VRD
  #undef KRD
  #undef STEP
  #undef ENDW
  {auto rr=__builtin_amdgcn_permlane32_swap(__float_as_uint(l_reg),__float_as_uint(l_reg),false,false);l_reg=__uint_as_float(rr[0])+__uint_as_float(rr[1]);}
  if(hi==0)wsf[32+r32]=l_reg;asm volatile("s_waitcnt lgkmcnt(0)":::"memory");
  float rli[16];
  #pragma unroll
  for(int r=0;r<16;++r)rli[r]=__builtin_amdgcn_rcpf(wsf[32+crow(r,hi)]);
  bf16*Ow=Ou+(long)(wid*QBLK)*OP;
  { bf16*stg=(bf16*)(shm+LDS_OST)+wid*2048;
    #pragma unroll
    for(int r=0;r<16;++r){const int orow=crow(r,hi);
      #pragma unroll
      for(int d0=0;d0<2;++d0)stg[orow*64+d0*32+r32]=__float2bfloat16(o[d0][r]*rli[r]);}
    asm volatile("s_waitcnt lgkmcnt(0)":::"memory");
    #pragma unroll
    for(int i=0;i<4;++i){const int row=i*8+(lane>>3),ch=lane&7; const u32x4 v=*(const u32x4*)(stg+row*64+ch*8); ATTN_STORE16(Ow+(long)row*OP+ch*8,v);} }
  asm volatile("s_waitcnt lgkmcnt(0)\n\ts_barrier":::"memory");
  #undef DMA_K
  #undef DMA_V
  #undef CMASK
  #undef START
  #undef RESC
  #undef ROT
}
constexpr int ATTN_LDS_BYTES=LDS_BYTES;
#undef SBAR
#undef WAIT_BAR
}
#define GAS __attribute__((address_space(1)))
#define LAS __attribute__((address_space(3)))
typedef unsigned short bf16;
typedef unsigned v4u __attribute__((ext_vector_type(4)));
typedef float f32x4 __attribute__((ext_vector_type(4)));
typedef short bf16x8 __attribute__((ext_vector_type(8)));
typedef GAS unsigned gu32;
typedef GAS unsigned long long gu64;
#define RLX_AGENT __ATOMIC_RELAXED, __HIP_MEMORY_SCOPE_AGENT
#define LDS_WAIT() asm volatile("s_waitcnt lgkmcnt(0)" ::: "memory")
#define VM_WAIT() asm volatile("s_waitcnt vmcnt(0)" ::: "memory")
__device__ __forceinline__ unsigned long long rt() { return __builtin_amdgcn_s_memrealtime(); }
__device__ __forceinline__ unsigned f2bf(float f) { unsigned u = __builtin_bit_cast(unsigned, f); return (u + 0x7fffu + ((u >> 16) & 1u)) >> 16; }
__device__ __forceinline__ unsigned pk2(float lo, float hi) { return f2bf(lo) | (f2bf(hi) << 16); }

#define XB_TMO      128
#define XB_XCNT(j)  (256  + 64 * (j))
#define XB_XSUB(j)  (1280 + 64 * (j))
#define XB_XGEN(j)  (2304 + 64 * (j))
#define XB_TOP      3328
#define XB_TOPGEN   3392
#define XCD_BAR_WORDS 3456
#define XB_SPIN_CAP (1u << 18)

__device__ __forceinline__ unsigned xb_ld(unsigned* p)              { return __hip_atomic_load(p, __ATOMIC_RELAXED, __HIP_MEMORY_SCOPE_AGENT); }
__device__ __forceinline__ unsigned xb_add(unsigned* p, unsigned v) { return __hip_atomic_fetch_add(p, v, __ATOMIC_RELAXED, __HIP_MEMORY_SCOPE_AGENT); }
__device__ __forceinline__ unsigned xb_xcc_id() { return (unsigned)__builtin_amdgcn_s_getreg((3 << 11) | 20) & 0xFu; }
#define XB_SPIN(cond, bar) do { unsigned _sp = 0; while (cond) { __builtin_amdgcn_s_sleep(1); \
    if ((++_sp & 255u) == 0u) { if (xb_ld(&(bar)[XB_TMO])) break; if (_sp > XB_SPIN_CAP) { atomicAdd(&(bar)[XB_TMO], 1u); break; } } } } while (0)

struct XcdBarrier {
    unsigned* bar; unsigned x;
    volatile LAS unsigned* st;
};

__device__ __forceinline__ XcdBarrier xcd_barrier_post(unsigned* bar, volatile LAS unsigned* st) {
    XcdBarrier b; b.bar = bar; b.x = xb_xcc_id(); b.st = st;
    if (threadIdx.x == 0) (void)xb_add(&bar[XB_XCNT(b.x)], 1u);
    return b;
}
__device__ __forceinline__ void xcd_barrier_complete(unsigned* bar, unsigned x, unsigned& nloc, unsigned& nx) {
    const unsigned G = gridDim.x * gridDim.y * gridDim.z;
    unsigned sum, cnt, mine, sp = 0u;
    for (;;) {
        sum = 0u; cnt = 0u; mine = 0u;
#pragma unroll
        for (unsigned j = 0; j < 16; ++j) { const unsigned c = xb_ld(&bar[XB_XCNT(j)]); sum += c; cnt += (c > 0u) ? 1u : 0u; mine = (j == x) ? c : mine; }
        if (sum == G) break;
        __builtin_amdgcn_s_sleep(1);
        if ((++sp & 255u) == 0u) { if (xb_ld(&bar[XB_TMO])) break; if (sp > XB_SPIN_CAP) { atomicAdd(&bar[XB_TMO], 1u); break; } }
    }
    nloc = mine > 0u ? mine : 1u; nx = cnt > 0u ? cnt : 1u;
}

__device__ __forceinline__ void xcd_barrier(const XcdBarrier& b) {
    asm volatile("s_waitcnt vmcnt(0)" ::: "memory");
    __syncthreads();
    if (threadIdx.x == 0) {
        unsigned* bar = b.bar;
        __builtin_amdgcn_s_waitcnt(0);
        unsigned nloc = b.st[0], nx = b.st[1];
        if (nloc == 0u) { xcd_barrier_complete(bar, b.x, nloc, nx); b.st[0] = nloc; b.st[1] = nx; }
        const unsigned old = xb_add(&bar[XB_XSUB(b.x)], 1u);
        const unsigned gen = old / nloc;
        if (old + 1u == (gen + 1u) * nloc) {
            __builtin_amdgcn_fence(__ATOMIC_RELEASE, "agent");
            asm volatile("s_waitcnt vmcnt(0)" ::: "memory");
            const unsigned og = xb_add(&bar[XB_TOP], 1u);
            const unsigned tg = og / nx;
            if (og + 1u == (tg + 1u) * nx) xb_add(&bar[XB_TOPGEN], 1u);
            else XB_SPIN(xb_ld(&bar[XB_TOPGEN]) == tg, bar);
            __builtin_amdgcn_fence(__ATOMIC_ACQUIRE, "agent");
            xb_add(&bar[XB_XGEN(b.x)], 1u);
            asm volatile("s_waitcnt vmcnt(0)" ::: "memory");
        } else {
            XB_SPIN(xb_ld(&bar[XB_XGEN(b.x)]) == gen, bar);
            __builtin_amdgcn_fence(__ATOMIC_ACQUIRE, "agent");
            asm volatile("s_waitcnt vmcnt(0)" ::: "memory");
        }
    }
    __syncthreads();
}
#ifndef FFT_HD
#define FFT_HD __device__ __forceinline__
#endif
struct __attribute__((aligned(8))) cpx { float x, y; };
FFT_HD cpx cadd(cpx a, cpx b) { return cpx{a.x + b.x, a.y + b.y}; }
FFT_HD cpx csub(cpx a, cpx b) { return cpx{a.x - b.x, a.y - b.y}; }
FFT_HD cpx cmul(cpx a, cpx b) { return cpx{a.x * b.x - a.y * b.y, a.x * b.y + a.y * b.x}; }
template <int SGN> FFT_HD cpx cmuli(cpx d) { return SGN > 0 ? cpx{-d.y, d.x} : cpx{d.y, -d.x}; }
template <int SGN> FFT_HD void dft4(cpx& u0, cpx& u1, cpx& u2, cpx& u3) {
    const cpx a0 = cadd(u0, u2), a1 = csub(u0, u2), b0 = cadd(u1, u3), b1 = cmuli<SGN>(csub(u1, u3));
    u0 = cadd(a0, b0); u2 = csub(a0, b0); u1 = cadd(a1, b1); u3 = csub(a1, b1);
}
template <int SGN> FFT_HD void dft8(cpx (&u)[8]) {
    dft4<SGN>(u[0], u[2], u[4], u[6]); dft4<SGN>(u[1], u[3], u[5], u[7]);
    const float H = 0.70710678118654752f;
    const cpx E0 = u[0], E1 = u[2], E2 = u[4], E3 = u[6];
    const cpx O0 = u[1], O1 = cmul(u[3], cpx{H, SGN * H}), O2 = cmuli<SGN>(u[5]), O3 = cmul(u[7], cpx{-H, SGN * H});
    u[0] = cadd(E0, O0); u[4] = csub(E0, O0); u[1] = cadd(E1, O1); u[5] = csub(E1, O1);
    u[2] = cadd(E2, O2); u[6] = csub(E2, O2); u[3] = cadd(E3, O3); u[7] = csub(E3, O3);
}
template <int SGN> FFT_HD void dft16(cpx (&u)[16]) {
    cpx e[8], o[8];
#pragma unroll
    for (int k = 0; k < 8; ++k) { e[k] = u[2 * k]; o[k] = u[2 * k + 1]; }
    dft8<SGN>(e); dft8<SGN>(o);
    const float C[8] = {1.f, 0.92387953251128674f, 0.70710678118654752f, 0.38268343236508977f, 0.f, -0.38268343236508977f, -0.70710678118654752f, -0.92387953251128674f};
    const float S[8] = {0.f, 0.38268343236508977f, 0.70710678118654752f, 0.92387953251128674f, 1.f, 0.92387953251128674f, 0.70710678118654752f, 0.38268343236508977f};
#pragma unroll
    for (int k = 0; k < 8; ++k) { const cpx t = cmul(o[k], cpx{C[k], SGN * S[k]}); u[k] = cadd(e[k], t); u[k + 8] = csub(e[k], t); }
}
FFT_HD int fpad(int n) { return n + (n >> 4); }
template <class BufPtr> FFT_HD cpx fft_ld(BufPtr buf, int i) { cpx v; v.x = buf[i].x; v.y = buf[i].y; return v; }
template <class BufPtr> FFT_HD void fft_st(BufPtr buf, int i, cpx v) { buf[i].x = v.x; buf[i].y = v.y; }
constexpr int FFT_N = 8192, FFT_BUF_ELEMS = FFT_N + FFT_N / 16;
#if defined(FFT_HOST_TEST)
static inline cpx fft_tw(float frac, int sgn) { const double a = 6.283185307179586476925 * (double)frac; return cpx{(float)cos(a), (float)(sgn * sin(a))}; }
#else
FFT_HD cpx fft_tw(float frac, int sgn) { return cpx{__builtin_amdgcn_cosf(frac), (float)sgn * __builtin_amdgcn_sinf(frac)}; }
#endif
template <int SGN, class BufPtr> FFT_HD void fft_p1_store(int tid, cpx (&u)[16], BufPtr buf) {
    dft16<SGN>(u);
#pragma unroll
    for (int r = 0; r < 16; ++r) fft_st(buf + 17 * tid, r, u[r]);
}
template <int SGN, int P, class BufPtr> FFT_HD void fft_p8_load(int tid, cpx (&u)[16], BufPtr buf) {
#pragma unroll
    for (int hlf = 0; hlf < 2; ++hlf) { const int i = tid + 512 * hlf, k = i & (P - 1);
        const cpx w1 = fft_tw((float)k * (1.0f / (float)(P * 8)), SGN), w2 = cmul(w1, w1), w3 = cmul(w2, w1), w4 = cmul(w2, w2), w5 = cmul(w4, w1), w6 = cmul(w3, w3), w7 = cmul(w4, w3);
        cpx v[8];
#pragma unroll
        for (int r = 0; r < 8; ++r) v[r] = fft_ld(buf + fpad(i), 1088 * r);
        v[1] = cmul(v[1], w1); v[2] = cmul(v[2], w2); v[3] = cmul(v[3], w3); v[4] = cmul(v[4], w4); v[5] = cmul(v[5], w5); v[6] = cmul(v[6], w6); v[7] = cmul(v[7], w7);
        dft8<SGN>(v);
#pragma unroll
        for (int r = 0; r < 8; ++r) u[8 * hlf + r] = v[r]; }
}
template <int P, class BufPtr> FFT_HD void fft_p8_store(int tid, const cpx (&u)[16], BufPtr buf) {
#pragma unroll
    for (int hlf = 0; hlf < 2; ++hlf) { const int i = tid + 512 * hlf, k = i & (P - 1), j = (i - k) * 8 + k;
#pragma unroll
        for (int r = 0; r < 8; ++r) fft_st(buf + fpad(j), r * (P + P / 16), u[8 * hlf + r]); }
}
FFT_HD void fft_regs_to_p1(const cpx (&u)[16], cpx (&v)[16]) {
#pragma unroll
    for (int r = 0; r < 8; ++r) { v[2 * r] = u[r]; v[2 * r + 1] = u[8 + r]; }
}
constexpr int NWAVES = 8;
constexpr int DM = 1024, NB = 4, SEQ = 4096, CTXL = 256, NLAT = NB * SEQ, NCTX = NB * CTXL, NTOK = NLAT + NCTX;
constexpr int DIN = 2304, NEXP = 32, DEPTH = 2, KVLEN = SEQ + CTXL;
constexpr int CQ = 0, CK = 512, CV = 640, CHY = 768, CNQ = 1536, CNK = 1792, CNV = 2048;
constexpr int MAXSORT = 77824;
constexpr float LN_EPS = 1e-6f, DN_ALPHA = 1.41421356237f;
constexpr float C2 = 0.125f * 1.4426950408889634f;
constexpr float W1_SCALE = 64.f, W2_SCALE = 128.f;
constexpr int PH_PER_LAYER = 10;
constexpr int NPHASE = 2 + PH_PER_LAYER * DEPTH;
#ifndef PROBE_MASK
#define PROBE_MASK 0
#endif
#define REPS(bit) for (int rep_ = 0; rep_ < 1 + ((PROBE_MASK >> (bit)) & 1); ++rep_)

constexpr size_t MiB = 1u << 20;
constexpr size_t WS_CTL = 0, CTL_ZERO_BYTES = 1 * MiB;
constexpr size_t WS_WIN = 2 * MiB, WS_WOUT = 12 * MiB, WS_W1 = 16 * MiB, WS_W2 = 272 * MiB, WS_MOD = 400 * MiB;
constexpr size_t WS_FILT = 402 * MiB, WS_FILTC = 418 * MiB, WS_X = 420 * MiB, WS_H = 488 * MiB, WS_P = 522 * MiB, WS_Q = 600 * MiB;
constexpr size_t WS_K = 618 * MiB, WS_V = 623 * MiB, WS_X0 = 628 * MiB, WS_ZT = 638 * MiB, WS_ZTC = 654 * MiB, WS_NQC = 655 * MiB, WS_YMIX = 656 * MiB;
constexpr size_t WS_Y = 690 * MiB, WS_ROUTE = 724 * MiB, WS_AS = 728 * MiB, WS_ACT = 880 * MiB, WS_Y4 = 1032 * MiB, WS_GF = 1168 * MiB, WS_YC = 1200 * MiB, WS_X1 = 1216 * MiB, WS_H8 = 1284 * MiB, WS_END = 1302 * MiB;
constexpr size_t RT_TOPI = 0, RT_GATE = 69632, RT_SLOTPOS = 139264, RT_CNT = 208896, RT_TT = 217088, RT_ROWSLOT = 218112;
static_assert((RT_ROWSLOT + MAXSORT) * 4 <= 4 * MiB, "route region");
constexpr int CW_BAR = 4096, CW_WCMAX = 8192;
constexpr size_t RT_SH = 300000;
static_assert((RT_SH + NTOK) * 4 <= 4 * MiB, "route region");

constexpr int RING_OFF = 0, RING_BYTES = 147456;
constexpr int LDSCTL_OFF = RING_BYTES, LDSCTL_BYTES = 4096, LDS_TT_OFF = LDSCTL_OFF + 1024;
constexpr int LDS_BYTES = RING_BYTES + LDSCTL_BYTES;

__device__ __forceinline__ float bf2f(unsigned short h) { return __uint_as_float(((unsigned)h) << 16); }
__device__ __forceinline__ float bflo(unsigned w) { return __uint_as_float(w << 16); }
__device__ __forceinline__ float bfhi(unsigned w) { return __uint_as_float(w & 0xffff0000u); }
__device__ __forceinline__ unsigned pk4_i8(float a, float b, float c, float d) {
    const int q0 = __float2int_rn(a), q1 = __float2int_rn(b), q2 = __float2int_rn(c), q3 = __float2int_rn(d);
    return (unsigned)(q0 & 255) | ((unsigned)(q1 & 255) << 8) | ((unsigned)(q2 & 255) << 16) | ((unsigned)q3 << 24);
}
__device__ __forceinline__ unsigned pk4_fp8(float a, float b, float c, float d) {
    a = fminf(fmaxf(a, -448.f), 448.f); b = fminf(fmaxf(b, -448.f), 448.f); c = fminf(fmaxf(c, -448.f), 448.f); d = fminf(fmaxf(d, -448.f), 448.f);
    unsigned w = 0u; w = (unsigned)__builtin_amdgcn_cvt_pk_fp8_f32(a, b, (int)w, false); w = (unsigned)__builtin_amdgcn_cvt_pk_fp8_f32(c, d, (int)w, true); return w;
}
__device__ __forceinline__ float wave_sum(float v) {
    v += __builtin_bit_cast(float, __builtin_amdgcn_update_dpp(0, __builtin_bit_cast(int, v), 0xB1, 0xF, 0xF, true));
    v += __builtin_bit_cast(float, __builtin_amdgcn_update_dpp(0, __builtin_bit_cast(int, v), 0x4E, 0xF, 0xF, true));
    v += __builtin_bit_cast(float, __builtin_amdgcn_update_dpp(0, __builtin_bit_cast(int, v), 0x141, 0xF, 0xF, true));
    v += __builtin_bit_cast(float, __builtin_amdgcn_update_dpp(0, __builtin_bit_cast(int, v), 0x140, 0xF, 0xF, true));
    const int vi = __builtin_bit_cast(int, v);
    const float r0 = __builtin_bit_cast(float, __builtin_amdgcn_readlane(vi, 0)), r1 = __builtin_bit_cast(float, __builtin_amdgcn_readlane(vi, 16));
    const float r2 = __builtin_bit_cast(float, __builtin_amdgcn_readlane(vi, 32)), r3 = __builtin_bit_cast(float, __builtin_amdgcn_readlane(vi, 48));
    return (r0 + r1) + (r2 + r3);
}
__device__ __forceinline__ float wave_max(float v) {
    v = fmaxf(v, __builtin_bit_cast(float, __builtin_amdgcn_update_dpp(0, __builtin_bit_cast(int, v), 0xB1, 0xF, 0xF, true)));
    v = fmaxf(v, __builtin_bit_cast(float, __builtin_amdgcn_update_dpp(0, __builtin_bit_cast(int, v), 0x4E, 0xF, 0xF, true)));
    v = fmaxf(v, __builtin_bit_cast(float, __builtin_amdgcn_update_dpp(0, __builtin_bit_cast(int, v), 0x141, 0xF, 0xF, true)));
    v = fmaxf(v, __builtin_bit_cast(float, __builtin_amdgcn_update_dpp(0, __builtin_bit_cast(int, v), 0x140, 0xF, 0xF, true)));
    const int vi = __builtin_bit_cast(int, v);
    const float r0 = __builtin_bit_cast(float, __builtin_amdgcn_readlane(vi, 0)), r1 = __builtin_bit_cast(float, __builtin_amdgcn_readlane(vi, 16));
    const float r2 = __builtin_bit_cast(float, __builtin_amdgcn_readlane(vi, 32)), r3 = __builtin_bit_cast(float, __builtin_amdgcn_readlane(vi, 48));
    return fmaxf(fmaxf(r0, r1), fmaxf(r2, r3));
}

template <int CTRL> __device__ __forceinline__ float rs_fold(float X, float Y, bool keepY) {
    const float A = keepY ? Y : X, B = keepY ? X : Y;
    return A + __builtin_bit_cast(float, __builtin_amdgcn_update_dpp(0, __builtin_bit_cast(int, B), CTRL, 0xF, 0xF, true));
}
__device__ __forceinline__ float rs64(const float (&v)[64], int lane) {
    float z1[32], z2[16], z3[8], z4[4], z5[2];
#pragma unroll
    for (int i = 0; i < 32; ++i) { const auto r = __builtin_amdgcn_permlane32_swap(__float_as_uint(v[i]), __float_as_uint(v[i + 32]), false, false); z1[i] = __uint_as_float(r[0]) + __uint_as_float(r[1]); }
#pragma unroll
    for (int i = 0; i < 16; ++i) { const auto r = __builtin_amdgcn_permlane16_swap(__float_as_uint(z1[i]), __float_as_uint(z1[i + 16]), false, false); z2[i] = __uint_as_float(r[0]) + __uint_as_float(r[1]); }
    const bool b3 = lane & 8, b2 = lane & 4, b1 = lane & 2, b0 = lane & 1;
#pragma unroll
    for (int i = 0; i < 8; ++i) z3[i] = rs_fold<0x140>(z2[i], z2[i + 8], b3);
#pragma unroll
    for (int i = 0; i < 4; ++i) z4[i] = rs_fold<0x141>(z3[i], z3[i + 4], b2);
#pragma unroll
    for (int i = 0; i < 2; ++i) z5[i] = rs_fold<0x4E>(z4[i], z4[i + 2], b1);
    return rs_fold<0xB1>(z5[0], z5[1], b0);
}

struct Frame {
    LAS unsigned char* lds;
    volatile LAS unsigned* MISC;
    gu32* ctl;
    int tid, lane, wave;
    int vcu, G;
    float* out;
    unsigned char* ws;
};
typedef __attribute__((address_space(4))) const char* kargp_t;
__device__ __forceinline__ const float* inp(int i) {
#if defined(__HIP_DEVICE_COMPILE__)
    kargp_t base = (kargp_t)__builtin_amdgcn_kernarg_segment_ptr();
    asm volatile("" : "+s"(base));
    typedef const float* cfp_t;
    return *(__attribute__((address_space(4))) const cfp_t*)(base + 8 * i);
#else
    return nullptr;
#endif
}
#define INP(i) inp(i)
#define IN_X 0
#define IN_C 1
#define IN_CTX 2
#define IN_CCTX 3
#define IN_ADAW 4
#define IN_ADAB 5
#define IN_WIN 6
#define IN_WOUT 7
#define IN_QG 8
#define IN_KG 9
#define IN_HCW 10
#define IN_HCB 11
#define IN_HW1 12
#define IN_HB1 13
#define IN_HFREQ 14
#define IN_HW2 15
#define IN_HB2 16
#define IN_HW3 17
#define IN_HB3 18
#define IN_HD 19
#define IN_RPB 20
#define IN_LN1G 21
#define IN_LN1B 22
#define IN_LN2G 23
#define IN_LN2B 24
#define IN_RW 25
#define IN_RB 26
#define IN_EW1 27
#define IN_EB1 28
#define IN_EW2 29
#define IN_EB2 30

#define WSP(T, off) ((T*)(F.ws + (off)))

__device__ __forceinline__ void p0_transpose_item(const float* W, int K, int N, bf16* WT, int row_off, LAS float* scr, int item, int lane) {
    const int nblk = N / 64, kb = item / nblk, nb = item % nblk, k0 = 64 * kb, n0 = 64 * nb;
    const int n4 = lane & 15, kr = lane >> 4;
    const float* src = W + (size_t)(k0 + kr) * N + n0 + 4 * n4;
    f32x4 v[16];
#pragma unroll
    for (int i = 0; i < 16; ++i) v[i] = __builtin_nontemporal_load((const f32x4*)(src + (size_t)(4 * i) * N));
#pragma unroll
    for (int i = 0; i < 16; ++i) { LAS float* d = scr + (4 * i + kr) * 65 + 4 * n4; d[0] = v[i].x; d[1] = v[i].y; d[2] = v[i].z; d[3] = v[i].w; }
    LDS_WAIT(); asm volatile("" ::: "memory");
    const int c = lane & 7;
#pragma unroll
    for (int j = 0; j < 8; ++j) { const int n = (lane >> 3) + 8 * j; const LAS float* s = scr + (8 * c) * 65 + n;
        v4u o; o.x = pk2(s[0 * 65], s[1 * 65]); o.y = pk2(s[2 * 65], s[3 * 65]); o.z = pk2(s[4 * 65], s[5 * 65]); o.w = pk2(s[6 * 65], s[7 * 65]);
        *(GAS v4u*)(WT + (size_t)(row_off + n0 + n) * K + k0 + 8 * c) = o; }
    LDS_WAIT(); asm volatile("" ::: "memory");
}

__device__ __forceinline__ void p0_transpose_item8(const float* W, int K, int N, unsigned char* WT, int row_off, float scale, LAS float* scr, int item, int lane) {
    const int nblk = N / 64, kb = item / nblk, nb = item % nblk, k0 = 64 * kb, n0 = 64 * nb;
    const int n4 = lane & 15, kr = lane >> 4;
    const float* src = W + (size_t)(k0 + kr) * N + n0 + 4 * n4;
    f32x4 v[16];
#pragma unroll
    for (int i = 0; i < 16; ++i) v[i] = __builtin_nontemporal_load((const f32x4*)(src + (size_t)(4 * i) * N));
#pragma unroll
    for (int i = 0; i < 16; ++i) { LAS float* d = scr + (4 * i + kr) * 65 + 4 * n4; d[0] = v[i].x; d[1] = v[i].y; d[2] = v[i].z; d[3] = v[i].w; }
    LDS_WAIT(); asm volatile("" ::: "memory");
    const int c = lane & 7;
#pragma unroll
    for (int j = 0; j < 8; ++j) { const int n = (lane >> 3) + 8 * j; const LAS float* s = scr + (8 * c) * 65 + n;
        const unsigned lo = pk4_fp8(s[0 * 65] * scale, s[1 * 65] * scale, s[2 * 65] * scale, s[3 * 65] * scale), hi = pk4_fp8(s[4 * 65] * scale, s[5 * 65] * scale, s[6 * 65] * scale, s[7 * 65] * scale);
        *(GAS unsigned long long*)(WT + (size_t)(row_off + n0 + n) * K + k0 + 8 * c) = (unsigned long long)lo | ((unsigned long long)hi << 32); }
    LDS_WAIT(); asm volatile("" ::: "memory");
}

struct XItem { const float* src; unsigned char* dst; int N; float scale; };
__device__ __forceinline__ XItem p0_xitem(Frame& F, const float* ew1, const float* ew2, int it, int lane) {
    constexpr int PER_E1 = 8 * 64, PER_E2 = 8 * 32, PER_L = NEXP * (PER_E1 + PER_E2);
    const int l = it / PER_L; int r = it % PER_L; XItem x; const int n4 = lane & 7, kr = lane >> 3;
    if (r < NEXP * PER_E1) { const int e = r / PER_E1, rr = r % PER_E1, kb = rr / 64, nb = rr % 64, k0 = 128 * kb, n0 = 32 * nb;
        const int drow = n0 < 1024 ? 256 * (n0 / 128) + (n0 % 128) : 256 * ((n0 - 1024) / 128) + 128 + ((n0 - 1024) % 128);
        x.src = ew1 + (size_t)(l * NEXP + e) * DM * 2048 + (size_t)(k0 + kr) * 2048 + n0 + 4 * n4; x.N = 2048; x.scale = W1_SCALE;
        x.dst = WSP(unsigned char, WS_W1) + (size_t)(l * NEXP + e) * 2048 * DM + (size_t)drow * DM + k0; }
    else { r -= NEXP * PER_E1; const int e = r / PER_E2, rr = r % PER_E2, kb = rr / 32, nb = rr % 32, k0 = 128 * kb, n0 = 32 * nb;
        x.src = ew2 + (size_t)(l * NEXP + e) * DM * DM + (size_t)(k0 + kr) * DM + n0 + 4 * n4; x.N = DM; x.scale = W2_SCALE;
        x.dst = WSP(unsigned char, WS_W2) + (size_t)(l * NEXP + e) * DM * DM + (size_t)n0 * DM + k0; }
    return x;
}
__device__ __forceinline__ void p0_xload(const XItem& x, f32x4 (&v)[16]) {
#pragma unroll
    for (int i = 0; i < 16; ++i) v[i] = __builtin_nontemporal_load((const f32x4*)(x.src + (size_t)(8 * i) * x.N));
}
__device__ __forceinline__ void p0_xstore(const XItem& x, const f32x4 (&v)[16], LAS float* scr, int lane) {
    LAS unsigned char* t8 = (LAS unsigned char*)scr; const int n4 = lane & 7, kr = lane >> 3; const float scale = x.scale;
#pragma unroll
    for (int i = 0; i < 16; ++i) { const unsigned w = pk4_fp8(v[i].x * scale, v[i].y * scale, v[i].z * scale, v[i].w * scale); const int k = kr + 8 * i;
        t8[(4 * n4 + 0) * 144 + k] = (unsigned char)w; t8[(4 * n4 + 1) * 144 + k] = (unsigned char)(w >> 8); t8[(4 * n4 + 2) * 144 + k] = (unsigned char)(w >> 16); t8[(4 * n4 + 3) * 144 + k] = (unsigned char)(w >> 24); }
    LDS_WAIT(); asm volatile("" ::: "memory");
#pragma unroll
    for (int j = 0; j < 4; ++j) { const int n = (lane >> 3) + 8 * j, c = lane & 7;
        const v4u o = *(const LAS v4u*)(t8 + n * 144 + 16 * c); *(GAS v4u*)(x.dst + (size_t)n * DM + 16 * c) = o; }
    LDS_WAIT(); asm volatile("" ::: "memory");
}
__device__ __forceinline__ void p0_expert_weights(Frame& F, LAS float* scr, int it_lo, int it_hi) {
    const int gw = F.vcu * NWAVES + F.wave, NGW = F.G * NWAVES, lane = F.lane;
    const float* ew1 = INP(IN_EW1); const float* ew2 = INP(IN_EW2);
    int it = it_lo + gw; if (it >= it_hi) return;
    XItem cur = p0_xitem(F, ew1, ew2, it, lane); f32x4 vc[16]; p0_xload(cur, vc);
    for (;;) { const int nx = it + NGW; const bool more = nx < it_hi;
        XItem nxt = cur; f32x4 vn[16];
        if (more) { nxt = p0_xitem(F, ew1, ew2, nx, lane); p0_xload(nxt, vn); }
        p0_xstore(cur, vc, scr, lane);
        if (!more) break;
        cur = nxt; it = nx;
#pragma unroll
        for (int i = 0; i < 16; ++i) vc[i] = vn[i]; }
}

__device__ __forceinline__ void p0_wmax_item(Frame& F, int it) {
    const int l = it / 288, r = it % 288, nb = r / 8, kc = r % 8, n = nb * 64 + F.lane;
    const float* W = INP(IN_WIN) + (size_t)l * DM * DIN + (size_t)(kc * 128) * DIN + n; float mx = 0.f;
#pragma unroll 16
    for (int k = 0; k < 128; ++k) mx = fmaxf(mx, fabsf(W[(size_t)k * DIN]));
    __hip_atomic_fetch_max((int*)(F.ctl + CW_WCMAX) + l * DIN + n, __float_as_int(mx), __ATOMIC_RELAXED, __HIP_MEMORY_SCOPE_AGENT);
}
__device__ __forceinline__ void p1_win_i8_item(Frame& F, int it, LAS float* scr) {
    const int lane = F.lane, l = it / 576, r = it % 576, kb = r / 36, nb = r % 36, k0 = 64 * kb, n0 = 64 * nb;
    const int n4 = lane & 15, kr = lane >> 4;
    const float* src = INP(IN_WIN) + (size_t)l * DM * DIN + (size_t)(k0 + kr) * DIN + n0 + 4 * n4;
    f32x4 v[16];
#pragma unroll
    for (int i = 0; i < 16; ++i) v[i] = *(const f32x4*)(src + (size_t)(4 * i) * DIN);
#pragma unroll
    for (int i = 0; i < 16; ++i) { LAS float* d = scr + (4 * i + kr) * 65 + 4 * n4; d[0] = v[i].x; d[1] = v[i].y; d[2] = v[i].z; d[3] = v[i].w; }
    LDS_WAIT(); asm volatile("" ::: "memory");
    const int c = lane & 7; unsigned char* WT = WSP(unsigned char, WS_WIN) + (size_t)l * DIN * DM;
#pragma unroll
    for (int j = 0; j < 8; ++j) { const int n = (lane >> 3) + 8 * j; const LAS float* s = scr + (8 * c) * 65 + n;
        const float cm = __int_as_float(__hip_atomic_load((int*)(F.ctl + CW_WCMAX) + l * DIN + n0 + n, __ATOMIC_RELAXED, __HIP_MEMORY_SCOPE_AGENT)), sc = cm > 0.f ? 127.f / cm : 0.f;
        const unsigned lo = pk4_i8(s[0 * 65] * sc, s[1 * 65] * sc, s[2 * 65] * sc, s[3 * 65] * sc), hi = pk4_i8(s[4 * 65] * sc, s[5 * 65] * sc, s[6 * 65] * sc, s[7 * 65] * sc);
        *(GAS unsigned long long*)(WT + (size_t)(n0 + n) * DM + k0 + 8 * c) = (unsigned long long)lo | ((unsigned long long)hi << 32); }
    LDS_WAIT(); asm volatile("" ::: "memory");
}

__device__ __forceinline__ void p0_mod_item(Frame& F, int it) {
    const int l = it / 96, cb = it % 96, col = cb * 64 + F.lane, kbase = F.wave * 128;
    const float* W = INP(IN_ADAW) + (size_t)l * DM * 6144 + (size_t)kbase * 6144 + col;
    const float* c = INP(IN_C) + kbase; const float* cc = INP(IN_CCTX) + kbase;
    float a0 = 0.f, a1 = 0.f, a2 = 0.f, a3 = 0.f, a4 = 0.f;
#pragma unroll 16
    for (int k = 0; k < 128; ++k) {
        const float w = W[(size_t)k * 6144];
        const float c0 = c[k], c1 = c[DM + k], c2 = c[2 * DM + k], c3 = c[3 * DM + k], c4 = cc[k];
        a0 += (c0 / (1.f + __expf(-c0))) * w; a1 += (c1 / (1.f + __expf(-c1))) * w; a2 += (c2 / (1.f + __expf(-c2))) * w;
        a3 += (c3 / (1.f + __expf(-c3))) * w; a4 += (c4 / (1.f + __expf(-c4))) * w;
    }
    LAS float* part = (LAS float*)(F.lds + RING_OFF);
    part[(F.wave * 5 + 0) * 64 + F.lane] = a0; part[(F.wave * 5 + 1) * 64 + F.lane] = a1; part[(F.wave * 5 + 2) * 64 + F.lane] = a2;
    part[(F.wave * 5 + 3) * 64 + F.lane] = a3; part[(F.wave * 5 + 4) * 64 + F.lane] = a4;
    __syncthreads();
    if (F.wave < 5) { float s = INP(IN_ADAB)[l * 6144 + col];
#pragma unroll
        for (int w = 0; w < 8; ++w) s += part[(w * 5 + F.wave) * 64 + F.lane];
        WSP(float, WS_MOD)[(size_t)(l * 5 + F.wave) * 6144 + col] = s; }
    __syncthreads();
}

__device__ __forceinline__ void p0_filter_item(Frame& F, int it) {
    const int lane = F.lane;
    const int l = it / 4352, rr = it % 4352, type = rr >= 4096 ? 1 : 0, t = type ? rr - 4096 : rr, L = type ? 256 : 4096;
    const float tn = (float)t / (float)(L - 1);
    const float w = (6.283185307179586f / (float)L) * (float)t;
    float zv = 0.f;
    if (lane == 0) zv = tn;
    else if (lane <= 16) { const float band = 1e-4f + (float)(lane - 1) * ((15.0f - 1e-4f) / 15.0f); zv = cosf(band * w); }
    else if (lane <= 32) { const float band = 1e-4f + (float)(lane - 17) * ((15.0f - 1e-4f) / 15.0f); zv = -sinf(band * w); }
    const float* w1 = INP(IN_HW1) + l * 33 * 64; const float* w2 = INP(IN_HW2) + l * 64 * 64; const float* w3 = INP(IN_HW3) + l * 64 * 512;
    float a = INP(IN_HB1)[l * 64 + lane];
#pragma unroll
    for (int k = 0; k < 33; ++k) a += __shfl(zv, k) * w1[k * 64 + lane];
    const float h1 = sinf(INP(IN_HFREQ)[l * 128 + lane] * a);
    float a2 = INP(IN_HB2)[l * 64 + lane];
#pragma unroll 16
    for (int k = 0; k < 64; ++k) a2 += __shfl(h1, k) * w2[k * 64 + lane];
    const float h2 = sinf(INP(IN_HFREQ)[l * 128 + 64 + lane] * a2);
    float o[8]; const float* b3p = INP(IN_HB3) + l * 512 + lane;
#pragma unroll
    for (int i = 0; i < 8; ++i) o[i] = b3p[64 * i];
#pragma unroll 8
    for (int k = 0; k < 64; ++k) { const float hk = __shfl(h2, k);
#pragma unroll
        for (int i = 0; i < 8; ++i) o[i] += hk * w3[k * 512 + lane + 64 * i]; }
    float* dst = type ? WSP(float, WS_FILTC) + (size_t)l * 2 * 256 * 256 : WSP(float, WS_FILT) + (size_t)l * 2 * 256 * 4096;
#pragma unroll
    for (int i = 0; i < 8; ++i) { const int c = lane + 64 * i, dir = c >> 8, ch = c & 255;
        const float ad = 3.0701134573253945f + (float)ch * ((15.350567286626973f - 3.0701134573253945f) / 255.0f);
        dst[((size_t)dir * 256 + ch) * L + t] = o[i] * expf(-tn * ad); }
}

__device__ __forceinline__ void ph_prologue(Frame& F) {
    LAS float* scr = (LAS float*)(F.lds + RING_OFF + F.wave * 16640);
    const int gw = F.vcu * NWAVES + F.wave, NGW = F.G * NWAVES;
    constexpr int I_IN = 16 * 36, I_OUT = 16 * 16, I_W1 = 32 * 16 * 32, I_W2 = 32 * 16 * 16, I_L = I_IN + I_OUT + I_W1 + I_W2;
    for (int it = F.vcu; it < 192; it += F.G) p0_mod_item(F, it);
    for (int it = gw; it < 2 * 4352; it += NGW) p0_filter_item(F, it);
    for (int it = gw; it < 2 * 288; it += NGW) p0_wmax_item(F, it);
    for (int it = gw; it < 2 * I_OUT; it += NGW) p0_transpose_item(INP(IN_WOUT) + (size_t)(it / I_OUT) * DM * DM, DM, DM, WSP(bf16, WS_WOUT) + (size_t)(it / I_OUT) * DM * DM, 0, scr, it % I_OUT, F.lane);
    p0_expert_weights(F, scr, 0, 2 * NEXP * (16 * 32 + 16 * 16));
}

__device__ __forceinline__ void row_stats(const f32x4 (&v)[4], float& mean, float& rstd) {
    float s = 0.f;
#pragma unroll
    for (int j = 0; j < 4; ++j) s += (v[j].x + v[j].y) + (v[j].z + v[j].w);
    mean = wave_sum(s) * (1.f / DM); float s2 = 0.f;
#pragma unroll
    for (int j = 0; j < 4; ++j) { const f32x4 d = v[j] - mean; s2 += (d.x * d.x + d.y * d.y) + (d.z * d.z + d.w * d.w); }
    rstd = 1.f / sqrtf(wave_sum(s2) * (1.f / DM) + LN_EPS);
}
__device__ __forceinline__ const float* modp(Frame& F, int l, int bsel, int which) { return WSP(float, WS_MOD) + ((size_t)(l * 5 + bsel) * 6 + which) * DM; }
__device__ __forceinline__ void modulate_store(Frame& F, const f32x4 (&v)[4], const f32x4 (&sh)[4], const f32x4 (&sc)[4], bf16* orow, f32x4 (&hv)[4]) {
    float mean, rstd; row_stats(v, mean, rstd);
    GAS unsigned long long* o8 = (GAS unsigned long long*)orow + F.lane;
#pragma unroll
    for (int j = 0; j < 4; ++j) { hv[j] = (v[j] - mean) * rstd * (sc[j] + 1.0f) + sh[j];
        o8[64 * j] = (unsigned long long)pk2(hv[j].x, hv[j].y) | ((unsigned long long)pk2(hv[j].z, hv[j].w) << 32); }
}
__device__ __forceinline__ void modulate_store8(Frame& F, const f32x4 (&v)[4], const f32x4 (&sh)[4], const f32x4 (&sc)[4], unsigned char* orow, f32x4 (&hv)[4]) {
    float mean, rstd; row_stats(v, mean, rstd);
    GAS unsigned* o4 = (GAS unsigned*)orow + F.lane;
#pragma unroll
    for (int j = 0; j < 4; ++j) { hv[j] = (v[j] - mean) * rstd * (sc[j] + 1.0f) + sh[j]; o4[64 * j] = pk4_fp8(hv[j].x, hv[j].y, hv[j].z, hv[j].w); }
}
__device__ __forceinline__ void modulate_store_i8(Frame& F, const f32x4 (&v)[4], const f32x4 (&sh)[4], const f32x4 (&sc)[4], unsigned char* orow, float* srow) {
    float mean, rstd; row_stats(v, mean, rstd); f32x4 hv[4]; float mx = 0.f;
#pragma unroll
    for (int j = 0; j < 4; ++j) { hv[j] = (v[j] - mean) * rstd * (sc[j] + 1.0f) + sh[j]; mx = fmaxf(mx, fmaxf(fmaxf(fabsf(hv[j].x), fabsf(hv[j].y)), fmaxf(fabsf(hv[j].z), fabsf(hv[j].w)))); }
    mx = wave_max(mx); const float q = mx > 0.f ? 127.f / mx : 0.f;
    GAS unsigned* o4 = (GAS unsigned*)orow + F.lane;
#pragma unroll
    for (int j = 0; j < 4; ++j) o4[64 * j] = pk4_i8(hv[j].x * q, hv[j].y * q, hv[j].z * q, hv[j].w * q);
    if (F.lane == 0) *srow = mx * (1.f / 127.f);
}
__device__ __forceinline__ void ldvec(const float* p, int lane, f32x4 (&d)[4]) {
#pragma unroll
    for (int j = 0; j < 4; ++j) d[j] = ((const f32x4*)p)[lane + 64 * j];
}
__device__ __forceinline__ void ph_r0(Frame& F) {
    const int gw = F.vcu * NWAVES + F.wave, NGW = F.G * NWAVES, lane = F.lane;
    const float* xin = INP(IN_X); const float* cin = INP(IN_CTX);
    for (int rA = gw; rA < NTOK; rA += 2 * NGW) {
        f32x4 v[2][4], sh[2][4], sc[2][4];
#pragma unroll
        for (int q = 0; q < 2; ++q) { const int r0 = rA + q * NGW, r = r0 < NTOK ? r0 : rA; const int bsel = r < NLAT ? r / SEQ : 4;
            ldvec(r < NLAT ? xin + (size_t)r * DM : cin + (size_t)(r - NLAT) * DM, lane, v[q]); ldvec(modp(F, 0, bsel, 0), lane, sh[q]); ldvec(modp(F, 0, bsel, 1), lane, sc[q]); }
#pragma unroll
        for (int q = 0; q < 2; ++q) { const int r = rA + q * NGW; if (r < NTOK) modulate_store_i8(F, v[q], sh[q], sc[q], WSP(unsigned char, WS_H) + (size_t)r * DM, WSP(float, WS_ROUTE) + RT_SH + r); }
    }
}

__device__ __forceinline__ void unpack8(const v4u raw, float (&x)[8]) {
    x[0] = bflo(raw.x); x[1] = bfhi(raw.x); x[2] = bflo(raw.y); x[3] = bfhi(raw.y); x[4] = bflo(raw.z); x[5] = bfhi(raw.z); x[6] = bflo(raw.w); x[7] = bfhi(raw.w);
}
__device__ __forceinline__ v4u pack8(const float (&x)[8]) { v4u o; o.x = pk2(x[0], x[1]); o.y = pk2(x[2], x[3]); o.z = pk2(x[4], x[5]); o.w = pk2(x[6], x[7]); return o; }
__device__ __forceinline__ void head_norm_rope(float (&x)[8], const float* gain, int lane, bool rope, const f32x4 (&cs4)[2], const f32x4 (&sn4)[2]) {
    float ss = 0.f;
#pragma unroll
    for (int i = 0; i < 8; ++i) ss += x[i] * x[i];
    ss += __shfl_xor(ss, 1); ss += __shfl_xor(ss, 2); ss += __shfl_xor(ss, 4);
    const float rinv = 1.f / sqrtf(ss * (1.f / 64.f) + LN_EPS);
    const int d0 = (lane & 7) * 8;
#pragma unroll
    for (int i = 0; i < 8; ++i) x[i] = x[i] * rinv * gain[d0 + i];
    const int half = (lane >> 1) & 1;
#pragma unroll
    for (int i = 0; i < 8; ++i) {
        const float pv = __shfl_xor(x[i], 2);
        if (rope) { const float cs = cs4[i >> 2][i & 3], sn = sn4[i >> 2][i & 3]; x[i] = x[i] * cs + (half ? pv : -pv) * sn; }
    }
}
__device__ __forceinline__ void ph_prep(Frame& F, int l) {
    const int gw = F.vcu * NWAVES + F.wave, NGW = F.G * NWAVES, lane = F.lane;
    const bf16* P = WSP(bf16, WS_P);
    const float* qg = INP(IN_QG) + l * 64; const float* kg = INP(IN_KG) + l * 64;
    LAS float* tabc = (LAS float*)(F.lds + RING_OFF + 8 * 16640); LAS float* tabs = tabc + 1024;
    for (int idx = F.tid; idx < 1024; idx += 512) { const float ang = (float)(idx >> 4) * exp2f(-(float)(idx & 15) * (13.287712379549449f / 16.0f)); tabc[idx] = cosf(ang); tabs[idx] = sinf(ang); }
    __syncthreads();
    v4u rq_n = {0u, 0u, 0u, 0u}, rk_n = {0u, 0u, 0u, 0u};
    if (gw < NTOK) { const bf16* prow = P + (size_t)gw * DIN; rq_n = *(const GAS v4u*)(prow + CQ + lane * 8); rk_n = *(const GAS v4u*)(prow + CK + (lane & 31) * 8); }
    for (int r = gw; r < NTOK; r += NGW) {
        const bool lat = r < NLAT; const int b = lat ? r / SEQ : (r - NLAT) / CTXL, t = lat ? r % SEQ : (r - NLAT) % CTXL, gr = t >> 6, gc = t & 63;
        const v4u rq = rq_n, raw = rk_n;
        if (r + NGW < NTOK) { const bf16* pn = P + (size_t)(r + NGW) * DIN; rq_n = *(const GAS v4u*)(pn + CQ + lane * 8); rk_n = *(const GAS v4u*)(pn + CK + (lane & 31) * 8); }
        f32x4 cs4[2], sn4[2];
        { const int pos = ((lane >> 2) & 1) ? gc : gr; const LAS f32x4* pc = (const LAS f32x4*)(tabc + pos * 16 + (lane & 1) * 8); const LAS f32x4* ps = (const LAS f32x4*)(tabs + pos * 16 + (lane & 1) * 8);
          cs4[0] = pc[0]; cs4[1] = pc[1]; sn4[0] = ps[0]; sn4[1] = ps[1]; }
        if (lat || l == 0) {
            float x[8]; unpack8(rq, x);
            head_norm_rope(x, qg, lane, lat, cs4, sn4);
#pragma unroll
            for (int i = 0; i < 8; ++i) x[i] *= C2;
            *(GAS v4u*)(WSP(bf16, WS_Q) + (size_t)r * 512 + lane * 8) = pack8(x);
        }
        {
            float x[8]; unpack8(raw, x);
            head_norm_rope(x, kg, lane, lat, cs4, sn4);
            const size_t krow = (size_t)b * KVLEN + (lat ? t : SEQ + t);
            if (lane < 16) *(GAS v4u*)(WSP(bf16, WS_K) + krow * 128 + lane * 8) = pack8(x);
            else if (lane < 32) *(GAS v4u*)(WSP(bf16, WS_V) + krow * 128 + (lane - 16) * 8) = raw;
        }
    }
    LAS float* tile = (LAS float*)(F.lds + RING_OFF + F.wave * 16640);
    const int nitems = 1024 + (l == 0 ? 64 : 0);
    const float* cw = INP(IN_HCW) + l * 3 * 768; const float* cbias = INP(IN_HCB) + l * 768;
    for (int it = gw; it < nitems; it += NGW) {
        const int type = it >= 1024 ? 1 : 0, ii = type ? it - 1024 : it;
        const int L = type ? CTXL : SEQ, ntb = L / 64;
        const int cb = ii & 3, tb = (ii >> 2) % ntb, b = (ii >> 2) / ntb;
        const int rowbase = type ? NLAT + b * CTXL : b * SEQ, t0 = tb * 64, ch = cb * 64 + lane;
        float w[3][3], bs[3];
#pragma unroll
        for (int g = 0; g < 3; ++g) { bs[g] = cbias[g * 256 + ch];
#pragma unroll
            for (int j = 0; j < 3; ++j) w[j][g] = cw[j * 768 + g * 256 + ch]; }
        float inn[3][18];
#define CONV_LOAD(ck_) do { const int tb0_ = t0 + 16 * (ck_); _Pragma("unroll") for (int g = 0; g < 3; ++g) { const bf16* pg = P + (size_t)(rowbase + tb0_) * DIN + CHY + g * 256 + ch; \
            inn[g][0] = tb0_ > 0 ? bf2f(pg[-(ptrdiff_t)DIN]) : 0.f; _Pragma("unroll") for (int q = 0; q < 16; ++q) inn[g][1 + q] = bf2f(pg[(size_t)q * DIN]); \
            inn[g][17] = (tb0_ + 16 < L) ? bf2f(pg[(size_t)16 * DIN]) : 0.f; } } while (0)
        CONV_LOAD(0);
#pragma unroll 1
        for (int ck = 0; ck < 4; ++ck) { const int tb0 = t0 + 16 * ck; float in[3][18];
#pragma unroll
            for (int g = 0; g < 3; ++g)
#pragma unroll
                for (int q = 0; q < 18; ++q) in[g][q] = inn[g][q];
            if (ck < 3) CONV_LOAD(ck + 1);
#pragma unroll
            for (int q = 0; q < 16; ++q) { float cv[3];
#pragma unroll
                for (int g = 0; g < 3; ++g) cv[g] = in[g][q] * w[0][g] + in[g][q + 1] * w[1][g] + in[g][q + 2] * w[2][g] + bs[g];
                WSP(bf16, WS_X0)[(size_t)(rowbase + tb0 + q) * 256 + ch] = (bf16)f2bf(cv[0]);
                tile[(16 * ck + q) * 65 + lane] = cv[1] * cv[2]; } }
        LDS_WAIT(); asm volatile("" ::: "memory");
        float* zt = type ? WSP(float, WS_ZTC) + ((size_t)b * 256 + cb * 64) * CTXL + t0 : WSP(float, WS_ZT) + ((size_t)b * 256 + cb * 64) * SEQ + t0;
#pragma unroll 8
        for (int i = 0; i < 64; ++i) zt[(size_t)i * L + lane] = tile[lane * 65 + i];
        LDS_WAIT(); asm volatile("" ::: "memory");
    }
}

typedef float f32x16 __attribute__((ext_vector_type(16)));
__device__ __forceinline__ int crow16(int r, int hi) { return (r & 3) + 8 * (r >> 2) + 4 * hi; }
__device__ __forceinline__ void na_wave_unit(Frame& F, const float* rpb_lh, int b, int h, int qr, int half, LAS unsigned char* wl) {
    const int lane = F.lane, r32 = lane & 31, hi = lane >> 5;
    const bf16* P = WSP(bf16, WS_P);
    LAS unsigned short* Vl = (LAS unsigned short*)wl;
    LAS float* tab = (LAS float*)(wl + 9216 + 512);
    LAS float* sc = (LAS float*)(wl + 12800);
    for (int i = lane; i < 465; i += 64) tab[i] = rpb_lh[i] * 1.4426950408889634f;
    const int qc = 32 * half + r32, rsq = min(max(qr - 4, 0), 56), csq = min(max(qc - 8, 0), 48);
    const int qtok = b * SEQ + qr * 64 + 32 * half;
    bf16x8 qf[4];
#pragma unroll
    for (int s = 0; s < 4; ++s) qf[s] = *(const bf16x8*)(P + (size_t)(qtok + r32) * DIN + CNQ + h * 64 + 16 * s + 8 * hi);
    f32x16 o0, o1;
#pragma unroll
    for (int i = 0; i < 16; ++i) { o0[i] = 0.f; o1[i] = 0.f; }
    float mrun = -INFINITY, lsum = 0.f;
    const size_t koff = (size_t)r32 * DIN + CNK + h * 64 + 8 * hi;
    const size_t voff = (size_t)(lane >> 2) * DIN + CNV + h * 64 + (lane & 3) * 8;
    typedef short v4i16_t __attribute__((ext_vector_type(4)));
    const LAS unsigned char* vtrb = (const LAS unsigned char*)Vl + ((lane >> 4) & 1) * 32 + (lane & 3) * 8 + (4 * hi + ((lane & 15) >> 2)) * 64;
    bf16x8 kn[2][4]; v4u vn[8];
    { const bf16* rb = P + (size_t)(NLAT + b * CTXL) * DIN;
#pragma unroll
      for (int kb = 0; kb < 2; ++kb)
#pragma unroll
          for (int s = 0; s < 4; ++s) kn[kb][s] = *(const bf16x8*)(rb + koff + (size_t)kb * 32 * DIN + 16 * s);
#pragma unroll
      for (int i = 0; i < 8; ++i) vn[i] = *(const GAS v4u*)(rb + voff + (size_t)(16 * (i & 3)) * DIN + 32 * (i >> 2)); }
    for (int t = 0; t < 12; ++t) {
        bf16x8 kc[2][4]; v4u vc[8];
#pragma unroll
        for (int kb = 0; kb < 2; ++kb)
#pragma unroll
            for (int s = 0; s < 4; ++s) kc[kb][s] = kn[kb][s];
#pragma unroll
        for (int i = 0; i < 8; ++i) { vc[i] = vn[i]; *(LAS v4u*)((LAS unsigned char*)Vl + i * 1024 + lane * 16) = vc[i]; }
        if (t + 1 < 12) { const int tn = t + 1; const int krow0 = tn < 4 ? NLAT + b * CTXL + 64 * tn : b * SEQ + (rsq + tn - 4) * 64; const bf16* rb = P + (size_t)krow0 * DIN;
#pragma unroll
            for (int kb = 0; kb < 2; ++kb)
#pragma unroll
                for (int s = 0; s < 4; ++s) kn[kb][s] = *(const bf16x8*)(rb + koff + (size_t)kb * 32 * DIN + 16 * s);
#pragma unroll
            for (int i = 0; i < 8; ++i) vn[i] = *(const GAS v4u*)(rb + voff + (size_t)(16 * (i & 3)) * DIN + 32 * (i >> 2)); }
        f32x16 s0, s1;
#pragma unroll
        for (int i = 0; i < 16; ++i) { s0[i] = 0.f; s1[i] = 0.f; }
#pragma unroll
        for (int s = 0; s < 4; ++s) { s0 = __builtin_amdgcn_mfma_f32_32x32x16_bf16(kc[0][s], qf[s], s0, 0, 0, 0); s1 = __builtin_amdgcn_mfma_f32_32x32x16_bf16(kc[1][s], qf[s], s1, 0, 0, 0); }
        if (t >= 4) { const int kr = rsq + t - 4; const LAS float* br = tab + (kr - qr + 7) * 31 + 15 - qc + 4 * hi; const int d0 = 4 * hi - csq;
#pragma unroll
            for (int i = 0; i < 16; ++i) { const int c = (i & 3) + 8 * (i >> 2);
                s0[i] = ((unsigned)(c + d0) < 16u) ? s0[i] + br[c] : -INFINITY;
                s1[i] = ((unsigned)(c + 32 + d0) < 16u) ? s1[i] + br[c + 32] : -INFINITY; } }
        float mx = fmaxf(s0[0], s1[0]);
#pragma unroll
        for (int i = 1; i < 16; ++i) mx = fmaxf(mx, fmaxf(s0[i], s1[i]));
        mx = fmaxf(mx, __shfl_xor(mx, 32));
        if (__any(mx > mrun)) {
            const float mn = fmaxf(mrun, mx), alpha = __builtin_amdgcn_exp2f(mrun - mn); mrun = mn; lsum *= alpha;
            if (hi == 0) sc[r32] = alpha;
#pragma unroll
            for (int i = 0; i < 16; ++i) { const float a = sc[crow16(i, hi)]; o0[i] *= a; o1[i] *= a; } }
        float psum = 0.f;
#pragma unroll
        for (int i = 0; i < 16; ++i) { s0[i] = __builtin_amdgcn_exp2f(s0[i] - mrun); s1[i] = __builtin_amdgcn_exp2f(s1[i] - mrun); psum += s0[i] + s1[i]; }
        lsum += psum;
#pragma unroll
        for (int ks = 0; ks < 4; ++ks) {
            v4u pw;
            if (ks == 0) { pw.x = pg8::cvt_pk_bf16(s0[0], s0[1]); pw.y = pg8::cvt_pk_bf16(s0[2], s0[3]); pw.z = pg8::cvt_pk_bf16(s0[4], s0[5]); pw.w = pg8::cvt_pk_bf16(s0[6], s0[7]); }
            else if (ks == 1) { pw.x = pg8::cvt_pk_bf16(s0[8], s0[9]); pw.y = pg8::cvt_pk_bf16(s0[10], s0[11]); pw.z = pg8::cvt_pk_bf16(s0[12], s0[13]); pw.w = pg8::cvt_pk_bf16(s0[14], s0[15]); }
            else if (ks == 2) { pw.x = pg8::cvt_pk_bf16(s1[0], s1[1]); pw.y = pg8::cvt_pk_bf16(s1[2], s1[3]); pw.z = pg8::cvt_pk_bf16(s1[4], s1[5]); pw.w = pg8::cvt_pk_bf16(s1[6], s1[7]); }
            else { pw.x = pg8::cvt_pk_bf16(s1[8], s1[9]); pw.y = pg8::cvt_pk_bf16(s1[10], s1[11]); pw.z = pg8::cvt_pk_bf16(s1[12], s1[13]); pw.w = pg8::cvt_pk_bf16(s1[14], s1[15]); }
            const bf16x8 pf = __builtin_bit_cast(bf16x8, pw);
#pragma unroll
            for (int dh = 0; dh < 2; ++dh) { const LAS unsigned char* vp = vtrb + dh * 4096 + ks * 1024;
                const v4i16_t lo = __builtin_amdgcn_ds_read_tr16_b64_v4i16((LAS v4i16_t*)vp), hv_ = __builtin_amdgcn_ds_read_tr16_b64_v4i16((LAS v4i16_t*)(vp + 512));
                const bf16x8 vf = {lo[0], lo[1], lo[2], lo[3], hv_[0], hv_[1], hv_[2], hv_[3]};
                if (dh == 0) o0 = __builtin_amdgcn_mfma_f32_32x32x16_bf16(pf, vf, o0, 0, 0, 0); else o1 = __builtin_amdgcn_mfma_f32_32x32x16_bf16(pf, vf, o1, 0, 0, 0); }
        }
    }
    lsum += __shfl_xor(lsum, 32);
    if (hi == 0) sc[32 + r32] = lsum;
    LAS unsigned short* stg = Vl;
#pragma unroll
    for (int i = 0; i < 16; ++i) { const int q = crow16(i, hi); const float rl = 1.0f / sc[32 + q];
        stg[q * 64 + r32] = (unsigned short)f2bf(o0[i] * rl); stg[q * 64 + 32 + r32] = (unsigned short)f2bf(o1[i] * rl); }
    bf16* Ow = WSP(bf16, WS_YMIX) + (size_t)qtok * DM + 768 + h * 64;
#pragma unroll
    for (int i = 0; i < 4; ++i) { const int row = i * 8 + (lane >> 3), ch = lane & 7; const v4u v = *(const LAS v4u*)(stg + row * 64 + ch * 8); *(GAS v4u*)(Ow + (size_t)row * DM + ch * 8) = v; }
}

constexpr int HY_OFF = 4099, HY_GN = 8196;
__device__ __forceinline__ void hy_item(Frame& F, const float* hd_l, int l, int type, int b, int c) {
    const int tid = F.tid, L = type ? CTXL : SEQ;
    LAS float* G = (LAS float*)(F.lds + RING_OFF); LAS float* Z = G + 8208; LAS float* red = Z + 4096;
    const float* hf = type ? WSP(float, WS_FILTC) + ((size_t)(l * 2 + 0) * 256 + c) * CTXL : WSP(float, WS_FILT) + ((size_t)(l * 2 + 0) * 256 + c) * SEQ;
    const float* hb = type ? WSP(float, WS_FILTC) + ((size_t)(l * 2 + 1) * 256 + c) * CTXL : WSP(float, WS_FILT) + ((size_t)(l * 2 + 1) * 256 + c) * SEQ;
    const float* zt = type ? WSP(float, WS_ZTC) + ((size_t)b * 256 + c) * CTXL : WSP(float, WS_ZT) + ((size_t)b * 256 + c) * SEQ;
    float ssq = 0.f;
    for (int idx = tid; idx < HY_GN; idx += 512) { const int lag = idx - HY_OFF; float v = 0.f;
        if (lag >= 0 && lag < L) v = hf[lag]; else if (lag < 0 && -lag < L) v = hb[-lag];
        G[idx] = v; ssq += v * v; }
    for (int idx = tid; idx < L; idx += 512) Z[idx] = zt[idx];
    ssq = wave_sum(ssq); if (F.lane == 0) red[F.wave] = ssq;
    __syncthreads();
    float tot = 0.f;
#pragma unroll
    for (int i = 0; i < 8; ++i) tot += red[i];
    const float nscale = 1.f / sqrtf(tot + LN_EPS);
    if (tid * 8 < L) {
        const int t0 = tid * 8; float acc[8], w[16];
#pragma unroll
        for (int i = 0; i < 8; ++i) acc[i] = 0.f;
#pragma unroll
        for (int m = 8; m < 15; ++m) w[m] = G[HY_OFF + t0 - 7 + m];
        for (int s0 = 0; s0 < L; s0 += 8) {
            const f32x4 g0 = *(const LAS f32x4*)(G + HY_OFF + t0 - s0 - 7), g1 = *(const LAS f32x4*)(G + HY_OFF + t0 - s0 - 3);
            w[0] = g0.x; w[1] = g0.y; w[2] = g0.z; w[3] = g0.w; w[4] = g1.x; w[5] = g1.y; w[6] = g1.z; w[7] = g1.w;
            const f32x4 z0 = *(const LAS f32x4*)(Z + s0), z1 = *(const LAS f32x4*)(Z + s0 + 4);
            const float zz[8] = {z0.x, z0.y, z0.z, z0.w, z1.x, z1.y, z1.z, z1.w};
#pragma unroll
            for (int i = 0; i < 8; ++i)
#pragma unroll
                for (int j = 0; j < 8; ++j) acc[i] += w[i - j + 7] * zz[j];
#pragma unroll
            for (int m = 14; m >= 8; --m) w[m] = w[m - 8];
        }
        const float dsk = hd_l[c]; const int rowbase = type ? NLAT + b * CTXL : b * SEQ;
#pragma unroll
        for (int i = 0; i < 8; ++i) { const int t = t0 + i; const float y = acc[i] * nscale + Z[t] * dsk;
            const float x0 = bf2f(WSP(bf16, WS_X0)[(size_t)(rowbase + t) * 256 + c]);
            WSP(bf16, WS_YMIX)[(size_t)(rowbase + t) * DM + 512 + c] = (bf16)f2bf(y * x0); }
    }
    __syncthreads();
}

__device__ __forceinline__ void hy_ctx_item(Frame& F, const float* hd_l, int l, int c) {
    const int tid = F.tid; constexpr int L = CTXL;
    LAS float* G = (LAS float*)(F.lds + RING_OFF); LAS float* Z = G + 8208; LAS float* red = Z + 4096;
    const float* hf = WSP(float, WS_FILTC) + ((size_t)(l * 2 + 0) * 256 + c) * CTXL; const float* hb = WSP(float, WS_FILTC) + ((size_t)(l * 2 + 1) * 256 + c) * CTXL;
    float ssq = 0.f;
    for (int idx = HY_OFF - 272 + tid; idx < HY_OFF + 272; idx += 512) { const int lag = idx - HY_OFF; float v = 0.f;
        if (lag >= 0 && lag < L) v = hf[lag]; else if (lag < 0 && -lag < L) v = hb[-lag];
        G[idx] = v; ssq += v * v; }
    for (int idx = tid; idx < 4 * L; idx += 512) Z[idx] = (WSP(float, WS_ZTC) + ((size_t)(idx >> 8) * 256 + c) * CTXL)[idx & 255];
    ssq = wave_sum(ssq); if (F.lane == 0) red[F.wave] = ssq;
    __syncthreads();
    float tot = 0.f;
#pragma unroll
    for (int i = 0; i < 8; ++i) tot += red[i];
    const float nscale = 1.f / sqrtf(tot + LN_EPS);
    if (tid < 128) {
        const int b = tid >> 5, t0 = (tid & 31) * 8; const LAS float* Zb = Z + b * L; float acc[8], w[16];
#pragma unroll
        for (int i = 0; i < 8; ++i) acc[i] = 0.f;
#pragma unroll
        for (int m = 8; m < 15; ++m) w[m] = G[HY_OFF + t0 - 7 + m];
        for (int s0 = 0; s0 < L; s0 += 8) {
            const f32x4 g0 = *(const LAS f32x4*)(G + HY_OFF + t0 - s0 - 7), g1 = *(const LAS f32x4*)(G + HY_OFF + t0 - s0 - 3);
            w[0] = g0.x; w[1] = g0.y; w[2] = g0.z; w[3] = g0.w; w[4] = g1.x; w[5] = g1.y; w[6] = g1.z; w[7] = g1.w;
            const f32x4 z0 = *(const LAS f32x4*)(Zb + s0), z1 = *(const LAS f32x4*)(Zb + s0 + 4);
            const float zz[8] = {z0.x, z0.y, z0.z, z0.w, z1.x, z1.y, z1.z, z1.w};
#pragma unroll
            for (int i = 0; i < 8; ++i)
#pragma unroll
                for (int j = 0; j < 8; ++j) acc[i] += w[i - j + 7] * zz[j];
#pragma unroll
            for (int m = 14; m >= 8; --m) w[m] = w[m - 8];
        }
        const float dsk = hd_l[c]; const int rowbase = NLAT + b * CTXL;
#pragma unroll
        for (int i = 0; i < 8; ++i) { const int t = t0 + i; const float y = acc[i] * nscale + Zb[t] * dsk;
            const float x0 = bf2f(WSP(bf16, WS_X0)[(size_t)(rowbase + t) * 256 + c]);
            WSP(bf16, WS_YMIX)[(size_t)(rowbase + t) * DM + 512 + c] = (bf16)f2bf(y * x0); }
    }
    __syncthreads();
}
#define FFT_SYNC() __syncthreads()
template <class T> __device__ __forceinline__ T* sgpr_ptr(T* p) { asm volatile("" : "+s"(p)); return p; }
template <int SGN> __device__ __forceinline__ void fft_mid_passes(int tid, cpx (&u)[16], LAS cpx* buf) {
    int t1 = tid; asm volatile("" : "+v"(t1)); FFT_SYNC(); fft_p8_load<SGN, 16>(t1, u, buf); FFT_SYNC(); fft_p8_store<16>(t1, u, buf);
    int t2 = tid; asm volatile("" : "+v"(t2)); FFT_SYNC(); fft_p8_load<SGN, 128>(t2, u, buf); FFT_SYNC(); fft_p8_store<128>(t2, u, buf);
    int t3 = tid; asm volatile("" : "+v"(t3)); FFT_SYNC(); fft_p8_load<SGN, 1024>(t3, u, buf);
}
__device__ __forceinline__ void hy_spectrum_item(Frame& F, int l, int c) {
    const int tid = F.tid; LAS cpx* buf = (LAS cpx*)(F.lds + RING_OFF); LAS float* red = (LAS float*)(F.lds + RING_OFF + FFT_BUF_ELEMS * 8);
    const float* hf = WSP(float, WS_FILT) + ((size_t)(l * 2 + 0) * 256 + c) * SEQ; const float* hb = WSP(float, WS_FILT) + ((size_t)(l * 2 + 1) * 256 + c) * SEQ;
    cpx u[16]; float ssq = 0.f;
#pragma unroll
    for (int r = 0; r < 16; ++r) { const int n = tid + 512 * r; float g;
        if (r < 8) g = sgpr_ptr(hf + 512 * r)[tid]; else g = (n == SEQ) ? 0.f : sgpr_ptr(hb + 2 * SEQ - 512 * r)[-tid];
        u[r] = cpx{g, 0.f}; ssq += g * g; }
    ssq = wave_sum(ssq); if (F.lane == 0) red[F.wave] = ssq;
    fft_p1_store<-1>(tid, u, buf);
    fft_mid_passes<-1>(tid, u, buf);
    float tot = 0.f;
#pragma unroll
    for (int i = 0; i < 8; ++i) tot += red[i];
    const float sc = (1.f / sqrtf(tot + LN_EPS)) * (1.f / (float)FFT_N);
    cpx* gf = WSP(cpx, WS_GF) + (size_t)(l * 256 + c) * FFT_N;
#pragma unroll
    for (int hlf = 0; hlf < 2; ++hlf)
#pragma unroll
        for (int r = 0; r < 8; ++r) sgpr_ptr(gf + 512 * hlf + 1024 * r)[tid] = cpx{u[8 * hlf + r].x * sc, u[8 * hlf + r].y * sc};
    FFT_SYNC();
}
__device__ __forceinline__ void hy_fft_item(Frame& F, const float* hd_l, int l, int c, int bp) {
    const int tid = F.tid; LAS cpx* buf = (LAS cpx*)(F.lds + RING_OFF);
    const float* z0 = WSP(float, WS_ZT) + ((size_t)(2 * bp) * 256 + c) * SEQ; const float* z1 = z0 + (size_t)256 * SEQ;
    cpx zin[8], u[16];
#pragma unroll
    for (int m8 = 0; m8 < 8; ++m8) { zin[m8] = cpx{sgpr_ptr(z0 + 512 * m8)[tid], sgpr_ptr(z1 + 512 * m8)[tid]}; u[m8] = zin[m8]; u[8 + m8] = cpx{0.f, 0.f}; }
    fft_p1_store<-1>(tid, u, buf);
    fft_mid_passes<-1>(tid, u, buf);
    const cpx* gf = WSP(cpx, WS_GF) + (size_t)(l * 256 + c) * FFT_N;
#pragma unroll
    for (int hlf = 0; hlf < 2; ++hlf)
#pragma unroll
        for (int r = 0; r < 8; ++r) u[8 * hlf + r] = cmul(u[8 * hlf + r], sgpr_ptr(gf + 512 * hlf + 1024 * r)[tid]);
    cpx v[16]; fft_regs_to_p1(u, v);
    FFT_SYNC();
    fft_p1_store<1>(tid, v, buf);
    fft_mid_passes<1>(tid, v, buf);
    const float dsk = hd_l[c];
    float* y0 = WSP(float, WS_YC) + ((size_t)(2 * bp) * 256 + c) * SEQ; float* y1 = y0 + (size_t)256 * SEQ;
#pragma unroll
    for (int hlf = 0; hlf < 2; ++hlf)
#pragma unroll
        for (int r = 0; r < 4; ++r) { const int m8 = hlf + 2 * r; sgpr_ptr(y0 + 512 * m8)[tid] = v[8 * hlf + r].x + zin[m8].x * dsk; sgpr_ptr(y1 + 512 * m8)[tid] = v[8 * hlf + r].y + zin[m8].y * dsk; }
    FFT_SYNC();
}
__device__ __forceinline__ void ph_hy_post(Frame& F) {
    const int gw = F.vcu * NWAVES + F.wave, NGW = F.G * NWAVES, lane = F.lane;
    LAS float* tile = (LAS float*)(F.lds + RING_OFF + F.wave * 16640);
    for (int it = gw; it < 1024; it += NGW) {
        const int cb = it & 3, tb = (it >> 2) & 63, b = it >> 8, t0 = tb * 64, c0 = cb * 64;
        const float* yc = WSP(float, WS_YC) + ((size_t)b * 256 + c0) * SEQ + t0;
#pragma unroll 1
        for (int ck = 0; ck < 4; ++ck) { float tv[16];
#pragma unroll
            for (int i = 0; i < 16; ++i) tv[i] = yc[(size_t)(16 * ck + i) * SEQ + lane];
#pragma unroll
            for (int i = 0; i < 16; ++i) tile[(16 * ck + i) * 65 + lane] = tv[i]; }
        LDS_WAIT(); asm volatile("" ::: "memory");
        const bf16* x0 = WSP(bf16, WS_X0) + (size_t)(b * SEQ + t0) * 256 + c0 + lane; bf16* ym = WSP(bf16, WS_YMIX) + (size_t)(b * SEQ + t0) * DM + 512 + c0 + lane;
#pragma unroll 1
        for (int ck = 0; ck < 4; ++ck) { float xv[16];
#pragma unroll
            for (int q = 0; q < 16; ++q) xv[q] = bf2f(x0[(size_t)(16 * ck + q) * 256]);
#pragma unroll
            for (int q = 0; q < 16; ++q) ym[(size_t)(16 * ck + q) * DM] = (bf16)f2bf(tile[lane * 65 + 16 * ck + q] * xv[q]); }
        LDS_WAIT(); asm volatile("" ::: "memory");
    }
}

__device__ __forceinline__ void ph_mixers(Frame& F, int l, char* lds_generic) {
    {
        typedef attn_body::bf16 abf;
        const abf* Qb = (const abf*)WSP(bf16, WS_Q); const abf* Kb = (const abf*)WSP(bf16, WS_K); const abf* Vb = (const abf*)WSP(bf16, WS_V);
        const abf* Pb = (const abf*)WSP(bf16, WS_P); abf* Ym = (abf*)WSP(bf16, WS_YMIX);
        const int nunits = 512 + (l == 0 ? 48 : 0);
        REPS(20) for (int u = F.vcu; u < nunits; u += F.G) {
            const abf *Qu, *Kh, *Vh; abf* Ou; int QP, KP, NT;
            if (u < 512) { const int bk = u >> 6, b = bk >> 1, kvh = bk & 1, hq = (u >> 4) & 3, qb = u & 15, head = kvh * 4 + hq;
                Qu = Qb + (size_t)(b * SEQ + qb * 256) * 512 + head * 64; Kh = Kb + (size_t)b * KVLEN * 128 + kvh * 64; Vh = Vb + (size_t)b * KVLEN * 128 + kvh * 64;
                Ou = Ym + (size_t)(b * SEQ + qb * 256) * DM + head * 64; QP = 512; KP = 128; NT = KVLEN / 64; }
            else if (u < 544) { const int j = u - 512, b = j >> 3, head = j & 7, kvh = head >> 2;
                Qu = Qb + (size_t)(NLAT + b * CTXL) * 512 + head * 64; Kh = Kb + ((size_t)b * KVLEN + SEQ) * 128 + kvh * 64; Vh = Vb + ((size_t)b * KVLEN + SEQ) * 128 + kvh * 64;
                Ou = Ym + (size_t)(NLAT + b * CTXL) * DM + head * 64; QP = 512; KP = 128; NT = 4; }
            else { const int j = u - 544, b = j >> 2, h = j & 3;
                Qu = Pb + (size_t)(NLAT + b * CTXL) * DIN + CNQ + h * 64; Kh = Pb + (size_t)(NLAT + b * CTXL) * DIN + CNK + h * 64; Vh = Pb + (size_t)(NLAT + b * CTXL) * DIN + CNV + h * 64;
                Ou = Ym + (size_t)(NLAT + b * CTXL) * DM + 768 + h * 64; QP = DIN; KP = DIN; NT = 4; }
            attn_body::attn_unit<8>(Qu, Kh, Vh, Ou, QP, KP, DM, NT, lds_generic, F.tid);
        }
    }
    __syncthreads();
    { Frame Fn = F; asm volatile("" : "+s"(Fn.ws), "+v"(Fn.tid), "+v"(Fn.lane), "+s"(Fn.wave));
      const int gw = Fn.vcu * NWAVES + Fn.wave, NGW = Fn.G * NWAVES;
      const float* rpb_l = INP(IN_RPB) + (size_t)l * 4 * 15 * 31;
      REPS(21) for (int w = gw; w < 2048; w += NGW) { const int h = (w >> 7) & 3; na_wave_unit(Fn, rpb_l + h * 15 * 31, w >> 9, h, (w >> 1) & 63, w & 1, Fn.lds + RING_OFF + Fn.wave * 16384); } }
    __syncthreads();
    { Frame Fh = F; asm volatile("" : "+s"(Fh.ws), "+v"(Fh.tid), "+v"(Fh.lane), "+s"(Fh.wave));
      const float* hd_l = INP(IN_HD) + l * 256;
      REPS(22) { for (int it = Fh.vcu; it < 512; it += Fh.G) hy_fft_item(Fh, hd_l, l, it >> 1, it & 1);
        if (l == 0) for (int it = Fh.vcu; it < 256; it += Fh.G) hy_ctx_item(Fh, hd_l, l, it); } }
}

__device__ __forceinline__ void ph_r1(Frame& F, int l) {
    const int tid = F.tid, lane = F.lane;
    LAS float* rwT = (LAS float*)(F.lds + RING_OFF);
    volatile LAS unsigned* cntL = F.MISC + 16;
    { const float* rw = INP(IN_RW) + (size_t)l * DM * NEXP;
      for (int i = tid; i < DM * NEXP / 4; i += 512) { const f32x4 v = ((const f32x4*)rw)[i]; const int k = i >> 3, e4 = (i & 7) * 4;
          rwT[(e4 + 0) * DM + k] = v.x; rwT[(e4 + 1) * DM + k] = v.y; rwT[(e4 + 2) * DM + k] = v.z; rwT[(e4 + 3) * DM + k] = v.w; } }
    LAS float* lnl = rwT + DM * NEXP;
    { const float* ln1g = INP(IN_LN1G) + l * DM; const float* ln1b = INP(IN_LN1B) + l * DM; for (int i = tid; i < DM; i += 512) { lnl[i] = ln1g[i]; lnl[DM + i] = ln1b[i]; } }
    if (tid < 32) cntL[tid] = 0u;
    __syncthreads();
    const int gw = F.vcu * NWAVES + F.wave, NGW = F.G * NWAVES, nrows = l == 0 ? NTOK : NLAT;
    const float* rb = INP(IN_RB) + l * NEXP; const float* xin = INP(IN_X); const float* cin = INP(IN_CTX);
    int* topi = WSP(int, WS_ROUTE) + RT_TOPI; float* gate = WSP(float, WS_ROUTE) + RT_GATE; int* slotpos = WSP(int, WS_ROUTE) + RT_SLOTPOS;
    const int myq = lane >> 5, mye = lane & 31; const float mybias = rb[mye];
    for (int rA = gw; rA < nrows; rA += 2 * NGW) {
        f32x4 hv[2][4];
        { f32x4 v[2][4];
#pragma unroll
          for (int q = 0; q < 2; ++q) { const int r0 = rA + q * NGW, r = r0 < nrows ? r0 : rA; const int bsel = r < NLAT ? r / SEQ : 4;
              const float* xsrc = l == 0 ? (r < NLAT ? xin + (size_t)r * DM : cin + (size_t)(r - NLAT) * DM) : WSP(float, WS_X) + (size_t)r * DM;
              const bf16* yrow = WSP(bf16, WS_Y) + (size_t)r * DM; const float* g1 = modp(F, l, bsel, 2);
#pragma unroll
              for (int j = 0; j < 4; ++j) { const f32x4 xv = ((const f32x4*)xsrc)[lane + 64 * j]; const f32x4 gv = ((const f32x4*)g1)[lane + 64 * j];
                  const unsigned long long yw = ((const GAS unsigned long long*)yrow)[lane + 64 * j];
                  const f32x4 yv = {bflo((unsigned)yw), bfhi((unsigned)yw), bflo((unsigned)(yw >> 32)), bfhi((unsigned)(yw >> 32))};
                  v[q][j] = xv * DN_ALPHA + gv * yv; }
              }
#pragma unroll
          for (int q = 0; q < 2; ++q) { const int r = rA + q * NGW;
              if (r < nrows) { float mean, rstd; row_stats(v[q], mean, rstd);
                  float* xdst = WSP(float, WS_X1) + (size_t)r * DM;
#pragma unroll
                  for (int j = 0; j < 4; ++j) { const f32x4 gg = ((const LAS f32x4*)lnl)[lane + 64 * j], bb = ((const LAS f32x4*)(lnl + DM))[lane + 64 * j];
                      v[q][j] = (v[q][j] - mean) * rstd * gg + bb; ((f32x4*)xdst)[lane + 64 * j] = v[q][j]; }
                  { const int bsel = r < NLAT ? r / SEQ : 4; f32x4 sh[4], sc[4]; ldvec(modp(F, l, bsel, 3), lane, sh); ldvec(modp(F, l, bsel, 4), lane, sc);
                    modulate_store8(F, v[q], sh, sc, WSP(unsigned char, WS_H8) + (size_t)r * DM, hv[q]); } }
              else {
#pragma unroll
                  for (int j = 0; j < 4; ++j) hv[q][j] = (f32x4){0.f, 0.f, 0.f, 0.f}; } } }
        typedef float f32x2r __attribute__((ext_vector_type(2)));
        unsigned rbase0 = (unsigned)(uintptr_t)rwT + 16u * (unsigned)lane, rbase1 = rbase0 + 65536u; asm volatile("" : "+v"(rbase0), "+v"(rbase1));
        float pv[64];
#pragma unroll
        for (int e = 0; e < 32; ++e) { f32x2r a0 = {0.f, 0.f}, a1 = {0.f, 0.f};
#pragma unroll
            for (int j = 0; j < 4; ++j) { const f32x4 w4 = *(const LAS f32x4*)(uintptr_t)((e < 16 ? rbase0 : rbase1) + (unsigned)((e & 15) * 4096 + 1024 * j));
                const f32x2r wl = {w4.x, w4.y}, wh = {w4.z, w4.w};
                a0 += (f32x2r){hv[0][j].x, hv[0][j].y} * wl; a0 += (f32x2r){hv[0][j].z, hv[0][j].w} * wh;
                a1 += (f32x2r){hv[1][j].x, hv[1][j].y} * wl; a1 += (f32x2r){hv[1][j].z, hv[1][j].w} * wh; }
            pv[e] = a0.x + a0.y; pv[32 + e] = a1.x + a1.y;
            if ((e & 3) == 3) asm volatile("" ::: "memory"); }
        const float mylg = rs64(pv, lane) + mybias;
        { const int fb = __float_as_int(mylg); int key = ((fb ^ ((fb >> 31) & 0x7fffffff)) & ~31) | (31 - mye);
          int te[2][4];
#pragma unroll
          for (int k = 0; k < 4; ++k) { int mk = key;
              mk = max(mk, __builtin_amdgcn_update_dpp(0, mk, 0xB1, 0xF, 0xF, true)); mk = max(mk, __builtin_amdgcn_update_dpp(0, mk, 0x4E, 0xF, 0xF, true));
              mk = max(mk, __builtin_amdgcn_update_dpp(0, mk, 0x141, 0xF, 0xF, true)); mk = max(mk, __builtin_amdgcn_update_dpp(0, mk, 0x140, 0xF, 0xF, true));
              const int mA = max(__builtin_amdgcn_readlane(mk, 0), __builtin_amdgcn_readlane(mk, 16)), mB = max(__builtin_amdgcn_readlane(mk, 32), __builtin_amdgcn_readlane(mk, 48));
              te[0][k] = 31 - (mA & 31); te[1][k] = 31 - (mB & 31);
              if (key == (myq ? mB : mA)) key = (int)0x80000000; }
#pragma unroll
          for (int q = 0; q < 2; ++q) { const int r = rA + q * NGW;
              if (r < nrows) { const int mli = __float_as_int(mylg);
                  const float t0 = __int_as_float(__builtin_amdgcn_readlane(mli, 32 * q + te[q][0])), t1 = __int_as_float(__builtin_amdgcn_readlane(mli, 32 * q + te[q][1]));
                  const float t2 = __int_as_float(__builtin_amdgcn_readlane(mli, 32 * q + te[q][2])), t3 = __int_as_float(__builtin_amdgcn_readlane(mli, 32 * q + te[q][3]));
                  const float e1 = __expf(t1 - t0), e2 = __expf(t2 - t0), e3 = __expf(t3 - t0); const float inv = 1.f / (1.f + e1 + e2 + e3);
                  if (lane < 4) { const int e = lane == 0 ? te[q][0] : lane == 1 ? te[q][1] : lane == 2 ? te[q][2] : te[q][3];
                      const float wg = (lane == 0 ? 1.f : lane == 1 ? e1 : lane == 2 ? e2 : e3) * inv;
                      const unsigned lp = __hip_atomic_fetch_add((LAS unsigned*)(cntL + e), 1u, __ATOMIC_RELAXED, __HIP_MEMORY_SCOPE_WORKGROUP);
                      topi[r * 4 + lane] = e; gate[r * 4 + lane] = wg; slotpos[r * 4 + lane] = (int)lp; } } } }
    }
    __syncthreads();
    if (tid < 32) (WSP(int, WS_ROUTE) + RT_CNT)[F.vcu * 32 + tid] = (int)cntL[tid];
}

__device__ __forceinline__ void ph_gather(Frame& F, int l) {
    const int tid = F.tid, lane = F.lane;
    volatile LAS int* sm = (volatile LAS int*)(F.lds + RING_OFF);
    const int* cnt = WSP(int, WS_ROUTE) + RT_CNT;
    { const int e = tid & 31, g = tid >> 5, per = (F.G + 15) / 16; int st = 0, sp = 0;
      for (int bb = 0; bb < per; ++bb) { const int blk = g * per + bb; if (blk < F.G) { const int v = cnt[blk * 32 + e]; st += v; if (blk < F.vcu) sp += v; } }
      sm[g * 32 + e] = st; sm[512 + g * 32 + e] = sp; }
    __syncthreads();
    if (tid < 32) { int tot = 0, pre = 0;
        for (int g = 0; g < 16; ++g) { tot += sm[g * 32 + tid]; pre += sm[512 + g * 32 + tid]; }
        sm[1024 + tid] = tot; sm[1056 + tid] = pre; }
    __syncthreads();
    if (tid == 0) { int base = 0; for (int e = 0; e < 32; ++e) { sm[1088 + e] = base; base += ((sm[1024 + e] + 255) / 256) * 256; } sm[1120] = base / 256; }
    __syncthreads();
    int* TT = WSP(int, WS_ROUTE) + RT_TT; int* rowslot = WSP(int, WS_ROUTE) + RT_ROWSLOT;
    if (F.vcu == 0) {
        if (tid == 0) TT[0] = sm[1120];
        for (int e = 0; e < 32; ++e) { const int tot = sm[1024 + e], base = sm[1088 + e], nte = (tot + 255) / 256;
            for (int i = tid; i < nte; i += 512) TT[1 + base / 256 + i] = e;
            for (int p = tot + tid; p < nte * 256; p += 512) rowslot[base + p] = -1; }
    }
    const int NGW = F.G * NWAVES, nrows = l == 0 ? NTOK : NLAT;
    const int* topi = WSP(int, WS_ROUTE) + RT_TOPI; const int* slotpos = WSP(int, WS_ROUTE) + RT_SLOTPOS;
    for (int s = tid; s < ((nrows + NGW - 1) / NGW) * 32; s += 512) { const int k = s & 3, w = (s >> 2) & 7, i = s >> 5, r = F.vcu * NWAVES + w + i * NGW;
        if (r < nrows) { const int e = topi[r * 4 + k], lp = slotpos[r * 4 + k]; rowslot[sm[1088 + e] + sm[1056 + e] + lp] = r * 4 + k; }
    }
}

namespace pg8 {
struct EpiBf16S {
    static constexpr bool PERM = true, AFTER_DRAIN = false;
    bf16_t* O; int ldc; int stile; float sval;
    __device__ __forceinline__ void operator()(const f32x4 (&acc)[2][2][4][2], const Unit& u, int wr, int wc, int fr, int fq) const {
        const int row0 = u.pm * BM + wr * 64 + fr, col0 = u.pn * BM + wc * 32 + 8 * fq; const float sc = (u.pn == stile) ? sval : 1.f;
#pragma unroll
        for (int ai = 0; ai < 2; ++ai)
#pragma unroll
            for (int m = 0; m < 4; ++m) { bf16_t* rowp = O + (size_t)(row0 + ai * HALF + m * 16) * ldc + col0;
#pragma unroll
                for (int bj = 0; bj < 2; ++bj) { const f32x4 v0 = acc[ai][bj][m][0] * sc, v1 = acc[ai][bj][m][1] * sc;
                    u32x4 w; w.x = cvt_pk_bf16(v0[0], v0[1]); w.y = cvt_pk_bf16(v0[2], v0[3]); w.z = cvt_pk_bf16(v1[0], v1[1]); w.w = cvt_pk_bf16(v1[2], v1[3]);
                    *(u32x4*)(rowp + bj * HALF) = w; } }
    }
};
}
namespace pg8 {
struct EpiI8S {
    static constexpr bool PERM = true, AFTER_DRAIN = false;
    bf16_t* O; int ldc; int stile; float sval; const float* srow; const int* cmaxbits;
    __device__ __forceinline__ void operator()(const f32x4 (&acc)[2][2][4][2], const Unit& u, int wr, int wc, int fr, int fq) const {
        const int row0 = u.pm * BM + wr * 64 + fr, col0 = u.pn * BM + wc * 32 + 8 * fq; const float sc = ((u.pn == stile) ? sval : 1.f) * (1.f / 127.f);
        f32x4 cs[2][2];
#pragma unroll
        for (int bj = 0; bj < 2; ++bj)
#pragma unroll
            for (int n = 0; n < 2; ++n) { const int* cb = cmaxbits + col0 + bj * HALF + 4 * n; cs[bj][n] = (f32x4){__int_as_float(cb[0]), __int_as_float(cb[1]), __int_as_float(cb[2]), __int_as_float(cb[3])} * sc; }
#pragma unroll
        for (int ai = 0; ai < 2; ++ai)
#pragma unroll
            for (int m = 0; m < 4; ++m) { const int row = row0 + ai * HALF + m * 16; const float rs = srow[row]; bf16_t* rowp = O + (size_t)row * ldc + col0;
#pragma unroll
                for (int bj = 0; bj < 2; ++bj) { const f32x4 v0 = acc[ai][bj][m][0] * cs[bj][0] * rs, v1 = acc[ai][bj][m][1] * cs[bj][1] * rs;
                    u32x4 w; w.x = cvt_pk_bf16(v0[0], v0[1]); w.y = cvt_pk_bf16(v0[2], v0[3]); w.z = cvt_pk_bf16(v1[0], v1[1]); w.w = cvt_pk_bf16(v1[2], v1[3]);
                    *(u32x4*)(rowp + bj * HALF) = w; } }
    }
};
}
namespace pg8 {
struct GroupedOrder {
    const PG8_LAS int* TT; int nN, G, c;
    __device__ __forceinline__ bool tile_of(int i, int& rt, int& pn) const {
        const int T = __builtin_amdgcn_readfirstlane(TT[0]);
        if ((G & 7) == 0) { const int x = c & 7, j = c >> 3, W = G >> 3, lo = (x * T) >> 3, hi = ((x + 1) * T) >> 3, uu = i * W + j;
            if (uu >= (hi - lo) * nN) return false; rt = lo + uu / nN; pn = uu % nN; }
        else { const long L = (long)i * G + c; if (L >= (long)T * nN) return false; rt = (int)(L / nN); pn = (int)(L % nN); }
        return true;
    }
    __device__ __forceinline__ bool next(int i, Unit& u) const {
        int rt, pn; if (!tile_of(i, rt, pn)) return false;
        const int e = __builtin_amdgcn_readfirstlane(TT[1 + rt]);
        u.pm = rt; u.pn = pn; u.pe = e; u.pb = e * nN + pn; return true;
    }
    __device__ __forceinline__ void a_ready(const Unit&) const {}
    __device__ __forceinline__ void done(const Unit&) const {}
};
struct EpiSwiGLU {
    static constexpr bool PERM = true, AFTER_DRAIN = false;
    unsigned char* O; const float* b1;
    __device__ __forceinline__ void operator()(const f32x4 (&acc)[2][2][4][2], const Unit& u, int wr, int wc, int fr, int fq) const {
        const int row0 = u.pm * BM + wr * 64 + fr, cc0 = u.pn * 128 + wc * 32 + 8 * fq;
        const float* bg = b1 + (size_t)u.pe * 2048 + cc0; const float* bl = bg + 1024;
        f32x4 vg[2], vl[2];
#pragma unroll
        for (int n = 0; n < 2; ++n) { vg[n] = *(const f32x4*)(bg + 4 * n); vl[n] = *(const f32x4*)(bl + 4 * n); }
#pragma unroll
        for (int ai = 0; ai < 2; ++ai)
#pragma unroll
            for (int m = 0; m < 4; ++m) { unsigned char* rowp = O + (size_t)(row0 + ai * HALF + m * 16) * 1024 + cc0; float o[8];
#pragma unroll
                for (int n = 0; n < 2; ++n) { const f32x4 g = acc[ai][0][m][n] * (1.0f / W1_SCALE) + vg[n], li = acc[ai][1][m][n] * (1.0f / W1_SCALE) + vl[n];
#pragma unroll
                    for (int j = 0; j < 4; ++j) { const float gg = fminf(g[j], 7.0f), ll = fminf(fmaxf(li[j], -7.0f), 7.0f);
                        o[n * 4 + j] = gg * (1.0f / (1.0f + __expf(-1.702f * gg))) * (ll + 1.0f); } }
                *(unsigned long long*)rowp = (unsigned long long)pk4_fp8(o[0], o[1], o[2], o[3]) | ((unsigned long long)pk4_fp8(o[4], o[5], o[6], o[7]) << 32); }
    }
};
struct EpiMoeOut {
    static constexpr bool PERM = true, AFTER_DRAIN = false;
    unsigned char* O; const float* b2; const float* gate; const int* rowslot;
    __device__ __forceinline__ void operator()(const f32x4 (&acc)[2][2][4][2], const Unit& u, int wr, int wc, int fr, int fq) const {
        const int row0 = u.pm * BM + wr * 64 + fr, col0 = u.pn * BM + wc * 32 + 8 * fq;
        f32x4 bv[2][2];
#pragma unroll
        for (int bj = 0; bj < 2; ++bj)
#pragma unroll
            for (int n = 0; n < 2; ++n) bv[bj][n] = *(const f32x4*)(b2 + (size_t)u.pe * 1024 + col0 + bj * HALF + 4 * n);
#pragma unroll
        for (int ai = 0; ai < 2; ++ai)
#pragma unroll
            for (int m = 0; m < 4; ++m) { const int slot = rowslot[row0 + ai * HALF + m * 16];
                if (slot >= 0) { const float gt = gate[slot]; unsigned char* rowp = O + (size_t)slot * 1024 + col0;
#pragma unroll
                    for (int bj = 0; bj < 2; ++bj) { const f32x4 v0 = (acc[ai][bj][m][0] * (1.0f / W2_SCALE) + bv[bj][0]) * gt, v1 = (acc[ai][bj][m][1] * (1.0f / W2_SCALE) + bv[bj][1]) * gt;
                        *(unsigned long long*)(rowp + bj * HALF) = (unsigned long long)pk4_fp8(v0[0], v0[1], v0[2], v0[3]) | ((unsigned long long)pk4_fp8(v1[0], v1[1], v1[2], v1[3]) << 32); } } }
    }
};
}

__device__ __forceinline__ void ph_r2(Frame& F, int l) {
    const int lane = F.lane, tid = F.tid, gw = F.vcu * NWAVES + F.wave, NGW = F.G * NWAVES, nrows = l == 0 ? NTOK : NLAT;
    LAS float* Lv = (LAS float*)(F.lds + RING_OFF);
    { const float* ln2g = INP(IN_LN2G) + l * DM; const float* ln2b = INP(IN_LN2B) + l * DM; const int ln = l + 1 < DEPTH ? l + 1 : l;
      for (int i = tid; i < DM; i += 512) { Lv[i] = ln2g[i]; Lv[DM + i] = ln2b[i];
#pragma unroll
          for (int b = 0; b < 5; ++b) { Lv[(2 + b) * DM + i] = modp(F, l, b, 5)[i]; Lv[(7 + b) * DM + i] = modp(F, ln, b, 0)[i]; Lv[(12 + b) * DM + i] = modp(F, ln, b, 1)[i]; } } }
    __syncthreads();
    for (int rA = gw; rA < nrows; rA += 2 * NGW) {
        f32x4 xv[2][4]; unsigned yw[2][4][4];
#pragma unroll
        for (int q = 0; q < 2; ++q) { const int r0 = rA + q * NGW, r = r0 < nrows ? r0 : rA;
            const float* xsrc = WSP(float, WS_X1) + (size_t)r * DM; const unsigned char* y4 = WSP(unsigned char, WS_Y4) + (size_t)r * 4 * DM;
#pragma unroll
            for (int j = 0; j < 4; ++j) { xv[q][j] = ((const f32x4*)xsrc)[lane + 64 * j];
#pragma unroll
                for (int k = 0; k < 4; ++k) yw[q][j][k] = ((const GAS unsigned*)(y4 + (size_t)k * DM))[lane + 64 * j]; } }
#pragma unroll
        for (int q = 0; q < 2; ++q) { const int r = rA + q * NGW;
            if (r < nrows) { const int bsel = r < NLAT ? r / SEQ : 4; f32x4 v[4];
#pragma unroll
                for (int j = 0; j < 4; ++j) { f32x4 mo = {0.f, 0.f, 0.f, 0.f}; typedef float f32x2c __attribute__((ext_vector_type(2)));
#pragma unroll
                    for (int k = 0; k < 4; ++k) { const int w = (int)yw[q][j][k]; const f32x2c lo = __builtin_amdgcn_cvt_pk_f32_fp8(w, false), hi = __builtin_amdgcn_cvt_pk_f32_fp8(w, true); mo += (f32x4){lo.x, lo.y, hi.x, hi.y}; }
                    v[j] = xv[q][j] * DN_ALPHA + ((const LAS f32x4*)(Lv + (2 + bsel) * DM))[lane + 64 * j] * mo; }
                float mean, rstd; row_stats(v, mean, rstd);
                float* xdst = (l == DEPTH - 1) ? F.out + (size_t)r * DM : WSP(float, WS_X) + (size_t)r * DM;
#pragma unroll
                for (int j = 0; j < 4; ++j) { const f32x4 gg = ((const LAS f32x4*)Lv)[lane + 64 * j], bb = ((const LAS f32x4*)(Lv + DM))[lane + 64 * j];
                    v[j] = (v[j] - mean) * rstd * gg + bb; ((f32x4*)xdst)[lane + 64 * j] = v[j]; }
                if (l + 1 < DEPTH) { f32x4 sh[4], sc[4];
#pragma unroll
                    for (int j = 0; j < 4; ++j) { sh[j] = ((const LAS f32x4*)(Lv + (7 + bsel) * DM))[lane + 64 * j]; sc[j] = ((const LAS f32x4*)(Lv + (12 + bsel) * DM))[lane + 64 * j]; }
                    modulate_store_i8(F, v, sh, sc, WSP(unsigned char, WS_H) + (size_t)r * DM, WSP(float, WS_ROUTE) + RT_SH + r); } } }
    }
}

#define PHASE_LOCAL Frame P = F; int l = l_; asm volatile("" : "+s"(P.ws), "+s"(P.out), "+v"(P.tid), "+v"(P.lane), "+s"(P.wave), "+s"(P.vcu), "+s"(P.G), "+s"(l))
#define IN(k) (lo <= (k) && (k) < hi)
#define SEAM(k) do { if (IN((k) + 1)) xcd_barrier(bar); } while (0)
template <int LAYER> __device__ __forceinline__ void layer_body(Frame& F, const XcdBarrier& bar, const int lo, const int hi, unsigned char* lds) {
    {
        constexpr int l_ = LAYER; constexpr int pb = 2 + PH_PER_LAYER * l_;
        if (IN(pb + 0)) { PHASE_LOCAL;
            pg8::Gemm g{(const bf16*)(P.ws + WS_H), (const bf16*)(P.ws + WS_WIN + (size_t)l * DIN * DM), NTOK, DIN, DM / 2}; pg8::StaticOrder S; S.init(NTOK, DIN, P.G, (int)blockIdx.x);
            pg8::EpiI8S E{(bf16*)(P.ws + WS_P), DIN, CNQ / 256, C2, (const float*)(P.ws + WS_ROUTE) + RT_SH, (const int*)(F.ctl + CW_WCMAX) + l * DIN};
            REPS(2) pg8::gemm_phase<pg8::EpiI8S, pg8::StaticOrder, true, true, false, false, true>(P.lds + RING_OFF, g, S, E, P.tid);
            SEAM(pb + 0); }
        if (IN(pb + 1)) { PHASE_LOCAL; REPS(3) ph_prep(P, l); SEAM(pb + 1); }
        if (IN(pb + 2)) { PHASE_LOCAL; ph_mixers(P, l, (char*)lds + RING_OFF); SEAM(pb + 2); }
        if (IN(pb + 3)) { PHASE_LOCAL; REPS(4) ph_hy_post(P); SEAM(pb + 3); }
        if (IN(pb + 4)) { PHASE_LOCAL;
            const int M = l == 0 ? NTOK : NLAT;
            pg8::Gemm g{(const bf16*)(P.ws + WS_YMIX), (const bf16*)(P.ws + WS_WOUT) + (size_t)l * DM * DM, M, DM, DM}; pg8::StaticOrder S; S.init(M, DM, P.G, (int)blockIdx.x);
            pg8::EpiBf16<0> E{(bf16*)(P.ws + WS_Y), DM, nullptr, 0, 0, 1.f};
            REPS(5) pg8::gemm_phase<pg8::EpiBf16<0>, pg8::StaticOrder, true, true>(P.lds + RING_OFF, g, S, E, P.tid);
            SEAM(pb + 4); }
        if (IN(pb + 5)) { PHASE_LOCAL; REPS(6) ph_r1(P, l); SEAM(pb + 5); }
        if (IN(pb + 6)) { PHASE_LOCAL; REPS(7) ph_gather(P, l); SEAM(pb + 6); }
        if (IN(pb + 7)) { PHASE_LOCAL;
            pg8::Gemm g{(const bf16*)(P.ws + WS_H8), (const bf16*)(P.ws + WS_W1 + (size_t)l * NEXP * 2048 * DM), MAXSORT, 2048, DM / 2};
            LAS int* TTl = (LAS int*)(P.lds + LDS_TT_OFF); { const int* TTg = (const int*)(P.ws + WS_ROUTE) + RT_TT; if (P.tid < 320) TTl[P.tid] = TTg[P.tid]; __syncthreads(); }
            pg8::GroupedOrder S{TTl, 8, P.G, (int)blockIdx.x};
            pg8::EpiSwiGLU E{(unsigned char*)(P.ws + WS_ACT), INP(IN_EB1) + (size_t)l * NEXP * 2048};
            LAS int* gtab = (LAS int*)(P.lds + RING_OFF + pg8::STAGE_BYTES);
            { const int* rowslot = (const int*)(P.ws + WS_ROUTE) + RT_ROWSLOT; pg8::Unit uu;
              { const int half = P.tid >> 8, r = P.tid & 255;
#pragma unroll
                for (int i0 = 0; i0 < 16; i0 += 2) { int rt, pn; if (S.tile_of(i0 + half, rt, pn)) { const int slot = rowslot[rt * 256 + r]; gtab[(i0 + half) * 256 + r] = slot < 0 ? 0 : slot >> 2; } } }
              (void)uu;
              __syncthreads(); }
            REPS(8) pg8::gemm_phase<pg8::EpiSwiGLU, pg8::GroupedOrder, true, true, true, true>(P.lds + RING_OFF, g, S, E, P.tid, gtab);
            SEAM(pb + 7); }
        if (IN(pb + 8)) { PHASE_LOCAL;
            pg8::Gemm g{(const bf16*)(P.ws + WS_ACT), (const bf16*)(P.ws + WS_W2 + (size_t)l * NEXP * DM * DM), MAXSORT, DM, DM / 2};
            LAS int* TTl = (LAS int*)(P.lds + LDS_TT_OFF); { const int* TTg = (const int*)(P.ws + WS_ROUTE) + RT_TT; if (P.tid < 320) TTl[P.tid] = TTg[P.tid]; __syncthreads(); }
            pg8::GroupedOrder S{TTl, 4, P.G, (int)blockIdx.x};
            pg8::EpiMoeOut E{(unsigned char*)(P.ws + WS_Y4), INP(IN_EB2) + (size_t)l * NEXP * DM, (const float*)(P.ws + WS_ROUTE) + RT_GATE, (const int*)(P.ws + WS_ROUTE) + RT_ROWSLOT};
            REPS(9) pg8::gemm_phase<pg8::EpiMoeOut, pg8::GroupedOrder, true, true, true>(P.lds + RING_OFF, g, S, E, P.tid);
            SEAM(pb + 8); }
        if (IN(pb + 9)) { PHASE_LOCAL; REPS(10) ph_r2(P, l); SEAM(pb + 9); if ((PROBE_MASK >> 12) & 1) { for (int xb = 0; xb < 10; ++xb) xcd_barrier(bar); } }
    }
}
struct Args { const float* in[31]; float* out; unsigned char* ws; int ph_lo, ph_hi; };
__global__ void __launch_bounds__(NWAVES * 64, 2) mega_fwd(Args args) {
    extern __shared__ __attribute__((aligned(16))) unsigned char lds[];
    Frame F;
    F.lds = (LAS unsigned char*)lds;
    F.MISC = (volatile LAS unsigned*)(F.lds + LDSCTL_OFF);
    F.tid = threadIdx.x; F.lane = F.tid & 63; F.wave = __builtin_amdgcn_readfirstlane(F.tid >> 6);
    F.G = gridDim.x; { const int bx = blockIdx.x; F.vcu = (F.G % 8 == 0) ? (bx % 8) * (F.G / 8) + bx / 8 : bx; }
    F.ws = args.ws; F.ctl = (gu32*)(args.ws + WS_CTL); F.out = args.out;
    for (int u = F.tid; u < 1024 / 4; u += NWAVES * 64) ((LAS unsigned*)(F.lds + LDSCTL_OFF))[u] = 0u;
    __syncthreads();
    const int lo = args.ph_lo, hi = args.ph_hi;
    const bool multi = (hi - lo) > 1;
    XcdBarrier bar; bar.bar = (unsigned*)(F.ctl + CW_BAR); bar.x = 0; bar.st = nullptr;
    if (multi) bar = xcd_barrier_post((unsigned*)(F.ctl + CW_BAR), F.MISC + 8);

    if (IN(0)) { REPS(0) ph_prologue(F); SEAM(0); }
    if (IN(1)) { REPS(1) { ph_r0(F); { LAS float* scr = (LAS float*)(F.lds + RING_OFF + F.wave * 16640); const int gw = F.vcu * NWAVES + F.wave, NGW = F.G * NWAVES; for (int it = gw; it < 2 * 576; it += NGW) p1_win_i8_item(F, it, scr); } __syncthreads(); { Frame Fs = F; asm volatile("" : "+s"(Fs.ws), "+v"(Fs.tid), "+v"(Fs.lane), "+s"(Fs.wave)); for (int it = Fs.vcu; it < 512; it += Fs.G) hy_spectrum_item(Fs, it >> 8, it & 255); } } SEAM(1); }
    layer_body<0>(F, bar, lo, hi, lds);
    layer_body<1>(F, bar, lo, hi, lds);
#undef IN
#undef SEAM
}

#ifndef MK_N_LAUNCHES
#define MK_N_LAUNCHES 1
#endif
extern "C" void kernel_launch(void* const* d_in, const int* in_sizes, int n_in, void* d_out, int out_size, void* d_ws, size_t ws_size, hipStream_t stream) {
    static int grid = 0;
    if (grid == 0) {
        if (n_in != 31 || out_size != NLAT * DM || ws_size < WS_END) { fprintf(stderr, "kernel_launch: unexpected problem (n_in %d, out %d, ws %zu); nothing launched\n", n_in, out_size, ws_size); grid = -1; return; }
        int dev = 0, cus = 0, per_cu = 0;
        if (hipGetDevice(&dev) != hipSuccess || hipDeviceGetAttribute(&cus, hipDeviceAttributeMultiprocessorCount, dev) != hipSuccess) { grid = -1; return; }
        if (hipFuncSetAttribute((const void*)mega_fwd, hipFuncAttributeMaxDynamicSharedMemorySize, LDS_BYTES) != hipSuccess) { fprintf(stderr, "kernel_launch: hipFuncSetAttribute failed\n"); grid = -1; return; }
        if (hipOccupancyMaxActiveBlocksPerMultiprocessor(&per_cu, (const void*)mega_fwd, NWAVES * 64, LDS_BYTES) != hipSuccess || per_cu < 1)
            fprintf(stderr, "kernel_launch: note: occupancy query reports %d workgroups per CU\n", per_cu);
        (void)hipGetLastError();
        grid = cus;
        if (grid > 256) grid = 256;
    }
    if (grid < 0) return;
    if (hipMemsetAsync((char*)d_ws + WS_CTL, 0, CTL_ZERO_BYTES, stream) != hipSuccess) return;
    Args a{};
    for (int i = 0; i < 31; ++i) a.in[i] = (const float*)d_in[i];
    a.out = (float*)d_out; a.ws = (unsigned char*)d_ws;
    if (MK_N_LAUNCHES == 1) { a.ph_lo = 0; a.ph_hi = NPHASE; hipLaunchKernelGGL(mega_fwd, dim3(grid), dim3(NWAVES * 64), LDS_BYTES, stream, a); }
    else for (int k = 0; k < NPHASE; ++k) { a.ph_lo = k; a.ph_hi = k + 1; hipLaunchKernelGGL(mega_fwd, dim3(grid), dim3(NWAVES * 64), LDS_BYTES, stream, a); }
}
```

```cpp
#include <hip/hip_runtime.h>
#include <cstdio>
#include <cstdint>
namespace pg8 {
#define PG8_LAS __attribute__((address_space(3)))
typedef unsigned short bf16_t;
typedef short bf16x8 __attribute__((ext_vector_type(8)));
typedef float f32x4 __attribute__((ext_vector_type(4)));
typedef unsigned u32x4 __attribute__((ext_vector_type(4)));
constexpr int BM = 256, BK = 64, HALF = 128, HTB = HALF * BK * 2  , STAGE_BYTES = 8 * HTB, NXCD = 8, WGM = 8;

__host__ __device__ __forceinline__ int lds_byte(int r, int c) { const int st = (r >> 4) * 2 + (c >> 5), rr = r & 15, cc = c & 31, ob = rr * 64 + cc * 2; return st * 1024 + (ob ^ (((ob >> 9) & 1) << 5)); }
__host__ __device__ __forceinline__ void stage_rc(int b, int& R, int& C) { const int st = b / 1024, sb = b % 1024, swz = sb ^ (((sb >> 9) & 1) << 5); R = (st >> 1) * 16 + swz / 64; C = (st & 1) * 32 + (swz % 64) / 2; }
__host__ __device__ __forceinline__ int perm32(int rho) { const int n = rho >> 4, i = rho & 15; return 8 * (i >> 2) + 4 * n + (i & 3); }

struct Unit { int pm, pn, pb, pe; };
struct Gemm { const bf16_t* A; const bf16_t* Bt; int M, N, K; };

struct StaticOrder {
    int nM, nN, nwg, G, c;
    __host__ __device__ void init(int M, int N, int G_, int c_) { nM = M / BM; nN = N / BM; nwg = nM * nN; G = G_; c = c_; }
    __host__ __device__ bool next(int i, Unit& u) const {
        const long L = (long)i * G + c; if (L >= nwg) return false;
        int wgid = (int)L; { const int q = nwg / NXCD, r = nwg % NXCD, xcd = wgid % NXCD, off = wgid / NXCD; wgid = (xcd < r ? xcd * (q + 1) : r * (q + 1) + (xcd - r) * q) + off; }
        const int nig = WGM * nN, gid = wgid / nig, fm = gid * WGM, gsz = (nM - fm) < WGM ? (nM - fm) : WGM;
        u.pm = fm + ((wgid % nig) % gsz); u.pn = (wgid % nig) / gsz; u.pb = u.pn; u.pe = 0; return true;
    }
    __device__ __forceinline__ void a_ready(const Unit&) const {}
    __device__ __forceinline__ void done(const Unit&) const {}
};

__device__ __forceinline__ unsigned cvt_pk_bf16(float lo, float hi) { unsigned r; asm volatile("v_cvt_pk_bf16_f32 %0, %1, %2" : "=v"(r) : "v"(lo), "v"(hi)); return r; }
typedef float f32x2 __attribute__((ext_vector_type(2)));
__device__ __forceinline__ f32x2 gelu_pk(f32x2 v) {
    const f32x2 av = __builtin_elementwise_abs(v), d = av * 0.2316418882f + 1.0f;
    f32x2 t; t.x = __builtin_amdgcn_rcpf(d.x); t.y = __builtin_amdgcn_rcpf(d.y);
    f32x2 q = t * 0.5307027145f + (-0.7265760135f); q = q * t + 0.7107068705f; q = q * t + (-0.142248368f); q = q * t + 0.127414796f; q = q * t;
    const f32x2 s = (v * v) * (-0.72134752044f);
    f32x2 e; e.x = __builtin_amdgcn_exp2f(s.x); e.y = __builtin_amdgcn_exp2f(s.y);
    const f32x2 m = v * (q * e), r = v - m;
    f32x2 o; o.x = v.x < 0.f ? m.x : r.x; o.y = v.y < 0.f ? m.y : r.y; return o;
}

template <int ACT  > struct EpiBf16 {
    static constexpr bool PERM = true, AFTER_DRAIN = false; static_assert(ACT == 0 || ACT == 1, "EpiBf16: ACT is 0 (none) or 1 (gelu_pk)");
    bf16_t* O; int ldc; const float* bias; int split_cols; size_t split_stride; float scale0;
    __device__ __forceinline__ void operator()(const f32x4 (&acc)[2][2][4][2], const Unit& u, int wr, int wc, int fr, int fq) const {
        const int row0 = u.pm * BM + wr * 64 + fr; int colt = u.pn * BM; bf16_t* base = O;
        float sc = 1.f; if (split_cols) { const int t = colt / split_cols; base += (size_t)t * split_stride; colt -= t * split_cols; if (t == 0) sc = scale0; }
        const int col0 = colt + wc * 32 + 8 * fq, bcol0 = u.pn * BM + wc * 32 + 8 * fq;
        f32x4 bv[2][2];
#pragma unroll
        for (int bj = 0; bj < 2; ++bj)
#pragma unroll
            for (int n = 0; n < 2; ++n) bv[bj][n] = bias ? *(const f32x4*)(bias + bcol0 + bj * HALF + 4 * n) : (f32x4){0.f, 0.f, 0.f, 0.f};
#pragma unroll
        for (int ai = 0; ai < 2; ++ai)
#pragma unroll
            for (int m = 0; m < 4; ++m) { bf16_t* rowp = base + (size_t)(row0 + ai * HALF + m * 16) * ldc + col0;
#pragma unroll
                for (int bj = 0; bj < 2; ++bj) { f32x4 v0 = acc[ai][bj][m][0] + bv[bj][0], v1 = acc[ai][bj][m][1] + bv[bj][1];
                    if (ACT == 1) { f32x2 a = gelu_pk((f32x2){v0[0], v0[1]}), b = gelu_pk((f32x2){v0[2], v0[3]}), c = gelu_pk((f32x2){v1[0], v1[1]}), d = gelu_pk((f32x2){v1[2], v1[3]});
                        v0 = (f32x4){a.x, a.y, b.x, b.y}; v1 = (f32x4){c.x, c.y, d.x, d.y}; }
                    v0 = v0 * sc; v1 = v1 * sc; u32x4 w; w.x = cvt_pk_bf16(v0[0], v0[1]); w.y = cvt_pk_bf16(v0[2], v0[3]); w.z = cvt_pk_bf16(v1[0], v1[1]); w.w = cvt_pk_bf16(v1[2], v1[3]);
                    *(u32x4*)(rowp + bj * HALF) = w; } }
    }
};

template <class Epi, class Sched, bool ALIGN_EPI = false, bool SP2 = false, bool F8 = false, bool GATHER = false, bool I8 = false>
__device__ __forceinline__ void gemm_phase(PG8_LAS unsigned char* lds, const Gemm g, const Sched& S, const Epi& E, const int tid, const PG8_LAS int* gtab = nullptr) {
    const int wid = __builtin_amdgcn_readfirstlane(tid >> 6), lane = tid & 63, wr = wid >> 2, wc = wid & 3, fr = lane & 15, fq = lane >> 4;
    const int K = g.K, nt = K / BK;
    unsigned voffA[2], voffB[2]; int gR[2]; unsigned gC[2];
#pragma unroll
    for (int i = 0; i < 2; ++i) { int R, C; stage_rc(tid * 16 + i * 8192, R, C); const int Rb = Epi::PERM ? ((R & ~31) + perm32(R & 31)) : R;
        voffA[i] = (unsigned)(R * K + C) * 2u; voffB[i] = (unsigned)(Rb * K + C) * 2u; gR[i] = R; gC[i] = (unsigned)C * 2u; }
    unsigned vC[2][2], vN[2][2];
#define PG8_GOFF(dst, ui_) do { _Pragma("unroll") for (int h_ = 0; h_ < 2; ++h_) _Pragma("unroll") for (int p_ = 0; p_ < 2; ++p_) dst[h_][p_] = (unsigned)gtab[(ui_) * 256 + h_ * HALF + gR[p_]] * (unsigned)(K * 2) + gC[p_]; } while (0)
#define PG8_STAGE_A(bufoff, abase, half, vsel) do { if constexpr (GATHER) { PG8_STAGE(bufoff, abase, vsel[half]); } else { PG8_STAGE(bufoff, (abase) + (half) * hstep, voffA); } } while (0)
    const size_t kstep = (size_t)(BK * 2);
    const size_t hstep = (size_t)HALF * K * 2;
    const size_t tstep = 2 * hstep;
    const unsigned ldsw = (unsigned)wid * 1024u;
    const int aoff = lds_byte(wr * 64 + fr, fq * 8), boff = lds_byte(wc * 32 + fr, fq * 8);
    const int aoff1 = aoff + 1024, boff1 = boff + 1024;
    unsigned f8scale = 0x7f7f7f7fu; asm volatile("" : "+v"(f8scale));
    unsigned abase0 = (unsigned)(uintptr_t)lds + (unsigned)aoff, abase1 = (unsigned)(uintptr_t)lds + (unsigned)aoff1, bbase0 = (unsigned)(uintptr_t)lds + 4u * HTB + (unsigned)boff, bbase1 = (unsigned)(uintptr_t)lds + 4u * HTB + (unsigned)boff1;
    asm volatile("" : "+v"(abase0), "+v"(abase1), "+v"(bbase0), "+v"(bbase1));
#define PG8_SA(b, h) (((b) * 2 + (h)) * HTB)
#define PG8_SB(b, h) ((4 + (b) * 2 + (h)) * HTB)
#define PG8_STAGE(bufoff, gbase, voff) do { _Pragma("unroll") for (int _i = 0; _i < 2; ++_i) \
        __builtin_amdgcn_global_load_lds((const unsigned*)((const char*)(gbase) + (voff)[_i]), (PG8_LAS unsigned*)(lds + (bufoff) + ldsw + _i * 8192), 16, 0, 0); } while (0)
#define PG8_LDA(dst, b, h) do { _Pragma("unroll") for (int m = 0; m < 4; ++m) _Pragma("unroll") for (int k = 0; k < 2; ++k) dst[m][k] = *(const PG8_LAS bf16x8*)(uintptr_t)((k ? abase1 : abase0) + (unsigned)(PG8_SA(b, h) + m * 2048)); } while (0)
#define PG8_LDB(dst, b, h) do { _Pragma("unroll") for (int n = 0; n < 2; ++n) _Pragma("unroll") for (int k = 0; k < 2; ++k) dst[n][k] = *(const PG8_LAS bf16x8*)(uintptr_t)((k ? bbase1 : bbase0) + (unsigned)(PG8_SA(b, h) + n * 2048)); } while (0)
#define PG8_MMA(ai, bj, At, Bt) do { __builtin_amdgcn_s_setprio(1); _Pragma("unroll") for (int m = 0; m < 4; ++m) _Pragma("unroll") for (int n = 0; n < 2; ++n) { \
        if constexpr (F8) { typedef int v8i_t __attribute__((ext_vector_type(8))); typedef int v4i_t __attribute__((ext_vector_type(4))); \
            const v4i_t b0_ = __builtin_bit_cast(v4i_t, Bt[n][0]), b1_ = __builtin_bit_cast(v4i_t, Bt[n][1]), a0_ = __builtin_bit_cast(v4i_t, At[m][0]), a1_ = __builtin_bit_cast(v4i_t, At[m][1]); \
            const v8i_t bb_ = {b0_[0], b0_[1], b0_[2], b0_[3], b1_[0], b1_[1], b1_[2], b1_[3]}, aa_ = {a0_[0], a0_[1], a0_[2], a0_[3], a1_[0], a1_[1], a1_[2], a1_[3]}; \
              \
            asm volatile("v_mfma_scale_f32_16x16x128_f8f6f4 %0, %1, %2, %0, %3, %3 op_sel_hi:[0,0,0]" : "+v"(acc[ai][bj][m][n]) : "v"(bb_), "v"(aa_), "v"(f8scale)); } \
        else if constexpr (I8) { typedef int v4i_t __attribute__((ext_vector_type(4))); _Pragma("unroll") for (int k = 0; k < 2; ++k) acc[ai][bj][m][n] = __builtin_bit_cast(f32x4, __builtin_amdgcn_mfma_i32_16x16x64_i8(__builtin_bit_cast(v4i_t, Bt[n][k]), __builtin_bit_cast(v4i_t, At[m][k]), __builtin_bit_cast(v4i_t, acc[ai][bj][m][n]), 0, 0, 0)); } \
        else { _Pragma("unroll") for (int k = 0; k < 2; ++k) acc[ai][bj][m][n] = __builtin_amdgcn_mfma_f32_16x16x32_bf16(Bt[n][k], At[m][k], acc[ai][bj][m][n], 0, 0, 0); } } \
        __builtin_amdgcn_s_setprio(0); } while (0)
#define PG8_WAIT_V(n) asm volatile("s_waitcnt vmcnt(" #n ")" ::: "memory")
#define PG8_WAIT_L(n) asm volatile("s_waitcnt lgkmcnt(" #n ")" ::: "memory")
#define PG8_BAR __builtin_amdgcn_s_barrier()
#define PG8_SCHED __builtin_amdgcn_sched_barrier(0)
    Unit cur, nxt; int ui = 0;
    if (!S.next(0, cur)) return;
    f32x4 acc[2][2][4][2];
#pragma unroll
    for (int a = 0; a < 2; ++a)
#pragma unroll
        for (int b = 0; b < 2; ++b)
#pragma unroll
            for (int m = 0; m < 4; ++m)
#pragma unroll
                for (int n = 0; n < 2; ++n) acc[a][b][m][n] = (f32x4){0.f, 0.f, 0.f, 0.f};
    bf16x8 At[4][2], B0[2][2], B1[2][2];
    const char* cA = (const char*)g.A + (GATHER ? (size_t)0 : (size_t)cur.pm * tstep); const char* cB = (const char*)g.Bt + (size_t)cur.pb * tstep;
    S.a_ready(cur);
    if constexpr (GATHER) { PG8_GOFF(vC, 0); }
    if constexpr (SP2) {
        PG8_STAGE(PG8_SB(0, 0), cB, voffB); PG8_STAGE(PG8_SB(0, 1), cB + hstep, voffB); PG8_STAGE_A(PG8_SA(0, 0), cA, 0, vC); PG8_STAGE_A(PG8_SA(0, 1), cA, 1, vC);
        if (wr == 1) PG8_BAR;
        PG8_WAIT_V(2); PG8_BAR;
        PG8_STAGE(PG8_SB(1, 0), cB + kstep, voffB); PG8_STAGE_A(PG8_SA(1, 0), cA + kstep, 0, vC); PG8_STAGE(PG8_SB(1, 1), cB + hstep + kstep, voffB);
        PG8_WAIT_V(6); PG8_BAR;
    } else {
        PG8_STAGE(PG8_SB(0, 0), cB, voffB); PG8_STAGE_A(PG8_SA(0, 0), cA, 0, vC); PG8_STAGE(PG8_SB(0, 1), cB + hstep, voffB); PG8_STAGE_A(PG8_SA(0, 1), cA, 1, vC);
        if (wr == 1) PG8_BAR;
        PG8_WAIT_V(4); PG8_BAR;
        PG8_STAGE(PG8_SB(1, 0), cB + kstep, voffB); PG8_STAGE_A(PG8_SA(1, 0), cA + kstep, 0, vC); PG8_STAGE(PG8_SB(1, 1), cB + hstep + kstep, voffB);
        PG8_WAIT_V(6); PG8_BAR;
    }
    for (;;) {
        const bool has_next = S.next(ui + 1, nxt);
        const char* nA = (has_next && !GATHER) ? (const char*)g.A + (size_t)nxt.pm * tstep : cA;
        if constexpr (GATHER) { if (has_next) { PG8_GOFF(vN, ui + 1); } else { _Pragma("unroll") for (int h_ = 0; h_ < 2; ++h_) _Pragma("unroll") for (int p_ = 0; p_ < 2; ++p_) vN[h_][p_] = vC[h_][p_]; } }
        const char* nB = has_next ? (const char*)g.Bt + (size_t)nxt.pb * tstep : cB;
#pragma unroll 1
        for (int t = 0; t < nt; t += 2) {
            const bool last = (t == nt - 2);
            const char* a1 = cA + (size_t)(t + 1) * kstep;
            const char* a2 = last ? nA : cA + (size_t)(t + 2) * kstep; const char* b2 = last ? nB : cB + (size_t)(t + 2) * kstep;
            const char* a3 = a2 + kstep; const char* b3 = b2 + kstep;
            unsigned v2[2][2];
            if constexpr (GATHER) { _Pragma("unroll") for (int h_ = 0; h_ < 2; ++h_) _Pragma("unroll") for (int p_ = 0; p_ < 2; ++p_) v2[h_][p_] = last ? vN[h_][p_] : vC[h_][p_]; }
            if (last && has_next) S.a_ready(nxt);
            if constexpr (SP2) {
            PG8_LDB(B0, 0, 0); PG8_LDB(B1, 0, 1); PG8_SCHED; PG8_LDA(At, 0, 0); PG8_STAGE_A(PG8_SA(1, 1), a1, 1, vC);
            PG8_WAIT_V(8); PG8_WAIT_L(0); PG8_BAR; PG8_MMA(0, 0, At, B0); PG8_MMA(0, 1, At, B1); PG8_BAR; PG8_SCHED;
            PG8_LDA(At, 0, 1); PG8_STAGE(PG8_SB(0, 0), b2, voffB); PG8_STAGE(PG8_SB(0, 1), b2 + hstep, voffB); PG8_STAGE_A(PG8_SA(0, 0), a2, 0, v2);
            PG8_WAIT_V(8); PG8_WAIT_L(0); PG8_BAR; PG8_MMA(1, 0, At, B0); PG8_MMA(1, 1, At, B1); PG8_BAR; PG8_SCHED;
            PG8_LDB(B0, 1, 0); PG8_LDB(B1, 1, 1); PG8_SCHED; PG8_LDA(At, 1, 0); PG8_STAGE_A(PG8_SA(0, 1), a2, 1, v2);
            PG8_WAIT_V(8); PG8_WAIT_L(0); PG8_BAR; PG8_MMA(0, 0, At, B0); PG8_MMA(0, 1, At, B1); PG8_BAR; PG8_SCHED;
            PG8_LDA(At, 1, 1); PG8_STAGE(PG8_SB(1, 0), b3, voffB); PG8_STAGE(PG8_SB(1, 1), b3 + hstep, voffB); PG8_STAGE_A(PG8_SA(1, 0), a3, 0, v2);
            PG8_WAIT_V(8); PG8_WAIT_L(0); PG8_BAR; PG8_MMA(1, 0, At, B0); PG8_MMA(1, 1, At, B1); PG8_BAR; PG8_SCHED;
            } else {
            PG8_LDB(B0, 0, 0); PG8_SCHED; PG8_LDA(At, 0, 0); PG8_STAGE_A(PG8_SA(1, 1), a1, 1, vC);
            PG8_WAIT_L(8); PG8_BAR; PG8_WAIT_L(0); PG8_MMA(0, 0, At, B0); PG8_BAR; PG8_SCHED;
            PG8_LDB(B1, 0, 1); PG8_STAGE(PG8_SB(0, 0), b2, voffB);
            PG8_BAR; PG8_WAIT_L(0); PG8_MMA(0, 1, At, B1); PG8_BAR;
            PG8_LDA(At, 0, 1); PG8_STAGE_A(PG8_SA(0, 0), a2, 0, v2);
            PG8_BAR; PG8_WAIT_L(0); PG8_MMA(1, 0, At, B0); PG8_BAR; PG8_SCHED;
            PG8_STAGE(PG8_SB(0, 1), b2 + hstep, voffB);
            PG8_WAIT_V(6); PG8_BAR; PG8_MMA(1, 1, At, B1); PG8_BAR;
            PG8_LDB(B0, 1, 0); PG8_SCHED; PG8_LDA(At, 1, 0); PG8_STAGE_A(PG8_SA(0, 1), a2, 1, v2);
            PG8_WAIT_L(8); PG8_BAR; PG8_WAIT_L(0); PG8_MMA(0, 0, At, B0); PG8_BAR; PG8_SCHED;
            PG8_LDB(B1, 1, 1); PG8_STAGE(PG8_SB(1, 0), b3, voffB);
            PG8_BAR; PG8_WAIT_L(0); PG8_MMA(0, 1, At, B1); PG8_BAR;
            PG8_LDA(At, 1, 1); PG8_STAGE_A(PG8_SA(1, 0), a3, 0, v2);
            PG8_BAR; PG8_WAIT_L(0); PG8_MMA(1, 0, At, B0); PG8_BAR; PG8_SCHED;
            PG8_STAGE(PG8_SB(1, 1), b3 + hstep, voffB);
            PG8_WAIT_V(6); PG8_BAR; PG8_MMA(1, 1, At, B1); PG8_BAR;
            }
        }
        if constexpr (F8) asm volatile("s_nop 15\n\ts_nop 15" ::: "memory");
        if constexpr (ALIGN_EPI) { if (wr == 0) PG8_BAR; }
        if constexpr (I8) { typedef int v4i_t __attribute__((ext_vector_type(4))); _Pragma("unroll") for (int a = 0; a < 2; ++a) _Pragma("unroll") for (int b = 0; b < 2; ++b) _Pragma("unroll") for (int m = 0; m < 4; ++m) _Pragma("unroll") for (int n = 0; n < 2; ++n) acc[a][b][m][n] = __builtin_convertvector(__builtin_bit_cast(v4i_t, acc[a][b][m][n]), f32x4); }
        if constexpr (!Epi::AFTER_DRAIN) { E(acc, cur, wr, wc, fr, fq); S.done(cur); }
        if (!has_next) break;
#pragma unroll
        for (int a = 0; a < 2; ++a)
#pragma unroll
            for (int b = 0; b < 2; ++b)
#pragma unroll
                for (int m = 0; m < 4; ++m)
#pragma unroll
                    for (int n = 0; n < 2; ++n) acc[a][b][m][n] = (f32x4){0.f, 0.f, 0.f, 0.f};
        cur = nxt; cA = nA; cB = nB; ++ui;
        if constexpr (GATHER) { _Pragma("unroll") for (int h_ = 0; h_ < 2; ++h_) _Pragma("unroll") for (int p_ = 0; p_ < 2; ++p_) vC[h_][p_] = vN[h_][p_]; }
        if constexpr (ALIGN_EPI) { if (wr == 1) PG8_BAR; }
    }
    PG8_WAIT_V(0);
    if constexpr (!ALIGN_EPI) { if (wr == 0) PG8_BAR; }
    PG8_BAR;
    if constexpr (Epi::AFTER_DRAIN) { E.fused(acc, cur, wr, wc, fr, fq, lds, wid, lane); S.done(cur); }
#undef PG8_SA
#undef PG8_SB
#undef PG8_STAGE
#undef PG8_STAGE_A
#undef PG8_GOFF
#undef PG8_LDA
#undef PG8_LDB
#undef PG8_MMA
#undef PG8_WAIT_V
#undef PG8_WAIT_L
#undef PG8_BAR
#undef PG8_SCHED
}
}
#include <hip/hip_bf16.h>
#include <cmath>
namespace attn_body {
using bf16=__hip_bfloat16;
using bf16x8=__attribute__((ext_vector_type(8)))short;
using s16x4=__attribute__((ext_vector_type(4)))short;
using f32x16=__attribute__((ext_vector_type(16)))float;
using u32x4=__attribute__((ext_vector_type(4)))unsigned;
constexpr int D=64;
constexpr int NW=8,QBLK=32,QB=QBLK*NW,KVBLK=64;
constexpr int ATTN_UNIT_ROWS=QB;
__device__ __forceinline__ int crow(int r,int hi){return (r&3)+8*(r>>2)+4*hi;}
#define SBAR() __builtin_amdgcn_sched_barrier(0)
__device__ __forceinline__ void cmask(f32x16&p0,f32x16&p1,int jb,int qrel,int hi){
  const float NEG=-INFINITY; int kb=64*jb+4*hi;
  #pragma unroll
  for(int r=0;r<16;++r){int kv=kb+(r&3)+8*(r>>2); if(kv>qrel)p0[r]=NEG; if(kv+32>qrel)p1[r]=NEG;}
}

constexpr int NSLOT=3, SLOTB=8192;
constexpr int LDS_K=0, LDS_V=NSLOT*SLOTB, LDS_WS=2*NSLOT*SLOTB, LDS_OST=LDS_WS+NW*64*4, LDS_BYTES=LDS_OST+NW*4096;
constexpr float C2=0.125f*1.4426950408889634f;
__device__ __forceinline__ void glds16(const void*gsrc,unsigned lds_dst){unsigned keep;
  asm volatile("s_mov_b32 %0, m0\n\ts_mov_b32 m0, %2\n\ts_nop 0\n\tglobal_load_lds_dwordx4 %1, off\n\ts_mov_b32 m0, %0":"=&s"(keep):"v"(gsrc),"s"(lds_dst):"memory");}
__device__ __forceinline__ float max3f(float a,float b,float c){float r;asm("v_max3_f32 %0, %1, %2, %3":"=v"(r):"v"(a),"v"(b),"v"(c));return r;}
__device__ __forceinline__ float max2f(float a,float b){float r;asm("v_max_f32_e32 %0, %1, %2":"=v"(r):"v"(a),"v"(b));return r;}
__device__ __forceinline__ float fadd_s(float a,float b){float r;asm("v_add_f32_e32 %0, %1, %2":"=v"(r):"v"(a),"v"(b));return r;}
__device__ __forceinline__ float fsub_s(float a,float b){float r;asm("v_sub_f32_e32 %0, %1, %2":"=v"(r):"v"(a),"v"(b));return r;}
typedef float f32x2_t __attribute__((ext_vector_type(2))); typedef __bf16 bf16x2_t __attribute__((ext_vector_type(2)));
__device__ __forceinline__ unsigned cvtpk_s(float lo,float hi){f32x2_t v={lo,hi};bf16x2_t b=__builtin_convertvector(v,bf16x2_t);return __builtin_bit_cast(unsigned,b);}
#define WAIT_BAR(N) asm volatile("s_waitcnt vmcnt(" #N ") lgkmcnt(0)\n\ts_barrier":::"memory")

__device__ __forceinline__ void qkt(f32x16&p0,f32x16&p1,const char*Kslot,const bf16x8*qr,const f32x16&negm,int r32,int hi){
  const char*kb=Kslot+hi*1024+r32*16;
  #pragma unroll
  for(int d0=0;d0<4;++d0){
    const bf16x8 b0=*reinterpret_cast<const bf16x8*>(kb+d0*2048);
    const bf16x8 b1=*reinterpret_cast<const bf16x8*>(kb+d0*2048+512);
    if(d0==0){p0=__builtin_amdgcn_mfma_f32_32x32x16_bf16(b0,qr[0],negm,0,0,0);p1=__builtin_amdgcn_mfma_f32_32x32x16_bf16(b1,qr[0],negm,0,0,0);}
    else{p0=__builtin_amdgcn_mfma_f32_32x32x16_bf16(b0,qr[d0],p0,0,0,0);p1=__builtin_amdgcn_mfma_f32_32x32x16_bf16(b1,qr[d0],p1,0,0,0);}}
}
typedef __attribute__((address_space(3))) const char* lds_cptr;
typedef short v4i16_t __attribute__((ext_vector_type(4)));
__device__ __forceinline__ void kload8(bf16x8*kf,lds_cptr kp){
  kf[0]=*(const __attribute__((address_space(3))) bf16x8*)(kp);      kf[1]=*(const __attribute__((address_space(3))) bf16x8*)(kp+512);
  kf[2]=*(const __attribute__((address_space(3))) bf16x8*)(kp+2048); kf[3]=*(const __attribute__((address_space(3))) bf16x8*)(kp+2560);
  kf[4]=*(const __attribute__((address_space(3))) bf16x8*)(kp+4096); kf[5]=*(const __attribute__((address_space(3))) bf16x8*)(kp+4608);
  kf[6]=*(const __attribute__((address_space(3))) bf16x8*)(kp+6144); kf[7]=*(const __attribute__((address_space(3))) bf16x8*)(kp+6656);
}
__device__ __forceinline__ void kload2(bf16x8*kf,lds_cptr kp,int j){ kf[2*j]=*(const __attribute__((address_space(3))) bf16x8*)(kp+j*2048); kf[2*j+1]=*(const __attribute__((address_space(3))) bf16x8*)(kp+j*2048+512); }
__device__ __forceinline__ s16x4 vtr(lds_cptr p){ return __builtin_bit_cast(s16x4,__builtin_amdgcn_ds_read_tr16_b64_v4i16((__attribute__((address_space(3))) v4i16_t*)p)); }
__device__ __forceinline__ float rowmax(const f32x16&p0,const f32x16&p1){
  float a=max3f(p0[0],p0[1],p1[0]),b=max3f(p0[2],p0[3],p1[1]);a=max3f(a,p1[2],p1[3]);
  #pragma unroll
  for(int r=4;r<16;r+=4){a=max3f(a,p0[r],p0[r+1]);b=max3f(b,p0[r+2],p0[r+3]);a=max3f(a,p1[r],p1[r+1]);b=max3f(b,p1[r+2],p1[r+3]);}
  const float m=max2f(a,b);
  auto rr=__builtin_amdgcn_permlane32_swap(__float_as_uint(m),__float_as_uint(m),false,false);
  return max2f(__uint_as_float(rr[0]),__uint_as_float(rr[1]));
}
__device__ __forceinline__ void pv(f32x16*o,int vb,bf16x8 pa0,bf16x8 pa1,bf16x8 pa2,bf16x8 pa3){
  #pragma unroll
  for(int d0=0;d0<2;++d0){s16x4 lo[4],hi[4];
    #pragma unroll
    for(int ks=0;ks<4;++ks){
      asm volatile("ds_read_b64_tr_b16 %0,%1 offset:%c2":"=&v"(lo[ks]):"v"(vb),"i"(d0*4096+ks*1024):"memory");
      asm volatile("ds_read_b64_tr_b16 %0,%1 offset:%c2":"=&v"(hi[ks]):"v"(vb),"i"(d0*4096+ks*1024+512):"memory");}
    asm volatile("s_waitcnt lgkmcnt(0)":::"memory");SBAR();
    #define PK(k) (bf16x8){lo[k][0],lo[k][1],lo[k][2],lo[k][3],hi[k][0],hi[k][1],hi[k][2],hi[k][3]}
    o[d0]=__builtin_amdgcn_mfma_f32_32x32x16_bf16(pa0,PK(0),o[d0],0,0,0);
    o[d0]=__builtin_amdgcn_mfma_f32_32x32x16_bf16(pa1,PK(1),o[d0],0,0,0);
    o[d0]=__builtin_amdgcn_mfma_f32_32x32x16_bf16(pa2,PK(2),o[d0],0,0,0);
    o[d0]=__builtin_amdgcn_mfma_f32_32x32x16_bf16(pa3,PK(3),o[d0],0,0,0);
    #undef PK
  }
}

#ifndef ATTN_STORE16
#define ATTN_STORE16(p,v) (*(u32x4*)(p)=(v))
#endif
template<int THRL> __device__ __forceinline__ void attn_unit(const bf16*Qu,const bf16*__restrict__ Kh,const bf16*__restrict__ Vh,bf16*Ou,const int QP,const int KP,const int OP,const int NT,char*shm,const int tid){
  const int lane=tid&63,r32=lane&31,hi=lane>>5; const int wid=__builtin_amdgcn_readfirstlane(tid>>6);
  const bf16*Qw=Qu+(long)(wid*QBLK)*QP;
  const unsigned lds0=(unsigned)(uintptr_t)shm;
  float*wsf=(float*)(shm+LDS_WS)+wid*64;
  const bf16*ksrc=Kh+(long)lane*KP+wid*8;
  const bf16*vsrc=Vh+(long)(16*(wid&3)+(lane>>2))*KP+(wid>>2)*32+(lane&3)*8;
  const unsigned kdst=lds0+LDS_K+wid*1024, vdst=lds0+LDS_V+wid*1024;
  #define DMA_K(t,slot) glds16(ksrc+(long)(t)*KVBLK*KP,(unsigned)__builtin_amdgcn_readfirstlane(kdst+(slot)))
  #define DMA_V(t,slot) glds16(vsrc+(long)(t)*KVBLK*KP,(unsigned)__builtin_amdgcn_readfirstlane(vdst+(slot)))
  const int vb0=(int)(lds0+LDS_V)+((lane>>4)&1)*32+(lane&3)*8+(4*hi+((lane&15)>>2))*64;
  const char*Kbase=shm+LDS_K; bf16x8 kf[8];
  const lds_cptr shm3=(lds_cptr)shm; const lds_cptr kp0=shm3+LDS_K+hi*1024+r32*16; const lds_cptr vp0=shm3+LDS_V+((lane>>4)&1)*32+(lane&3)*8+(4*hi+((lane&15)>>2))*64;
  DMA_K(0,0);DMA_V(0,0);DMA_K(1,SLOTB);
  bf16x8 qr[4];
  #pragma unroll
  for(int d0=0;d0<4;++d0)qr[d0]=*reinterpret_cast<const bf16x8*>(&Qw[(long)r32*QP+d0*16+hi*8]);
  float mhat=0.f,l_reg=0.f;f32x16 o[2];o[0]=f32x16{};o[1]=f32x16{};f32x16 negm=f32x16{};asm volatile("":"+v"(negm));
  #define CMASK(P0,P1,t) do{}while(0)
  bool resc=false;
  #define START(P0,P1) do{ const float rm=rowmax(P0,P1); resc=false; \
    { const float dl=rm; mhat=fadd_s(mhat,dl); \
      _Pragma("unroll") for(int r=0;r<16;++r){P0[r]=fsub_s(P0[r],dl);P1[r]=fsub_s(P1[r],dl);} \
      _Pragma("unroll") for(int r=0;r<16;++r)negm[r]=-mhat; asm volatile("":"+v"(negm)); } \
    _Pragma("unroll") for(int r=0;r<16;++r)P0[r]=__builtin_amdgcn_exp2f(P0[r]); }while(0)
  #define RESC() do{ if(resc){ asm volatile("s_waitcnt lgkmcnt(0)":::"memory"); \
      _Pragma("unroll") for(int d_=0;d_<2;++d_) _Pragma("unroll") for(int r=0;r<16;++r)o[d_][r]*=wsf[crow(r,hi)]; } }while(0)
  f32x16 pA0,pA1,pB0,pB1;
  int sl_prev=0,sl_cur=0,sl_next=SLOTB;
  #define ROT() do{sl_prev=sl_cur;sl_cur=sl_next;sl_next=(sl_next==(NSLOT-1)*SLOTB)?0:sl_next+SLOTB;}while(0)
  DMA_K(2,2*SLOTB);
  WAIT_BAR(3);
  qkt(pA0,pA1,Kbase,qr,negm,r32,hi);asm volatile("s_nop 15\n\ts_nop 7":"+v"(pA0),"+v"(pA1));CMASK(pA0,pA1,0);
  START(pA0,pA1);
  _Pragma("unroll") for(int r=0;r<16;++r)pA1[r]=__builtin_amdgcn_exp2f(pA1[r]);
  WAIT_BAR(0);
  DMA_K(3,0);DMA_V(1,SLOTB);
  ROT();
  kload8(kf,kp0+sl_cur);
  WAIT_BAR(2);
  s16x4 vlo[8],vhi[8]; u32x4 pw0,pw1,pw2,pw3;
  #define PKW(P,B) cvtpk_s(P[B],P[B+1])
  #define PAF(k) __builtin_bit_cast(bf16x8,pw##k)
  #define VFR(i) (bf16x8){vlo[i][0],vlo[i][1],vlo[i][2],vlo[i][3],vhi[i][0],vhi[i][1],vhi[i][2],vhi[i][3]}
  #define PIN(x) asm volatile("":"+v"(x))
  #define MX3(a,b,c) __builtin_fmaxf(__builtin_fmaxf((a),(b)),(c))
  #define GAPA(MF,A0,A1,A2,A3,W0,W1,PW) do{ MF; sacc+=A0; sacc+=A1; sacc+=A2; sacc+=A3; PIN(sacc); W0; W1; PIN(PW); SBAR(); }while(0)
  #define EX(v) __builtin_amdgcn_exp2f(v)
  #define GAPB(MF,X,B) do{ MF; X[B]=EX(X[B]); X[B+1]=EX(X[B+1]); X[B+2]=EX(X[B+2]); X[B+3]=EX(X[B+3]); PIN(X); SBAR(); }while(0)
  #define VRD(i) do{ vlo[i]=vtr(vp_+(((i)>>2)*4096+((i)&3)*1024)); vhi[i]=vtr(vp_+(((i)>>2)*4096+((i)&3)*1024+512)); }while(0)
  #define KRD(G,j) do{ if(G){ kload2(kf,kp0+sl_next,j); SBAR(); } }while(0)
  #define STEP(C0,C1,P0,P1,t,GK,GV,GL) do{ SBAR(); \
    const lds_cptr vp_=vp0+sl_prev; \
    VRD(0); SBAR(); float sacc=(P0[0]+P0[1]); \
    GAPA(C0=__builtin_amdgcn_mfma_f32_32x32x16_bf16(kf[0],qr[0],negm,0,0,0), P0[2],P0[3],P0[4],P0[5],     pw0[0]=PKW(P0,0), pw0[1]=PKW(P0,2), pw0); \
    VRD(4); SBAR(); GAPA(C1=__builtin_amdgcn_mfma_f32_32x32x16_bf16(kf[1],qr[0],negm,0,0,0), P0[6],P0[7],P0[8],P0[9],     pw0[2]=PKW(P0,4), pw0[3]=PKW(P0,6), pw0); \
    VRD(1); SBAR(); GAPA(C0=__builtin_amdgcn_mfma_f32_32x32x16_bf16(kf[2],qr[1],C0,0,0,0),   P0[10],P0[11],P0[12],P0[13], pw1[0]=PKW(P0,8), pw1[1]=PKW(P0,10), pw1); \
    VRD(5); SBAR(); GAPA(C1=__builtin_amdgcn_mfma_f32_32x32x16_bf16(kf[3],qr[1],C1,0,0,0),   P0[14],P0[15],P1[0],P1[1],   pw1[2]=PKW(P0,12),pw1[3]=PKW(P0,14), pw1); \
    VRD(2); SBAR(); GAPA(C0=__builtin_amdgcn_mfma_f32_32x32x16_bf16(kf[4],qr[2],C0,0,0,0),   P1[2],P1[3],P1[4],P1[5],     pw2[0]=PKW(P1,0), pw2[1]=PKW(P1,2), pw2); \
    VRD(6); SBAR(); GAPA(C1=__builtin_amdgcn_mfma_f32_32x32x16_bf16(kf[5],qr[2],C1,0,0,0),   P1[6],P1[7],P1[8],P1[9],     pw2[2]=PKW(P1,4), pw2[3]=PKW(P1,6), pw2); \
    VRD(3); SBAR(); GAPA(C0=__builtin_amdgcn_mfma_f32_32x32x16_bf16(kf[6],qr[3],C0,0,0,0),   P1[10],P1[11],P1[12],P1[13], pw3[0]=PKW(P1,8), pw3[1]=PKW(P1,10), pw3); \
    VRD(7); SBAR(); GAPA(C1=__builtin_amdgcn_mfma_f32_32x32x16_bf16(kf[7],qr[3],C1,0,0,0),   P1[14],P1[15],0.f,0.f,       pw3[2]=PKW(P1,12),pw3[3]=PKW(P1,14), pw3); \
    l_reg+=sacc; \
    if(GK){DMA_K((t)+3,sl_cur);} if(GV){DMA_V((t)+1,sl_next);} \
    CMASK(C0,C1,t); \
    { float a=MX3(C0[0],C0[1],C1[0]),b=MX3(C0[2],C0[3],C1[1]); a=MX3(a,C1[2],C1[3]); \
      _Pragma("unroll") for(int r=4;r<16;r+=4){a=MX3(a,C0[r],C0[r+1]);b=MX3(b,C0[r+2],C0[r+3]);a=MX3(a,C1[r],C1[r+1]);b=MX3(b,C1[r+2],C1[r+3]);} \
      float rm=__builtin_fmaxf(a,b); { auto rr=__builtin_amdgcn_permlane32_swap(__float_as_uint(rm),__float_as_uint(rm),false,false); rm=__builtin_fmaxf(__uint_as_float(rr[0]),__uint_as_float(rr[1])); } \
      resc=false; \
      if(__builtin_expect(__any(rm>(float)THRL),0)){ const float dl=__builtin_fmaxf(rm,0.f); mhat+=dl; \
        _Pragma("unroll") for(int r=0;r<16;++r){C0[r]-=dl;C1[r]-=dl;} \
        _Pragma("unroll") for(int r=0;r<16;++r)negm[r]=-mhat; asm volatile("":"+v"(negm)); \
        const float f=__builtin_amdgcn_exp2f(-dl); l_reg*=f; if(hi==0)wsf[r32]=f; resc=true; } } \
    SBAR(); \
    GAPB(o[0]=__builtin_amdgcn_mfma_f32_32x32x16_bf16(PAF(0),VFR(0),o[0],0,0,0), C0,0); \
    GAPB(o[1]=__builtin_amdgcn_mfma_f32_32x32x16_bf16(PAF(0),VFR(4),o[1],0,0,0), C0,4); \
    KRD(GL,0); GAPB(o[0]=__builtin_amdgcn_mfma_f32_32x32x16_bf16(PAF(1),VFR(1),o[0],0,0,0), C0,8); \
    KRD(GL,1); GAPB(o[1]=__builtin_amdgcn_mfma_f32_32x32x16_bf16(PAF(1),VFR(5),o[1],0,0,0), C0,12); \
    KRD(GL,2); GAPB(o[0]=__builtin_amdgcn_mfma_f32_32x32x16_bf16(PAF(2),VFR(2),o[0],0,0,0), C1,0); \
    KRD(GL,3); GAPB(o[1]=__builtin_amdgcn_mfma_f32_32x32x16_bf16(PAF(2),VFR(6),o[1],0,0,0), C1,4); \
    GAPB(o[0]=__builtin_amdgcn_mfma_f32_32x32x16_bf16(PAF(3),VFR(3),o[0],0,0,0), C1,8); \
    GAPB(o[1]=__builtin_amdgcn_mfma_f32_32x32x16_bf16(PAF(3),VFR(7),o[1],0,0,0), C1,12); \
    }while(0)
  int t=1;
  #undef CMASK
  #define CMASK(P0,P1,t) do{}while(0)
  for(;t+5<NT;t+=2){
    STEP(pB0,pB1,pA0,pA1,t,true,true,true);     WAIT_BAR(2); RESC(); ROT();
    STEP(pA0,pA1,pB0,pB1,t+1,true,true,true);   WAIT_BAR(2); RESC(); ROT();
  }
  #undef CMASK
  #define CMASK(P0,P1,t) do{}while(0)
  #define ENDW(tt) do{ if((tt)+3<NT){WAIT_BAR(2);} else if((tt)+2<NT){WAIT_BAR(1);} else {WAIT_BAR(0);} }while(0)
  for(;t+1<NT;t+=2){
    STEP(pB0,pB1,pA0,pA1,t,(t+3<NT),(t+1<NT),(t+1<NT));       ENDW(t);   RESC(); ROT();
    STEP(pA0,pA1,pB0,pB1,t+1,(t+4<NT),(t+2<NT),(t+2<NT));     ENDW(t+1); RESC(); ROT();
  }
  STEP(pB0,pB1,pA0,pA1,NT-1,false,false,false); RESC();
  { float sacc=pB0[0]+pB0[1]; _Pragma("unroll") for(int r=2;r<16;++r)sacc+=pB0[r]; _Pragma("unroll") for(int r=0;r<16;++r)sacc+=pB1[r]; l_reg+=sacc;
    pw0=(u32x4){PKW(pB0,0),PKW(pB0,2),PKW(pB0,4),PKW(pB0,6)};pw1=(u32x4){PKW(pB0,8),PKW(pB0,10),PKW(pB0,12),PKW(pB0,14)};pw2=(u32x4){PKW(pB1,0),PKW(pB1,2),PKW(pB1,4),PKW(pB1,6)};pw3=(u32x4){PKW(pB1,8),PKW(pB1,10),PKW(pB1,12),PKW(pB1,14)};
    SBAR(); pv(o,vb0+sl_cur,PAF(0),PAF(1),PAF(2),PAF(3)); }
  #undef PKW
  #undef PAF
  #undef VFR
  #undef PIN
  #undef MX3
  #undef GAPA
  #undef GAPB
  #undef EX
  #undef VRD
  #undef KRD
  #undef STEP
  #undef ENDW
  {auto rr=__builtin_amdgcn_permlane32_swap(__float_as_uint(l_reg),__float_as_uint(l_reg),false,false);l_reg=__uint_as_float(rr[0])+__uint_as_float(rr[1]);}
  if(hi==0)wsf[32+r32]=l_reg;asm volatile("s_waitcnt lgkmcnt(0)":::"memory");
  float rli[16];
  #pragma unroll
  for(int r=0;r<16;++r)rli[r]=__builtin_amdgcn_rcpf(wsf[32+crow(r,hi)]);
  bf16*Ow=Ou+(long)(wid*QBLK)*OP;
  { bf16*stg=(bf16*)(shm+LDS_OST)+wid*2048;
    #pragma unroll
    for(int r=0;r<16;++r){const int orow=crow(r,hi);
      #pragma unroll
      for(int d0=0;d0<2;++d0)stg[orow*64+d0*32+r32]=__float2bfloat16(o[d0][r]*rli[r]);}
    asm volatile("s_waitcnt lgkmcnt(0)":::"memory");
    #pragma unroll
    for(int i=0;i<4;++i){const int row=i*8+(lane>>3),ch=lane&7; const u32x4 v=*(const u32x4*)(stg+row*64+ch*8); ATTN_STORE16(Ow+(long)row*OP+ch*8,v);} }
  asm volatile("s_waitcnt lgkmcnt(0)\n\ts_barrier":::"memory");
  #undef DMA_K
  #undef DMA_V
  #undef CMASK
  #undef START
  #undef RESC
  #undef ROT
}
constexpr int ATTN_LDS_BYTES=LDS_BYTES;
#undef SBAR
#undef WAIT_BAR
}
#define GAS __attribute__((address_space(1)))
#define LAS __attribute__((address_space(3)))
typedef unsigned short bf16;
typedef unsigned v4u __attribute__((ext_vector_type(4)));
typedef float f32x4 __attribute__((ext_vector_type(4)));
typedef short bf16x8 __attribute__((ext_vector_type(8)));
typedef GAS unsigned gu32;
typedef GAS unsigned long long gu64;
#define RLX_AGENT __ATOMIC_RELAXED, __HIP_MEMORY_SCOPE_AGENT
#define LDS_WAIT() asm volatile("s_waitcnt lgkmcnt(0)" ::: "memory")
#define VM_WAIT() asm volatile("s_waitcnt vmcnt(0)" ::: "memory")
__device__ __forceinline__ unsigned long long rt() { return __builtin_amdgcn_s_memrealtime(); }
__device__ __forceinline__ unsigned f2bf(float f) { unsigned u = __builtin_bit_cast(unsigned, f); return (u + 0x7fffu + ((u >> 16) & 1u)) >> 16; }
__device__ __forceinline__ unsigned pk2(float lo, float hi) { return f2bf(lo) | (f2bf(hi) << 16); }

#define XB_TMO      128
#define XB_XCNT(j)  (256  + 64 * (j))
#define XB_XSUB(j)  (1280 + 64 * (j))
#define XB_XGEN(j)  (2304 + 64 * (j))
#define XB_TOP      3328
#define XB_TOPGEN   3392
#define XCD_BAR_WORDS 3456
#define XB_SPIN_CAP (1u << 18)

__device__ __forceinline__ unsigned xb_ld(unsigned* p)              { return __hip_atomic_load(p, __ATOMIC_RELAXED, __HIP_MEMORY_SCOPE_AGENT); }
__device__ __forceinline__ unsigned xb_add(unsigned* p, unsigned v) { return __hip_atomic_fetch_add(p, v, __ATOMIC_RELAXED, __HIP_MEMORY_SCOPE_AGENT); }
__device__ __forceinline__ unsigned xb_xcc_id() { return (unsigned)__builtin_amdgcn_s_getreg((3 << 11) | 20) & 0xFu; }
#define XB_SPIN(cond, bar) do { unsigned _sp = 0; while (cond) { __builtin_amdgcn_s_sleep(1); \
    if ((++_sp & 255u) == 0u) { if (xb_ld(&(bar)[XB_TMO])) break; if (_sp > XB_SPIN_CAP) { atomicAdd(&(bar)[XB_TMO], 1u); break; } } } } while (0)

struct XcdBarrier {
    unsigned* bar; unsigned x;
    volatile LAS unsigned* st;
};

__device__ __forceinline__ XcdBarrier xcd_barrier_post(unsigned* bar, volatile LAS unsigned* st) {
    XcdBarrier b; b.bar = bar; b.x = xb_xcc_id(); b.st = st;
    if (threadIdx.x == 0) (void)xb_add(&bar[XB_XCNT(b.x)], 1u);
    return b;
}
__device__ __forceinline__ void xcd_barrier_complete(unsigned* bar, unsigned x, unsigned& nloc, unsigned& nx) {
    const unsigned G = gridDim.x * gridDim.y * gridDim.z;
    unsigned sum, cnt, mine, sp = 0u;
    for (;;) {
        sum = 0u; cnt = 0u; mine = 0u;
#pragma unroll
        for (unsigned j = 0; j < 16; ++j) { const unsigned c = xb_ld(&bar[XB_XCNT(j)]); sum += c; cnt += (c > 0u) ? 1u : 0u; mine = (j == x) ? c : mine; }
        if (sum == G) break;
        __builtin_amdgcn_s_sleep(1);
        if ((++sp & 255u) == 0u) { if (xb_ld(&bar[XB_TMO])) break; if (sp > XB_SPIN_CAP) { atomicAdd(&bar[XB_TMO], 1u); break; } }
    }
    nloc = mine > 0u ? mine : 1u; nx = cnt > 0u ? cnt : 1u;
}

__device__ __forceinline__ void xcd_barrier(const XcdBarrier& b) {
    asm volatile("s_waitcnt vmcnt(0)" ::: "memory");
    __syncthreads();
    if (threadIdx.x == 0) {
        unsigned* bar = b.bar;
        __builtin_amdgcn_s_waitcnt(0);
        unsigned nloc = b.st[0], nx = b.st[1];
        if (nloc == 0u) { xcd_barrier_complete(bar, b.x, nloc, nx); b.st[0] = nloc; b.st[1] = nx; }
        const unsigned old = xb_add(&bar[XB_XSUB(b.x)], 1u);
        const unsigned gen = old / nloc;
        if (old + 1u == (gen + 1u) * nloc) {
            __builtin_amdgcn_fence(__ATOMIC_RELEASE, "agent");
            asm volatile("s_waitcnt vmcnt(0)" ::: "memory");
            const unsigned og = xb_add(&bar[XB_TOP], 1u);
            const unsigned tg = og / nx;
            if (og + 1u == (tg + 1u) * nx) xb_add(&bar[XB_TOPGEN], 1u);
            else XB_SPIN(xb_ld(&bar[XB_TOPGEN]) == tg, bar);
            __builtin_amdgcn_fence(__ATOMIC_ACQUIRE, "agent");
            xb_add(&bar[XB_XGEN(b.x)], 1u);
            asm volatile("s_waitcnt vmcnt(0)" ::: "memory");
        } else {
            XB_SPIN(xb_ld(&bar[XB_XGEN(b.x)]) == gen, bar);
            __builtin_amdgcn_fence(__ATOMIC_ACQUIRE, "agent");
            asm volatile("s_waitcnt vmcnt(0)" ::: "memory");
        }
    }
    __syncthreads();
}
#ifndef FFT_HD
#define FFT_HD __device__ __forceinline__
#endif
struct __attribute__((aligned(8))) cpx { float x, y; };
FFT_HD cpx cadd(cpx a, cpx b) { return cpx{a.x + b.x, a.y + b.y}; }
FFT_HD cpx csub(cpx a, cpx b) { return cpx{a.x - b.x, a.y - b.y}; }
FFT_HD cpx cmul(cpx a, cpx b) { return cpx{a.x * b.x - a.y * b.y, a.x * b.y + a.y * b.x}; }
template <int SGN> FFT_HD cpx cmuli(cpx d) { return SGN > 0 ? cpx{-d.y, d.x} : cpx{d.y, -d.x}; }
template <int SGN> FFT_HD void dft4(cpx& u0, cpx& u1, cpx& u2, cpx& u3) {
    const cpx a0 = cadd(u0, u2), a1 = csub(u0, u2), b0 = cadd(u1, u3), b1 = cmuli<SGN>(csub(u1, u3));
    u0 = cadd(a0, b0); u2 = csub(a0, b0); u1 = cadd(a1, b1); u3 = csub(a1, b1);
}
template <int SGN> FFT_HD void dft8(cpx (&u)[8]) {
    dft4<SGN>(u[0], u[2], u[4], u[6]); dft4<SGN>(u[1], u[3], u[5], u[7]);
    const float H = 0.70710678118654752f;
    const cpx E0 = u[0], E1 = u[2], E2 = u[4], E3 = u[6];
    const cpx O0 = u[1], O1 = cmul(u[3], cpx{H, SGN * H}), O2 = cmuli<SGN>(u[5]), O3 = cmul(u[7], cpx{-H, SGN * H});
    u[0] = cadd(E0, O0); u[4] = csub(E0, O0); u[1] = cadd(E1, O1); u[5] = csub(E1, O1);
    u[2] = cadd(E2, O2); u[6] = csub(E2, O2); u[3] = cadd(E3, O3); u[7] = csub(E3, O3);
}
template <int SGN> FFT_HD void dft16(cpx (&u)[16]) {
    cpx e[8], o[8];
#pragma unroll
    for (int k = 0; k < 8; ++k) { e[k] = u[2 * k]; o[k] = u[2 * k + 1]; }
    dft8<SGN>(e); dft8<SGN>(o);
    const float C[8] = {1.f, 0.92387953251128674f, 0.70710678118654752f, 0.38268343236508977f, 0.f, -0.38268343236508977f, -0.70710678118654752f, -0.92387953251128674f};
    const float S[8] = {0.f, 0.38268343236508977f, 0.70710678118654752f, 0.92387953251128674f, 1.f, 0.92387953251128674f, 0.70710678118654752f, 0.38268343236508977f};
#pragma unroll
    for (int k = 0; k < 8; ++k) { const cpx t = cmul(o[k], cpx{C[k], SGN * S[k]}); u[k] = cadd(e[k], t); u[k + 8] = csub(e[k], t); }
}
FFT_HD int fpad(int n) { return n + (n >> 4); }
template <class BufPtr> FFT_HD cpx fft_ld(BufPtr buf, int i) { cpx v; v.x = buf[i].x; v.y = buf[i].y; return v; }
template <class BufPtr> FFT_HD void fft_st(BufPtr buf, int i, cpx v) { buf[i].x = v.x; buf[i].y = v.y; }
constexpr int FFT_N = 8192, FFT_BUF_ELEMS = FFT_N + FFT_N / 16;
#if defined(FFT_HOST_TEST)
static inline cpx fft_tw(float frac, int sgn) { const double a = 6.283185307179586476925 * (double)frac; return cpx{(float)cos(a), (float)(sgn * sin(a))}; }
#else
FFT_HD cpx fft_tw(float frac, int sgn) { return cpx{__builtin_amdgcn_cosf(frac), (float)sgn * __builtin_amdgcn_sinf(frac)}; }
#endif
template <int SGN, class BufPtr> FFT_HD void fft_p1_store(int tid, cpx (&u)[16], BufPtr buf) {
    dft16<SGN>(u);
#pragma unroll
    for (int r = 0; r < 16; ++r) fft_st(buf + 17 * tid, r, u[r]);
}
template <int SGN, int P, class BufPtr> FFT_HD void fft_p8_load(int tid, cpx (&u)[16], BufPtr buf) {
#pragma unroll
    for (int hlf = 0; hlf < 2; ++hlf) { const int i = tid + 512 * hlf, k = i & (P - 1);
        const cpx w1 = fft_tw((float)k * (1.0f / (float)(P * 8)), SGN), w2 = cmul(w1, w1), w3 = cmul(w2, w1), w4 = cmul(w2, w2), w5 = cmul(w4, w1), w6 = cmul(w3, w3), w7 = cmul(w4, w3);
        cpx v[8];
#pragma unroll
        for (int r = 0; r < 8; ++r) v[r] = fft_ld(buf + fpad(i), 1088 * r);
        v[1] = cmul(v[1], w1); v[2] = cmul(v[2], w2); v[3] = cmul(v[3], w3); v[4] = cmul(v[4], w4); v[5] = cmul(v[5], w5); v[6] = cmul(v[6], w6); v[7] = cmul(v[7], w7);
        dft8<SGN>(v);
#pragma unroll
        for (int r = 0; r < 8; ++r) u[8 * hlf + r] = v[r]; }
}
template <int P, class BufPtr> FFT_HD void fft_p8_store(int tid, const cpx (&u)[16], BufPtr buf) {
#pragma unroll
    for (int hlf = 0; hlf < 2; ++hlf) { const int i = tid + 512 * hlf, k = i & (P - 1), j = (i - k) * 8 + k;
#pragma unroll
        for (int r = 0; r < 8; ++r) fft_st(buf + fpad(j), r * (P + P / 16), u[8 * hlf + r]); }
}
FFT_HD void fft_regs_to_p1(const cpx (&u)[16], cpx (&v)[16]) {
#pragma unroll
    for (int r = 0; r < 8; ++r) { v[2 * r] = u[r]; v[2 * r + 1] = u[8 + r]; }
}
constexpr int NWAVES = 8;
constexpr int DM = 1024, NB = 4, SEQ = 4096, CTXL = 256, NLAT = NB * SEQ, NCTX = NB * CTXL, NTOK = NLAT + NCTX;
constexpr int DIN = 2304, NEXP = 32, DEPTH = 2, KVLEN = SEQ + CTXL;
constexpr int CQ = 0, CK = 512, CV = 640, CHY = 768, CNQ = 1536, CNK = 1792, CNV = 2048;
constexpr int MAXSORT = 77824;
constexpr float LN_EPS = 1e-6f, DN_ALPHA = 1.41421356237f;
constexpr float C2 = 0.125f * 1.4426950408889634f;
constexpr float W1_SCALE = 64.f, W2_SCALE = 128.f;
constexpr int PH_PER_LAYER = 10;
constexpr int NPHASE = 2 + PH_PER_LAYER * DEPTH;
#ifndef PROBE_MASK
#define PROBE_MASK 0
#endif
#define REPS(bit) for (int rep_ = 0; rep_ < 1 + ((PROBE_MASK >> (bit)) & 1); ++rep_)

constexpr size_t MiB = 1u << 20;
constexpr size_t WS_CTL = 0, CTL_ZERO_BYTES = 1 * MiB;
constexpr size_t WS_WIN = 2 * MiB, WS_WOUT = 12 * MiB, WS_W1 = 16 * MiB, WS_W2 = 272 * MiB, WS_MOD = 400 * MiB;
constexpr size_t WS_FILT = 402 * MiB, WS_FILTC = 418 * MiB, WS_X = 420 * MiB, WS_H = 488 * MiB, WS_P = 522 * MiB, WS_Q = 600 * MiB;
constexpr size_t WS_K = 618 * MiB, WS_V = 623 * MiB, WS_X0 = 628 * MiB, WS_ZT = 638 * MiB, WS_ZTC = 654 * MiB, WS_NQC = 655 * MiB, WS_YMIX = 656 * MiB;
constexpr size_t WS_Y = 690 * MiB, WS_ROUTE = 724 * MiB, WS_AS = 728 * MiB, WS_ACT = 880 * MiB, WS_Y4 = 1032 * MiB, WS_GF = 1168 * MiB, WS_YC = 1200 * MiB, WS_X1 = 1216 * MiB, WS_H8 = 1284 * MiB, WS_END = 1302 * MiB;
constexpr size_t RT_TOPI = 0, RT_GATE = 69632, RT_SLOTPOS = 139264, RT_CNT = 208896, RT_TT = 217088, RT_ROWSLOT = 218112;
static_assert((RT_ROWSLOT + MAXSORT) * 4 <= 4 * MiB, "route region");
constexpr int CW_BAR = 4096, CW_WCMAX = 8192;
constexpr size_t RT_SH = 300000;
static_assert((RT_SH + NTOK) * 4 <= 4 * MiB, "route region");

constexpr int RING_OFF = 0, RING_BYTES = 147456;
constexpr int LDSCTL_OFF = RING_BYTES, LDSCTL_BYTES = 4096, LDS_TT_OFF = LDSCTL_OFF + 1024;
constexpr int LDS_BYTES = RING_BYTES + LDSCTL_BYTES;

__device__ __forceinline__ float bf2f(unsigned short h) { return __uint_as_float(((unsigned)h) << 16); }
__device__ __forceinline__ float bflo(unsigned w) { return __uint_as_float(w << 16); }
__device__ __forceinline__ float bfhi(unsigned w) { return __uint_as_float(w & 0xffff0000u); }
__device__ __forceinline__ unsigned pk4_i8(float a, float b, float c, float d) {
    const int q0 = __float2int_rn(a), q1 = __float2int_rn(b), q2 = __float2int_rn(c), q3 = __float2int_rn(d);
    return (unsigned)(q0 & 255) | ((unsigned)(q1 & 255) << 8) | ((unsigned)(q2 & 255) << 16) | ((unsigned)q3 << 24);
}
__device__ __forceinline__ unsigned pk4_fp8(float a, float b, float c, float d) {
    a = fminf(fmaxf(a, -448.f), 448.f); b = fminf(fmaxf(b, -448.f), 448.f); c = fminf(fmaxf(c, -448.f), 448.f); d = fminf(fmaxf(d, -448.f), 448.f);
    unsigned w = 0u; w = (unsigned)__builtin_amdgcn_cvt_pk_fp8_f32(a, b, (int)w, false); w = (unsigned)__builtin_amdgcn_cvt_pk_fp8_f32(c, d, (int)w, true); return w;
}
__device__ __forceinline__ float wave_sum(float v) {
    v += __builtin_bit_cast(float, __builtin_amdgcn_update_dpp(0, __builtin_bit_cast(int, v), 0xB1, 0xF, 0xF, true));
    v += __builtin_bit_cast(float, __builtin_amdgcn_update_dpp(0, __builtin_bit_cast(int, v), 0x4E, 0xF, 0xF, true));
    v += __builtin_bit_cast(float, __builtin_amdgcn_update_dpp(0, __builtin_bit_cast(int, v), 0x141, 0xF, 0xF, true));
    v += __builtin_bit_cast(float, __builtin_amdgcn_update_dpp(0, __builtin_bit_cast(int, v), 0x140, 0xF, 0xF, true));
    const int vi = __builtin_bit_cast(int, v);
    const float r0 = __builtin_bit_cast(float, __builtin_amdgcn_readlane(vi, 0)), r1 = __builtin_bit_cast(float, __builtin_amdgcn_readlane(vi, 16));
    const float r2 = __builtin_bit_cast(float, __builtin_amdgcn_readlane(vi, 32)), r3 = __builtin_bit_cast(float, __builtin_amdgcn_readlane(vi, 48));
    return (r0 + r1) + (r2 + r3);
}
__device__ __forceinline__ float wave_max(float v) {
    v = fmaxf(v, __builtin_bit_cast(float, __builtin_amdgcn_update_dpp(0, __builtin_bit_cast(int, v), 0xB1, 0xF, 0xF, true)));
    v = fmaxf(v, __builtin_bit_cast(float, __builtin_amdgcn_update_dpp(0, __builtin_bit_cast(int, v), 0x4E, 0xF, 0xF, true)));
    v = fmaxf(v, __builtin_bit_cast(float, __builtin_amdgcn_update_dpp(0, __builtin_bit_cast(int, v), 0x141, 0xF, 0xF, true)));
    v = fmaxf(v, __builtin_bit_cast(float, __builtin_amdgcn_update_dpp(0, __builtin_bit_cast(int, v), 0x140, 0xF, 0xF, true)));
    const int vi = __builtin_bit_cast(int, v);
    const float r0 = __builtin_bit_cast(float, __builtin_amdgcn_readlane(vi, 0)), r1 = __builtin_bit_cast(float, __builtin_amdgcn_readlane(vi, 16));
    const float r2 = __builtin_bit_cast(float, __builtin_amdgcn_readlane(vi, 32)), r3 = __builtin_bit_cast(float, __builtin_amdgcn_readlane(vi, 48));
    return fmaxf(fmaxf(r0, r1), fmaxf(r2, r3));
}

template <int CTRL> __device__ __forceinline__ float rs_fold(float X, float Y, bool keepY) {
    const float A = keepY ? Y : X, B = keepY ? X : Y;
    return A + __builtin_bit_cast(float, __builtin_amdgcn_update_dpp(0, __builtin_bit_cast(int, B), CTRL, 0xF, 0xF, true));
}
__device__ __forceinline__ float rs64(const float (&v)[64], int lane) {
    float z1[32], z2[16], z3[8], z4[4], z5[2];
#pragma unroll
    for (int i = 0; i < 32; ++i) { const auto r = __builtin_amdgcn_permlane32_swap(__float_as_uint(v[i]), __float_as_uint(v[i + 32]), false, false); z1[i] = __uint_as_float(r[0]) + __uint_as_float(r[1]); }
#pragma unroll
    for (int i = 0; i < 16; ++i) { const auto r = __builtin_amdgcn_permlane16_swap(__float_as_uint(z1[i]), __float_as_uint(z1[i + 16]), false, false); z2[i] = __uint_as_float(r[0]) + __uint_as_float(r[1]); }
    const bool b3 = lane & 8, b2 = lane & 4, b1 = lane & 2, b0 = lane & 1;
#pragma unroll
    for (int i = 0; i < 8; ++i) z3[i] = rs_fold<0x140>(z2[i], z2[i + 8], b3);
#pragma unroll
    for (int i = 0; i < 4; ++i) z4[i] = rs_fold<0x141>(z3[i], z3[i + 4], b2);
#pragma unroll
    for (int i = 0; i < 2; ++i) z5[i] = rs_fold<0x4E>(z4[i], z4[i + 2], b1);
    return rs_fold<0xB1>(z5[0], z5[1], b0);
}

struct Frame {
    LAS unsigned char* lds;
    volatile LAS unsigned* MISC;
    gu32* ctl;
    int tid, lane, wave;
    int vcu, G;
    float* out;
    unsigned char* ws;
};
typedef __attribute__((address_space(4))) const char* kargp_t;
__device__ __forceinline__ const float* inp(int i) {
#if defined(__HIP_DEVICE_COMPILE__)
    kargp_t base = (kargp_t)__builtin_amdgcn_kernarg_segment_ptr();
    asm volatile("" : "+s"(base));
    typedef const float* cfp_t;
    return *(__attribute__((address_space(4))) const cfp_t*)(base + 8 * i);
#else
    return nullptr;
#endif
}
#define INP(i) inp(i)
#define IN_X 0
#define IN_C 1
#define IN_CTX 2
#define IN_CCTX 3
#define IN_ADAW 4
#define IN_ADAB 5
#define IN_WIN 6
#define IN_WOUT 7
#define IN_QG 8
#define IN_KG 9
#define IN_HCW 10
#define IN_HCB 11
#define IN_HW1 12
#define IN_HB1 13
#define IN_HFREQ 14
#define IN_HW2 15
#define IN_HB2 16
#define IN_HW3 17
#define IN_HB3 18
#define IN_HD 19
#define IN_RPB 20
#define IN_LN1G 21
#define IN_LN1B 22
#define IN_LN2G 23
#define IN_LN2B 24
#define IN_RW 25
#define IN_RB 26
#define IN_EW1 27
#define IN_EB1 28
#define IN_EW2 29
#define IN_EB2 30

#define WSP(T, off) ((T*)(F.ws + (off)))

template <class T> __device__ __forceinline__ T* sgpr_ptr(T* p) { asm volatile("" : "+s"(p)); return p; }
__device__ __forceinline__ void p0_transpose_item(const float* W, int K, int N, bf16* WT, int row_off, LAS float* scr, int item, int lane) {
    const int nblk = N / 64, kb = item / nblk, nb = item % nblk, k0 = 64 * kb, n0 = 64 * nb;
    const int n4 = lane & 15, kr = lane >> 4;
    const float* src = W + (size_t)(k0 + kr) * N + n0 + 4 * n4;
    f32x4 v[16];
#pragma unroll
    for (int i = 0; i < 16; ++i) v[i] = __builtin_nontemporal_load((const f32x4*)(src + (size_t)(4 * i) * N));
#pragma unroll
    for (int i = 0; i < 16; ++i) { LAS float* d = scr + (4 * i + kr) * 65 + 4 * n4; d[0] = v[i].x; d[1] = v[i].y; d[2] = v[i].z; d[3] = v[i].w; }
    LDS_WAIT(); asm volatile("" ::: "memory");
    const int c = lane & 7;
#pragma unroll
    for (int j = 0; j < 8; ++j) { const int n = (lane >> 3) + 8 * j; const LAS float* s = scr + (8 * c) * 65 + n;
        v4u o; o.x = pk2(s[0 * 65], s[1 * 65]); o.y = pk2(s[2 * 65], s[3 * 65]); o.z = pk2(s[4 * 65], s[5 * 65]); o.w = pk2(s[6 * 65], s[7 * 65]);
        *(GAS v4u*)(WT + (size_t)(row_off + n0 + n) * K + k0 + 8 * c) = o; }
    LDS_WAIT(); asm volatile("" ::: "memory");
}

__device__ __forceinline__ void p0_transpose_item8(const float* W, int K, int N, unsigned char* WT, int row_off, float scale, LAS float* scr, int item, int lane) {
    const int nblk = N / 64, kb = item / nblk, nb = item % nblk, k0 = 64 * kb, n0 = 64 * nb;
    const int n4 = lane & 15, kr = lane >> 4;
    const float* src = W + (size_t)(k0 + kr) * N + n0 + 4 * n4;
    f32x4 v[16];
#pragma unroll
    for (int i = 0; i < 16; ++i) v[i] = __builtin_nontemporal_load((const f32x4*)(src + (size_t)(4 * i) * N));
#pragma unroll
    for (int i = 0; i < 16; ++i) { LAS float* d = scr + (4 * i + kr) * 65 + 4 * n4; d[0] = v[i].x; d[1] = v[i].y; d[2] = v[i].z; d[3] = v[i].w; }
    LDS_WAIT(); asm volatile("" ::: "memory");
    const int c = lane & 7;
#pragma unroll
    for (int j = 0; j < 8; ++j) { const int n = (lane >> 3) + 8 * j; const LAS float* s = scr + (8 * c) * 65 + n;
        const unsigned lo = pk4_fp8(s[0 * 65] * scale, s[1 * 65] * scale, s[2 * 65] * scale, s[3 * 65] * scale), hi = pk4_fp8(s[4 * 65] * scale, s[5 * 65] * scale, s[6 * 65] * scale, s[7 * 65] * scale);
        *(GAS unsigned long long*)(WT + (size_t)(row_off + n0 + n) * K + k0 + 8 * c) = (unsigned long long)lo | ((unsigned long long)hi << 32); }
    LDS_WAIT(); asm volatile("" ::: "memory");
}

struct XItem { const float* src; unsigned char* dst; int N; float scale; };
__device__ __forceinline__ XItem p0_xitem(Frame& F, const float* ew1, const float* ew2, int it, int lane) {
    constexpr int PER_E1 = 8 * 64, PER_E2 = 8 * 32, PER_L = NEXP * (PER_E1 + PER_E2);
    const int l = it / PER_L; int r = it % PER_L; XItem x; const int n4 = lane & 7, kr = lane >> 3;
    if (r < NEXP * PER_E1) { const int e = r / PER_E1, rr = r % PER_E1, kb = rr / 64, nb = rr % 64, k0 = 128 * kb, n0 = 32 * nb;
        const int drow = n0 < 1024 ? 256 * (n0 / 128) + (n0 % 128) : 256 * ((n0 - 1024) / 128) + 128 + ((n0 - 1024) % 128);
        x.src = ew1 + (size_t)(l * NEXP + e) * DM * 2048 + (size_t)(k0 + kr) * 2048 + n0 + 4 * n4; x.N = 2048; x.scale = W1_SCALE;
        x.dst = WSP(unsigned char, WS_W1) + (size_t)(l * NEXP + e) * 2048 * DM + (size_t)drow * DM + k0; }
    else { r -= NEXP * PER_E1; const int e = r / PER_E2, rr = r % PER_E2, kb = rr / 32, nb = rr % 32, k0 = 128 * kb, n0 = 32 * nb;
        x.src = ew2 + (size_t)(l * NEXP + e) * DM * DM + (size_t)(k0 + kr) * DM + n0 + 4 * n4; x.N = DM; x.scale = W2_SCALE;
        x.dst = WSP(unsigned char, WS_W2) + (size_t)(l * NEXP + e) * DM * DM + (size_t)n0 * DM + k0; }
    return x;
}
__device__ __forceinline__ void p0_xload(const XItem& x, f32x4 (&v)[16]) {
#pragma unroll
    for (int i = 0; i < 16; ++i) v[i] = __builtin_nontemporal_load((const f32x4*)(x.src + (size_t)(8 * i) * x.N));
}
__device__ __forceinline__ void p0_xstore(const XItem& x, const f32x4 (&v)[16], LAS float* scr, int lane) {
    LAS unsigned char* t8 = (LAS unsigned char*)scr; const int n4 = lane & 7, kr = lane >> 3; const float scale = x.scale;
#pragma unroll
    for (int i = 0; i < 16; ++i) { const unsigned w = pk4_fp8(v[i].x * scale, v[i].y * scale, v[i].z * scale, v[i].w * scale); const int k = kr + 8 * i;
        t8[(4 * n4 + 0) * 144 + k] = (unsigned char)w; t8[(4 * n4 + 1) * 144 + k] = (unsigned char)(w >> 8); t8[(4 * n4 + 2) * 144 + k] = (unsigned char)(w >> 16); t8[(4 * n4 + 3) * 144 + k] = (unsigned char)(w >> 24); }
    LDS_WAIT(); asm volatile("" ::: "memory");
#pragma unroll
    for (int j = 0; j < 4; ++j) { const int n = (lane >> 3) + 8 * j, c = lane & 7;
        const v4u o = *(const LAS v4u*)(t8 + n * 144 + 16 * c); *(GAS v4u*)(x.dst + (size_t)n * DM + 16 * c) = o; }
    LDS_WAIT(); asm volatile("" ::: "memory");
}
__device__ __forceinline__ void p0_expert_weights(Frame& F, LAS float* scr, int it_lo, int it_hi) {
    const int gw = F.vcu * NWAVES + F.wave, NGW = F.G * NWAVES, lane = F.lane;
    const float* ew1 = INP(IN_EW1); const float* ew2 = INP(IN_EW2);
    int it = it_lo + gw; if (it >= it_hi) return;
    XItem cur = p0_xitem(F, ew1, ew2, it, lane); f32x4 vc[16]; p0_xload(cur, vc);
    for (;;) { const int nx = it + NGW; const bool more = nx < it_hi;
        XItem nxt = cur; f32x4 vn[16];
        if (more) { nxt = p0_xitem(F, ew1, ew2, nx, lane); p0_xload(nxt, vn); }
        p0_xstore(cur, vc, scr, lane);
        if (!more) break;
        cur = nxt; it = nx;
#pragma unroll
        for (int i = 0; i < 16; ++i) vc[i] = vn[i]; }
}

__device__ __forceinline__ void p0_wmax_item(Frame& F, int it) {
    const int l = it / 288, r = it % 288, nb = r / 8, kc = r % 8, n = nb * 64 + F.lane;
    const float* W = INP(IN_WIN) + (size_t)l * DM * DIN + (size_t)(kc * 128) * DIN + n; float mx = 0.f;
#pragma unroll 16
    for (int k = 0; k < 128; ++k) mx = fmaxf(mx, fabsf(W[(size_t)k * DIN]));
    __hip_atomic_fetch_max((int*)(F.ctl + CW_WCMAX) + l * DIN + n, __float_as_int(mx), __ATOMIC_RELAXED, __HIP_MEMORY_SCOPE_AGENT);
}
__device__ __forceinline__ void p1_win_i8_item(Frame& F, int it, LAS float* scr) {
    const int lane = F.lane, l = it / 576, r = it % 576, kb = r / 36, nb = r % 36, k0 = 64 * kb, n0 = 64 * nb;
    const int n4 = lane & 15, kr = lane >> 4;
    const float* src = INP(IN_WIN) + (size_t)l * DM * DIN + (size_t)(k0 + kr) * DIN + n0 + 4 * n4;
    f32x4 v[16];
#pragma unroll
    for (int i = 0; i < 16; ++i) v[i] = *(const f32x4*)(src + (size_t)(4 * i) * DIN);
#pragma unroll
    for (int i = 0; i < 16; ++i) { LAS float* d = scr + (4 * i + kr) * 65 + 4 * n4; d[0] = v[i].x; d[1] = v[i].y; d[2] = v[i].z; d[3] = v[i].w; }
    LDS_WAIT(); asm volatile("" ::: "memory");
    const int c = lane & 7; unsigned char* WT = WSP(unsigned char, WS_WIN) + (size_t)l * DIN * DM;
#pragma unroll
    for (int j = 0; j < 8; ++j) { const int n = (lane >> 3) + 8 * j; const LAS float* s = scr + (8 * c) * 65 + n;
        const float cm = __int_as_float(__hip_atomic_load((int*)(F.ctl + CW_WCMAX) + l * DIN + n0 + n, __ATOMIC_RELAXED, __HIP_MEMORY_SCOPE_AGENT)), sc = cm > 0.f ? 127.f / cm : 0.f;
        const unsigned lo = pk4_i8(s[0 * 65] * sc, s[1 * 65] * sc, s[2 * 65] * sc, s[3 * 65] * sc), hi = pk4_i8(s[4 * 65] * sc, s[5 * 65] * sc, s[6 * 65] * sc, s[7 * 65] * sc);
        *(GAS unsigned long long*)(WT + (size_t)(n0 + n) * DM + k0 + 8 * c) = (unsigned long long)lo | ((unsigned long long)hi << 32); }
    LDS_WAIT(); asm volatile("" ::: "memory");
}

__device__ __forceinline__ float rl_f(float x, int k) { return __int_as_float(__builtin_amdgcn_readlane(__float_as_int(x), k)); }
__device__ __forceinline__ void p0_mod_item(Frame& F, int it) {
    const int l = it / 96, cb = it % 96, col = cb * 64 + F.lane, kbase = F.wave * 128;
    const float* W = INP(IN_ADAW) + (size_t)l * DM * 6144 + (size_t)kbase * 6144 + col;
    const float* c = INP(IN_C) + kbase; const float* cc = INP(IN_CCTX) + kbase;
    float s[2][5];
#pragma unroll
    for (int h = 0; h < 2; ++h) { const int k = 64 * h + F.lane; const float c0 = c[k], c1 = c[DM + k], c2 = c[2 * DM + k], c3 = c[3 * DM + k], c4 = cc[k];
        s[h][0] = c0 / (1.f + __expf(-c0)); s[h][1] = c1 / (1.f + __expf(-c1)); s[h][2] = c2 / (1.f + __expf(-c2)); s[h][3] = c3 / (1.f + __expf(-c3)); s[h][4] = c4 / (1.f + __expf(-c4)); }
    float a0 = 0.f, a1 = 0.f, a2 = 0.f, a3 = 0.f, a4 = 0.f;
#pragma unroll
    for (int h = 0; h < 2; ++h) {
#pragma unroll 32
        for (int k = 0; k < 64; ++k) {
            const float w = W[(size_t)(64 * h + k) * 6144];
            a0 += rl_f(s[h][0], k) * w; a1 += rl_f(s[h][1], k) * w; a2 += rl_f(s[h][2], k) * w; a3 += rl_f(s[h][3], k) * w; a4 += rl_f(s[h][4], k) * w; } }
    LAS float* part = (LAS float*)(F.lds + RING_OFF);
    part[(F.wave * 5 + 0) * 64 + F.lane] = a0; part[(F.wave * 5 + 1) * 64 + F.lane] = a1; part[(F.wave * 5 + 2) * 64 + F.lane] = a2;
    part[(F.wave * 5 + 3) * 64 + F.lane] = a3; part[(F.wave * 5 + 4) * 64 + F.lane] = a4;
    __syncthreads();
    if (F.wave < 5) { float s = INP(IN_ADAB)[l * 6144 + col];
#pragma unroll
        for (int w = 0; w < 8; ++w) s += part[(w * 5 + F.wave) * 64 + F.lane];
        WSP(float, WS_MOD)[(size_t)(l * 5 + F.wave) * 6144 + col] = s; }
    __syncthreads();
}

__device__ __forceinline__ void p0_filter_block(Frame& F, int it) {
    const int lane = F.lane, wave = F.wave;
    const int l = it / 136, rr = it % 136, type = rr >= 128 ? 1 : 0, tb = type ? rr - 128 : rr, L = type ? 256 : 4096;
    float zv[4], tn[4];
#pragma unroll
    for (int j = 0; j < 4; ++j) { const int t = 32 * tb + 4 * wave + j;
        tn[j] = (float)t / (float)(L - 1);
        const float w = (6.283185307179586f / (float)L) * (float)t;
        float z = 0.f;
        if (lane == 0) z = tn[j];
        else if (lane <= 16) { const float band = 1e-4f + (float)(lane - 1) * ((15.0f - 1e-4f) / 15.0f); z = cosf(band * w); }
        else if (lane <= 32) { const float band = 1e-4f + (float)(lane - 17) * ((15.0f - 1e-4f) / 15.0f); z = -sinf(band * w); }
        zv[j] = z; }
    const float* w1 = sgpr_ptr(INP(IN_HW1) + l * 33 * 64); const float* w2 = sgpr_ptr(INP(IN_HW2) + l * 64 * 64); const float* w3 = sgpr_ptr(INP(IN_HW3) + l * 64 * 512);
    float a[4]; { const float b = INP(IN_HB1)[l * 64 + lane];
#pragma unroll
        for (int j = 0; j < 4; ++j) a[j] = b; }
#pragma unroll
    for (int k = 0; k < 33; ++k) { const float wv = w1[k * 64 + lane];
#pragma unroll
        for (int j = 0; j < 4; ++j) a[j] += rl_f(zv[j], k) * wv; }
    float h1[4]; { const float f = INP(IN_HFREQ)[l * 128 + lane];
#pragma unroll
        for (int j = 0; j < 4; ++j) h1[j] = sinf(f * a[j]); }
    { const float b = INP(IN_HB2)[l * 64 + lane];
#pragma unroll
        for (int j = 0; j < 4; ++j) a[j] = b; }
#pragma unroll 32
    for (int k = 0; k < 64; ++k) { const float wv = w2[k * 64 + lane];
#pragma unroll
        for (int j = 0; j < 4; ++j) a[j] += rl_f(h1[j], k) * wv; }
    float h2[4]; { const float f = INP(IN_HFREQ)[l * 128 + 64 + lane];
#pragma unroll
        for (int j = 0; j < 4; ++j) h2[j] = sinf(f * a[j]); }
    float o[4][8]; { const float* b3p = INP(IN_HB3) + l * 512 + lane;
#pragma unroll
        for (int i = 0; i < 8; ++i) { const float b = b3p[64 * i];
#pragma unroll
            for (int j = 0; j < 4; ++j) o[j][i] = b; } }
#pragma unroll 8
    for (int k = 0; k < 64; ++k) { float wv[8];
#pragma unroll
        for (int i = 0; i < 8; ++i) wv[i] = w3[k * 512 + lane + 64 * i];
#pragma unroll
        for (int j = 0; j < 4; ++j) { const float hk = rl_f(h2[j], k);
#pragma unroll
            for (int i = 0; i < 8; ++i) o[j][i] += hk * wv[i]; } }
    LAS float* tile = (LAS float*)(F.lds + RING_OFF);
#pragma unroll
    for (int i = 0; i < 8; ++i) { const int c = lane + 64 * i, ch = c & 255;
        const float ad = 3.0701134573253945f + (float)ch * ((15.350567286626973f - 3.0701134573253945f) / 255.0f);
        f32x4 r; r.x = o[0][i] * expf(-tn[0] * ad); r.y = o[1][i] * expf(-tn[1] * ad); r.z = o[2][i] * expf(-tn[2] * ad); r.w = o[3][i] * expf(-tn[3] * ad);
        *(LAS f32x4*)(tile + c * 36 + 4 * wave) = r; }
    __syncthreads();
    float* dst = type ? WSP(float, WS_FILTC) + (size_t)l * 2 * 256 * 256 : WSP(float, WS_FILT) + (size_t)l * 2 * 256 * 4096;
#pragma unroll
    for (int p = 0; p < 8; ++p) { const int c = 64 * p + (F.tid >> 3), q = F.tid & 7;
        const f32x4 r = *(const LAS f32x4*)(tile + c * 36 + 4 * q);
        *(f32x4*)(dst + (size_t)c * L + 32 * tb + 4 * q) = r; }
    __syncthreads();
}

__device__ __forceinline__ void ph_prologue(Frame& F) {
    LAS float* scr = (LAS float*)(F.lds + RING_OFF + F.wave * 16640);
    const int gw = F.vcu * NWAVES + F.wave, NGW = F.G * NWAVES;
    constexpr int I_IN = 16 * 36, I_OUT = 16 * 16, I_W1 = 32 * 16 * 32, I_W2 = 32 * 16 * 16, I_L = I_IN + I_OUT + I_W1 + I_W2;
    REPS(13) for (int it = F.vcu; it < 192; it += F.G) p0_mod_item(F, it);
    REPS(14) for (int it = F.G - 1 - F.vcu; it < 2 * 136; it += F.G) p0_filter_block(F, it);
    REPS(15) { for (int it = gw; it < 2 * 288; it += NGW) p0_wmax_item(F, it);
    for (int it = gw; it < 2 * I_OUT; it += NGW) p0_transpose_item(INP(IN_WOUT) + (size_t)(it / I_OUT) * DM * DM, DM, DM, WSP(bf16, WS_WOUT) + (size_t)(it / I_OUT) * DM * DM, 0, scr, it % I_OUT, F.lane); }
    REPS(16) p0_expert_weights(F, scr, 0, 2 * NEXP * (16 * 32 + 16 * 16));
}

__device__ __forceinline__ void row_stats(const f32x4 (&v)[4], float& mean, float& rstd) {
    float s = 0.f;
#pragma unroll
    for (int j = 0; j < 4; ++j) s += (v[j].x + v[j].y) + (v[j].z + v[j].w);
    mean = wave_sum(s) * (1.f / DM); float s2 = 0.f;
#pragma unroll
    for (int j = 0; j < 4; ++j) { const f32x4 d = v[j] - mean; s2 += (d.x * d.x + d.y * d.y) + (d.z * d.z + d.w * d.w); }
    rstd = 1.f / sqrtf(wave_sum(s2) * (1.f / DM) + LN_EPS);
}
__device__ __forceinline__ const float* modp(Frame& F, int l, int bsel, int which) { return WSP(float, WS_MOD) + ((size_t)(l * 5 + bsel) * 6 + which) * DM; }
__device__ __forceinline__ void modulate_store(Frame& F, const f32x4 (&v)[4], const f32x4 (&sh)[4], const f32x4 (&sc)[4], bf16* orow, f32x4 (&hv)[4]) {
    float mean, rstd; row_stats(v, mean, rstd);
    GAS unsigned long long* o8 = (GAS unsigned long long*)orow + F.lane;
#pragma unroll
    for (int j = 0; j < 4; ++j) { hv[j] = (v[j] - mean) * rstd * (sc[j] + 1.0f) + sh[j];
        o8[64 * j] = (unsigned long long)pk2(hv[j].x, hv[j].y) | ((unsigned long long)pk2(hv[j].z, hv[j].w) << 32); }
}
__device__ __forceinline__ void modulate_store8(Frame& F, const f32x4 (&v)[4], const f32x4 (&sh)[4], const f32x4 (&sc)[4], unsigned char* orow, f32x4 (&hv)[4]) {
    float mean, rstd; row_stats(v, mean, rstd);
    GAS unsigned* o4 = (GAS unsigned*)orow + F.lane;
#pragma unroll
    for (int j = 0; j < 4; ++j) { hv[j] = (v[j] - mean) * rstd * (sc[j] + 1.0f) + sh[j]; o4[64 * j] = pk4_fp8(hv[j].x, hv[j].y, hv[j].z, hv[j].w); }
}
__device__ __forceinline__ void modulate_store_i8(Frame& F, const f32x4 (&v)[4], const f32x4 (&sh)[4], const f32x4 (&sc)[4], unsigned char* orow, float* srow) {
    float mean, rstd; row_stats(v, mean, rstd); f32x4 hv[4]; float mx = 0.f;
#pragma unroll
    for (int j = 0; j < 4; ++j) { hv[j] = (v[j] - mean) * rstd * (sc[j] + 1.0f) + sh[j]; mx = fmaxf(mx, fmaxf(fmaxf(fabsf(hv[j].x), fabsf(hv[j].y)), fmaxf(fabsf(hv[j].z), fabsf(hv[j].w)))); }
    mx = wave_max(mx); const float q = mx > 0.f ? 127.f / mx : 0.f;
    GAS unsigned* o4 = (GAS unsigned*)orow + F.lane;
#pragma unroll
    for (int j = 0; j < 4; ++j) o4[64 * j] = pk4_i8(hv[j].x * q, hv[j].y * q, hv[j].z * q, hv[j].w * q);
    if (F.lane == 0) *srow = mx * (1.f / 127.f);
}
__device__ __forceinline__ void ldvec(const float* p, int lane, f32x4 (&d)[4]) {
#pragma unroll
    for (int j = 0; j < 4; ++j) d[j] = ((const f32x4*)p)[lane + 64 * j];
}
__device__ __forceinline__ void ph_r0(Frame& F) {
    const int gw = F.vcu * NWAVES + F.wave, NGW = F.G * NWAVES, lane = F.lane;
    const float* xin = INP(IN_X); const float* cin = INP(IN_CTX);
    for (int rA = gw; rA < NTOK; rA += 2 * NGW) {
        f32x4 v[2][4], sh[2][4], sc[2][4];
#pragma unroll
        for (int q = 0; q < 2; ++q) { const int r0 = rA + q * NGW, r = r0 < NTOK ? r0 : rA; const int bsel = r < NLAT ? r / SEQ : 4;
            ldvec(r < NLAT ? xin + (size_t)r * DM : cin + (size_t)(r - NLAT) * DM, lane, v[q]); ldvec(modp(F, 0, bsel, 0), lane, sh[q]); ldvec(modp(F, 0, bsel, 1), lane, sc[q]); }
#pragma unroll
        for (int q = 0; q < 2; ++q) { const int r = rA + q * NGW; if (r < NTOK) modulate_store_i8(F, v[q], sh[q], sc[q], WSP(unsigned char, WS_H) + (size_t)r * DM, WSP(float, WS_ROUTE) + RT_SH + r); }
    }
}

__device__ __forceinline__ void unpack8(const v4u raw, float (&x)[8]) {
    x[0] = bflo(raw.x); x[1] = bfhi(raw.x); x[2] = bflo(raw.y); x[3] = bfhi(raw.y); x[4] = bflo(raw.z); x[5] = bfhi(raw.z); x[6] = bflo(raw.w); x[7] = bfhi(raw.w);
}
__device__ __forceinline__ v4u pack8(const float (&x)[8]) { v4u o; o.x = pk2(x[0], x[1]); o.y = pk2(x[2], x[3]); o.z = pk2(x[4], x[5]); o.w = pk2(x[6], x[7]); return o; }
__device__ __forceinline__ void head_norm_rope(float (&x)[8], const float* gain, int lane, bool rope, const f32x4 (&cs4)[2], const f32x4 (&sn4)[2]) {
    float ss = 0.f;
#pragma unroll
    for (int i = 0; i < 8; ++i) ss += x[i] * x[i];
    ss += __shfl_xor(ss, 1); ss += __shfl_xor(ss, 2); ss += __shfl_xor(ss, 4);
    const float rinv = 1.f / sqrtf(ss * (1.f / 64.f) + LN_EPS);
    const int d0 = (lane & 7) * 8;
#pragma unroll
    for (int i = 0; i < 8; ++i) x[i] = x[i] * rinv * gain[d0 + i];
    const int half = (lane >> 1) & 1;
#pragma unroll
    for (int i = 0; i < 8; ++i) {
        const float pv = __shfl_xor(x[i], 2);
        if (rope) { const float cs = cs4[i >> 2][i & 3], sn = sn4[i >> 2][i & 3]; x[i] = x[i] * cs + (half ? pv : -pv) * sn; }
    }
}
__device__ __forceinline__ void ph_prep(Frame& F, int l) {
    const int gw = F.vcu * NWAVES + F.wave, NGW = F.G * NWAVES, lane = F.lane;
    const bf16* P = WSP(bf16, WS_P);
    const float* qg = INP(IN_QG) + l * 64; const float* kg = INP(IN_KG) + l * 64;
    LAS float* tabc = (LAS float*)(F.lds + RING_OFF + 8 * 16640); LAS float* tabs = tabc + 1024;
    for (int idx = F.tid; idx < 1024; idx += 512) { const float ang = (float)(idx >> 4) * exp2f(-(float)(idx & 15) * (13.287712379549449f / 16.0f)); tabc[idx] = cosf(ang); tabs[idx] = sinf(ang); }
    __syncthreads();
    v4u rq_n = {0u, 0u, 0u, 0u}, rk_n = {0u, 0u, 0u, 0u};
    if (gw < NTOK) { const bf16* prow = P + (size_t)gw * DIN; rq_n = *(const GAS v4u*)(prow + CQ + lane * 8); rk_n = *(const GAS v4u*)(prow + CK + (lane & 31) * 8); }
    for (int r = gw; r < NTOK; r += NGW) {
        const bool lat = r < NLAT; const int b = lat ? r / SEQ : (r - NLAT) / CTXL, t = lat ? r % SEQ : (r - NLAT) % CTXL, gr = t >> 6, gc = t & 63;
        const v4u rq = rq_n, raw = rk_n;
        if (r + NGW < NTOK) { const bf16* pn = P + (size_t)(r + NGW) * DIN; rq_n = *(const GAS v4u*)(pn + CQ + lane * 8); rk_n = *(const GAS v4u*)(pn + CK + (lane & 31) * 8); }
        f32x4 cs4[2], sn4[2];
        { const int pos = ((lane >> 2) & 1) ? gc : gr; const LAS f32x4* pc = (const LAS f32x4*)(tabc + pos * 16 + (lane & 1) * 8); const LAS f32x4* ps = (const LAS f32x4*)(tabs + pos * 16 + (lane & 1) * 8);
          cs4[0] = pc[0]; cs4[1] = pc[1]; sn4[0] = ps[0]; sn4[1] = ps[1]; }
        if (lat || l == 0) {
            float x[8]; unpack8(rq, x);
            head_norm_rope(x, qg, lane, lat, cs4, sn4);
#pragma unroll
            for (int i = 0; i < 8; ++i) x[i] *= C2;
            *(GAS v4u*)(WSP(bf16, WS_Q) + (size_t)r * 512 + lane * 8) = pack8(x);
        }
        {
            float x[8]; unpack8(raw, x);
            head_norm_rope(x, kg, lane, lat, cs4, sn4);
            const size_t krow = (size_t)b * KVLEN + (lat ? t : SEQ + t);
            if (lane < 16) *(GAS v4u*)(WSP(bf16, WS_K) + krow * 128 + lane * 8) = pack8(x);
            else if (lane < 32) *(GAS v4u*)(WSP(bf16, WS_V) + krow * 128 + (lane - 16) * 8) = raw;
        }
    }
    LAS float* tile = (LAS float*)(F.lds + RING_OFF + F.wave * 16640);
    const int nitems = 1024 + (l == 0 ? 64 : 0);
    const float* cw = INP(IN_HCW) + l * 3 * 768; const float* cbias = INP(IN_HCB) + l * 768;
    for (int it = gw; it < nitems; it += NGW) {
        const int type = it >= 1024 ? 1 : 0, ii = type ? it - 1024 : it;
        const int L = type ? CTXL : SEQ, ntb = L / 64;
        const int cb = ii & 3, tb = (ii >> 2) % ntb, b = (ii >> 2) / ntb;
        const int rowbase = type ? NLAT + b * CTXL : b * SEQ, t0 = tb * 64, ch = cb * 64 + lane;
        float w[3][3], bs[3];
#pragma unroll
        for (int g = 0; g < 3; ++g) { bs[g] = cbias[g * 256 + ch];
#pragma unroll
            for (int j = 0; j < 3; ++j) w[j][g] = cw[j * 768 + g * 256 + ch]; }
        float inn[3][18];
#define CONV_LOAD(ck_) do { const int tb0_ = t0 + 16 * (ck_); _Pragma("unroll") for (int g = 0; g < 3; ++g) { const bf16* pg = P + (size_t)(rowbase + tb0_) * DIN + CHY + g * 256 + ch; \
            inn[g][0] = tb0_ > 0 ? bf2f(pg[-(ptrdiff_t)DIN]) : 0.f; _Pragma("unroll") for (int q = 0; q < 16; ++q) inn[g][1 + q] = bf2f(pg[(size_t)q * DIN]); \
            inn[g][17] = (tb0_ + 16 < L) ? bf2f(pg[(size_t)16 * DIN]) : 0.f; } } while (0)
        CONV_LOAD(0);
#pragma unroll 1
        for (int ck = 0; ck < 4; ++ck) { const int tb0 = t0 + 16 * ck; float in[3][18];
#pragma unroll
            for (int g = 0; g < 3; ++g)
#pragma unroll
                for (int q = 0; q < 18; ++q) in[g][q] = inn[g][q];
            if (ck < 3) CONV_LOAD(ck + 1);
#pragma unroll
            for (int q = 0; q < 16; ++q) { float cv[3];
#pragma unroll
                for (int g = 0; g < 3; ++g) cv[g] = in[g][q] * w[0][g] + in[g][q + 1] * w[1][g] + in[g][q + 2] * w[2][g] + bs[g];
                WSP(bf16, WS_X0)[(size_t)(rowbase + tb0 + q) * 256 + ch] = (bf16)f2bf(cv[0]);
                tile[(16 * ck + q) * 65 + lane] = cv[1] * cv[2]; } }
        LDS_WAIT(); asm volatile("" ::: "memory");
        float* zt = type ? WSP(float, WS_ZTC) + ((size_t)b * 256 + cb * 64) * CTXL + t0 : WSP(float, WS_ZT) + ((size_t)b * 256 + cb * 64) * SEQ + t0;
#pragma unroll 8
        for (int i = 0; i < 64; ++i) zt[(size_t)i * L + lane] = tile[lane * 65 + i];
        LDS_WAIT(); asm volatile("" ::: "memory");
    }
}

typedef float f32x16 __attribute__((ext_vector_type(16)));
__device__ __forceinline__ int crow16(int r, int hi) { return (r & 3) + 8 * (r >> 2) + 4 * hi; }
__device__ __forceinline__ void na_wave_unit(Frame& F, const float* rpb_lh, int b, int h, int qr, int half, LAS unsigned char* wl) {
    const int lane = F.lane, r32 = lane & 31, hi = lane >> 5;
    const bf16* P = WSP(bf16, WS_P);
    LAS unsigned short* Vl = (LAS unsigned short*)wl;
    LAS float* tab = (LAS float*)(wl + 9216 + 512);
    LAS float* sc = (LAS float*)(wl + 12800);
    for (int i = lane; i < 465; i += 64) tab[i] = rpb_lh[i] * 1.4426950408889634f;
    const int qc = 32 * half + r32, rsq = min(max(qr - 4, 0), 56), csq = min(max(qc - 8, 0), 48);
    const int qtok = b * SEQ + qr * 64 + 32 * half;
    bf16x8 qf[4];
#pragma unroll
    for (int s = 0; s < 4; ++s) qf[s] = *(const bf16x8*)(P + (size_t)(qtok + r32) * DIN + CNQ + h * 64 + 16 * s + 8 * hi);
    f32x16 o0, o1;
#pragma unroll
    for (int i = 0; i < 16; ++i) { o0[i] = 0.f; o1[i] = 0.f; }
    float mrun = -INFINITY, lsum = 0.f;
    const size_t koff = (size_t)r32 * DIN + CNK + h * 64 + 8 * hi;
    const size_t voff = (size_t)(lane >> 2) * DIN + CNV + h * 64 + (lane & 3) * 8;
    typedef short v4i16_t __attribute__((ext_vector_type(4)));
    const LAS unsigned char* vtrb = (const LAS unsigned char*)Vl + ((lane >> 4) & 1) * 32 + (lane & 3) * 8 + (4 * hi + ((lane & 15) >> 2)) * 64;
    bf16x8 kn[2][4]; v4u vn[8];
    { const bf16* rb = P + (size_t)(NLAT + b * CTXL) * DIN;
#pragma unroll
      for (int kb = 0; kb < 2; ++kb)
#pragma unroll
          for (int s = 0; s < 4; ++s) kn[kb][s] = *(const bf16x8*)(rb + koff + (size_t)kb * 32 * DIN + 16 * s);
#pragma unroll
      for (int i = 0; i < 8; ++i) vn[i] = *(const GAS v4u*)(rb + voff + (size_t)(16 * (i & 3)) * DIN + 32 * (i >> 2)); }
    for (int t = 0; t < 12; ++t) {
        bf16x8 kc[2][4]; v4u vc[8];
#pragma unroll
        for (int kb = 0; kb < 2; ++kb)
#pragma unroll
            for (int s = 0; s < 4; ++s) kc[kb][s] = kn[kb][s];
#pragma unroll
        for (int i = 0; i < 8; ++i) { vc[i] = vn[i]; *(LAS v4u*)((LAS unsigned char*)Vl + i * 1024 + lane * 16) = vc[i]; }
        if (t + 1 < 12) { const int tn = t + 1; const int krow0 = tn < 4 ? NLAT + b * CTXL + 64 * tn : b * SEQ + (rsq + tn - 4) * 64; const bf16* rb = P + (size_t)krow0 * DIN;
#pragma unroll
            for (int kb = 0; kb < 2; ++kb)
#pragma unroll
                for (int s = 0; s < 4; ++s) kn[kb][s] = *(const bf16x8*)(rb + koff + (size_t)kb * 32 * DIN + 16 * s);
#pragma unroll
            for (int i = 0; i < 8; ++i) vn[i] = *(const GAS v4u*)(rb + voff + (size_t)(16 * (i & 3)) * DIN + 32 * (i >> 2)); }
        f32x16 s0, s1;
#pragma unroll
        for (int i = 0; i < 16; ++i) { s0[i] = 0.f; s1[i] = 0.f; }
#pragma unroll
        for (int s = 0; s < 4; ++s) { s0 = __builtin_amdgcn_mfma_f32_32x32x16_bf16(kc[0][s], qf[s], s0, 0, 0, 0); s1 = __builtin_amdgcn_mfma_f32_32x32x16_bf16(kc[1][s], qf[s], s1, 0, 0, 0); }
        if (t >= 4) { const int kr = rsq + t - 4; const LAS float* br = tab + (kr - qr + 7) * 31 + 15 - qc + 4 * hi; const int d0 = 4 * hi - csq;
#pragma unroll
            for (int i = 0; i < 16; ++i) { const int c = (i & 3) + 8 * (i >> 2);
                s0[i] = ((unsigned)(c + d0) < 16u) ? s0[i] + br[c] : -INFINITY;
                s1[i] = ((unsigned)(c + 32 + d0) < 16u) ? s1[i] + br[c + 32] : -INFINITY; } }
        float mx = fmaxf(s0[0], s1[0]);
#pragma unroll
        for (int i = 1; i < 16; ++i) mx = fmaxf(mx, fmaxf(s0[i], s1[i]));
        mx = fmaxf(mx, __shfl_xor(mx, 32));
        if (__any(mx > mrun)) {
            const float mn = fmaxf(mrun, mx), alpha = __builtin_amdgcn_exp2f(mrun - mn); mrun = mn; lsum *= alpha;
            if (hi == 0) sc[r32] = alpha;
#pragma unroll
            for (int i = 0; i < 16; ++i) { const float a = sc[crow16(i, hi)]; o0[i] *= a; o1[i] *= a; } }
        float psum = 0.f;
#pragma unroll
        for (int i = 0; i < 16; ++i) { s0[i] = __builtin_amdgcn_exp2f(s0[i] - mrun); s1[i] = __builtin_amdgcn_exp2f(s1[i] - mrun); psum += s0[i] + s1[i]; }
        lsum += psum;
#pragma unroll
        for (int ks = 0; ks < 4; ++ks) {
            v4u pw;
            if (ks == 0) { pw.x = pg8::cvt_pk_bf16(s0[0], s0[1]); pw.y = pg8::cvt_pk_bf16(s0[2], s0[3]); pw.z = pg8::cvt_pk_bf16(s0[4], s0[5]); pw.w = pg8::cvt_pk_bf16(s0[6], s0[7]); }
            else if (ks == 1) { pw.x = pg8::cvt_pk_bf16(s0[8], s0[9]); pw.y = pg8::cvt_pk_bf16(s0[10], s0[11]); pw.z = pg8::cvt_pk_bf16(s0[12], s0[13]); pw.w = pg8::cvt_pk_bf16(s0[14], s0[15]); }
            else if (ks == 2) { pw.x = pg8::cvt_pk_bf16(s1[0], s1[1]); pw.y = pg8::cvt_pk_bf16(s1[2], s1[3]); pw.z = pg8::cvt_pk_bf16(s1[4], s1[5]); pw.w = pg8::cvt_pk_bf16(s1[6], s1[7]); }
            else { pw.x = pg8::cvt_pk_bf16(s1[8], s1[9]); pw.y = pg8::cvt_pk_bf16(s1[10], s1[11]); pw.z = pg8::cvt_pk_bf16(s1[12], s1[13]); pw.w = pg8::cvt_pk_bf16(s1[14], s1[15]); }
            const bf16x8 pf = __builtin_bit_cast(bf16x8, pw);
#pragma unroll
            for (int dh = 0; dh < 2; ++dh) { const LAS unsigned char* vp = vtrb + dh * 4096 + ks * 1024;
                const v4i16_t lo = __builtin_amdgcn_ds_read_tr16_b64_v4i16((LAS v4i16_t*)vp), hv_ = __builtin_amdgcn_ds_read_tr16_b64_v4i16((LAS v4i16_t*)(vp + 512));
                const bf16x8 vf = {lo[0], lo[1], lo[2], lo[3], hv_[0], hv_[1], hv_[2], hv_[3]};
                if (dh == 0) o0 = __builtin_amdgcn_mfma_f32_32x32x16_bf16(pf, vf, o0, 0, 0, 0); else o1 = __builtin_amdgcn_mfma_f32_32x32x16_bf16(pf, vf, o1, 0, 0, 0); }
        }
    }
    lsum += __shfl_xor(lsum, 32);
    if (hi == 0) sc[32 + r32] = lsum;
    LAS unsigned short* stg = Vl;
#pragma unroll
    for (int i = 0; i < 16; ++i) { const int q = crow16(i, hi); const float rl = 1.0f / sc[32 + q];
        stg[q * 64 + r32] = (unsigned short)f2bf(o0[i] * rl); stg[q * 64 + 32 + r32] = (unsigned short)f2bf(o1[i] * rl); }
    bf16* Ow = WSP(bf16, WS_YMIX) + (size_t)qtok * DM + 768 + h * 64;
#pragma unroll
    for (int i = 0; i < 4; ++i) { const int row = i * 8 + (lane >> 3), ch = lane & 7; const v4u v = *(const LAS v4u*)(stg + row * 64 + ch * 8); *(GAS v4u*)(Ow + (size_t)row * DM + ch * 8) = v; }
}

constexpr int HY_OFF = 4099, HY_GN = 8196;
__device__ __forceinline__ void hy_item(Frame& F, const float* hd_l, int l, int type, int b, int c) {
    const int tid = F.tid, L = type ? CTXL : SEQ;
    LAS float* G = (LAS float*)(F.lds + RING_OFF); LAS float* Z = G + 8208; LAS float* red = Z + 4096;
    const float* hf = type ? WSP(float, WS_FILTC) + ((size_t)(l * 2 + 0) * 256 + c) * CTXL : WSP(float, WS_FILT) + ((size_t)(l * 2 + 0) * 256 + c) * SEQ;
    const float* hb = type ? WSP(float, WS_FILTC) + ((size_t)(l * 2 + 1) * 256 + c) * CTXL : WSP(float, WS_FILT) + ((size_t)(l * 2 + 1) * 256 + c) * SEQ;
    const float* zt = type ? WSP(float, WS_ZTC) + ((size_t)b * 256 + c) * CTXL : WSP(float, WS_ZT) + ((size_t)b * 256 + c) * SEQ;
    float ssq = 0.f;
    for (int idx = tid; idx < HY_GN; idx += 512) { const int lag = idx - HY_OFF; float v = 0.f;
        if (lag >= 0 && lag < L) v = hf[lag]; else if (lag < 0 && -lag < L) v = hb[-lag];
        G[idx] = v; ssq += v * v; }
    for (int idx = tid; idx < L; idx += 512) Z[idx] = zt[idx];
    ssq = wave_sum(ssq); if (F.lane == 0) red[F.wave] = ssq;
    __syncthreads();
    float tot = 0.f;
#pragma unroll
    for (int i = 0; i < 8; ++i) tot += red[i];
    const float nscale = 1.f / sqrtf(tot + LN_EPS);
    if (tid * 8 < L) {
        const int t0 = tid * 8; float acc[8], w[16];
#pragma unroll
        for (int i = 0; i < 8; ++i) acc[i] = 0.f;
#pragma unroll
        for (int m = 8; m < 15; ++m) w[m] = G[HY_OFF + t0 - 7 + m];
        for (int s0 = 0; s0 < L; s0 += 8) {
            const f32x4 g0 = *(const LAS f32x4*)(G + HY_OFF + t0 - s0 - 7), g1 = *(const LAS f32x4*)(G + HY_OFF + t0 - s0 - 3);
            w[0] = g0.x; w[1] = g0.y; w[2] = g0.z; w[3] = g0.w; w[4] = g1.x; w[5] = g1.y; w[6] = g1.z; w[7] = g1.w;
            const f32x4 z0 = *(const LAS f32x4*)(Z + s0), z1 = *(const LAS f32x4*)(Z + s0 + 4);
            const float zz[8] = {z0.x, z0.y, z0.z, z0.w, z1.x, z1.y, z1.z, z1.w};
#pragma unroll
            for (int i = 0; i < 8; ++i)
#pragma unroll
                for (int j = 0; j < 8; ++j) acc[i] += w[i - j + 7] * zz[j];
#pragma unroll
            for (int m = 14; m >= 8; --m) w[m] = w[m - 8];
        }
        const float dsk = hd_l[c]; const int rowbase = type ? NLAT + b * CTXL : b * SEQ;
#pragma unroll
        for (int i = 0; i < 8; ++i) { const int t = t0 + i; const float y = acc[i] * nscale + Z[t] * dsk;
            const float x0 = bf2f(WSP(bf16, WS_X0)[(size_t)(rowbase + t) * 256 + c]);
            WSP(bf16, WS_YMIX)[(size_t)(rowbase + t) * DM + 512 + c] = (bf16)f2bf(y * x0); }
    }
    __syncthreads();
}

__device__ __forceinline__ void hy_ctx_item(Frame& F, const float* hd_l, int l, int c) {
    const int tid = F.tid; constexpr int L = CTXL;
    LAS float* G = (LAS float*)(F.lds + RING_OFF); LAS float* Z = G + 8208; LAS float* red = Z + 4096;
    const float* hf = WSP(float, WS_FILTC) + ((size_t)(l * 2 + 0) * 256 + c) * CTXL; const float* hb = WSP(float, WS_FILTC) + ((size_t)(l * 2 + 1) * 256 + c) * CTXL;
    float ssq = 0.f;
    for (int idx = HY_OFF - 272 + tid; idx < HY_OFF + 272; idx += 512) { const int lag = idx - HY_OFF; float v = 0.f;
        if (lag >= 0 && lag < L) v = hf[lag]; else if (lag < 0 && -lag < L) v = hb[-lag];
        G[idx] = v; ssq += v * v; }
    for (int idx = tid; idx < 4 * L; idx += 512) Z[idx] = (WSP(float, WS_ZTC) + ((size_t)(idx >> 8) * 256 + c) * CTXL)[idx & 255];
    ssq = wave_sum(ssq); if (F.lane == 0) red[F.wave] = ssq;
    __syncthreads();
    float tot = 0.f;
#pragma unroll
    for (int i = 0; i < 8; ++i) tot += red[i];
    const float nscale = 1.f / sqrtf(tot + LN_EPS);
    if (tid < 128) {
        const int b = tid >> 5, t0 = (tid & 31) * 8; const LAS float* Zb = Z + b * L; float acc[8], w[16];
#pragma unroll
        for (int i = 0; i < 8; ++i) acc[i] = 0.f;
#pragma unroll
        for (int m = 8; m < 15; ++m) w[m] = G[HY_OFF + t0 - 7 + m];
        for (int s0 = 0; s0 < L; s0 += 8) {
            const f32x4 g0 = *(const LAS f32x4*)(G + HY_OFF + t0 - s0 - 7), g1 = *(const LAS f32x4*)(G + HY_OFF + t0 - s0 - 3);
            w[0] = g0.x; w[1] = g0.y; w[2] = g0.z; w[3] = g0.w; w[4] = g1.x; w[5] = g1.y; w[6] = g1.z; w[7] = g1.w;
            const f32x4 z0 = *(const LAS f32x4*)(Zb + s0), z1 = *(const LAS f32x4*)(Zb + s0 + 4);
            const float zz[8] = {z0.x, z0.y, z0.z, z0.w, z1.x, z1.y, z1.z, z1.w};
#pragma unroll
            for (int i = 0; i < 8; ++i)
#pragma unroll
                for (int j = 0; j < 8; ++j) acc[i] += w[i - j + 7] * zz[j];
#pragma unroll
            for (int m = 14; m >= 8; --m) w[m] = w[m - 8];
        }
        const float dsk = hd_l[c]; const int rowbase = NLAT + b * CTXL;
#pragma unroll
        for (int i = 0; i < 8; ++i) { const int t = t0 + i; const float y = acc[i] * nscale + Zb[t] * dsk;
            const float x0 = bf2f(WSP(bf16, WS_X0)[(size_t)(rowbase + t) * 256 + c]);
            WSP(bf16, WS_YMIX)[(size_t)(rowbase + t) * DM + 512 + c] = (bf16)f2bf(y * x0); }
    }
    __syncthreads();
}
#define FFT_SYNC() __syncthreads()
template <int SGN> __device__ __forceinline__ void fft_mid_passes(int tid, cpx (&u)[16], LAS cpx* buf) {
    int t1 = tid; asm volatile("" : "+v"(t1)); FFT_SYNC(); fft_p8_load<SGN, 16>(t1, u, buf); FFT_SYNC(); fft_p8_store<16>(t1, u, buf);
    int t2 = tid; asm volatile("" : "+v"(t2)); FFT_SYNC(); fft_p8_load<SGN, 128>(t2, u, buf); FFT_SYNC(); fft_p8_store<128>(t2, u, buf);
    int t3 = tid; asm volatile("" : "+v"(t3)); FFT_SYNC(); fft_p8_load<SGN, 1024>(t3, u, buf);
}
__device__ __forceinline__ void hy_spectrum_item(Frame& F, int l, int c) {
    const int tid = F.tid; LAS cpx* buf = (LAS cpx*)(F.lds + RING_OFF); LAS float* red = (LAS float*)(F.lds + RING_OFF + FFT_BUF_ELEMS * 8);
    const float* hf = WSP(float, WS_FILT) + ((size_t)(l * 2 + 0) * 256 + c) * SEQ; const float* hb = WSP(float, WS_FILT) + ((size_t)(l * 2 + 1) * 256 + c) * SEQ;
    cpx u[16]; float ssq = 0.f;
#pragma unroll
    for (int r = 0; r < 16; ++r) { const int n = tid + 512 * r; float g;
        if (r < 8) g = sgpr_ptr(hf + 512 * r)[tid]; else g = (n == SEQ) ? 0.f : sgpr_ptr(hb + 2 * SEQ - 512 * r)[-tid];
        u[r] = cpx{g, 0.f}; ssq += g * g; }
    ssq = wave_sum(ssq); if (F.lane == 0) red[F.wave] = ssq;
    fft_p1_store<-1>(tid, u, buf);
    fft_mid_passes<-1>(tid, u, buf);
    float tot = 0.f;
#pragma unroll
    for (int i = 0; i < 8; ++i) tot += red[i];
    const float sc = (1.f / sqrtf(tot + LN_EPS)) * (1.f / (float)FFT_N);
    cpx* gf = WSP(cpx, WS_GF) + (size_t)(l * 256 + c) * FFT_N;
#pragma unroll
    for (int hlf = 0; hlf < 2; ++hlf)
#pragma unroll
        for (int r = 0; r < 8; ++r) sgpr_ptr(gf + 512 * hlf + 1024 * r)[tid] = cpx{u[8 * hlf + r].x * sc, u[8 * hlf + r].y * sc};
    FFT_SYNC();
}
__device__ __forceinline__ void hy_fft_item(Frame& F, const float* hd_l, int l, int c, int bp) {
    const int tid = F.tid; LAS cpx* buf = (LAS cpx*)(F.lds + RING_OFF);
    const float* z0 = WSP(float, WS_ZT) + ((size_t)(2 * bp) * 256 + c) * SEQ; const float* z1 = z0 + (size_t)256 * SEQ;
    cpx zin[8], u[16];
#pragma unroll
    for (int m8 = 0; m8 < 8; ++m8) { zin[m8] = cpx{sgpr_ptr(z0 + 512 * m8)[tid], sgpr_ptr(z1 + 512 * m8)[tid]}; u[m8] = zin[m8]; u[8 + m8] = cpx{0.f, 0.f}; }
    fft_p1_store<-1>(tid, u, buf);
    fft_mid_passes<-1>(tid, u, buf);
    const cpx* gf = WSP(cpx, WS_GF) + (size_t)(l * 256 + c) * FFT_N;
#pragma unroll
    for (int hlf = 0; hlf < 2; ++hlf)
#pragma unroll
        for (int r = 0; r < 8; ++r) u[8 * hlf + r] = cmul(u[8 * hlf + r], sgpr_ptr(gf + 512 * hlf + 1024 * r)[tid]);
    cpx v[16]; fft_regs_to_p1(u, v);
    FFT_SYNC();
    fft_p1_store<1>(tid, v, buf);
    fft_mid_passes<1>(tid, v, buf);
    const float dsk = hd_l[c];
    float* y0 = WSP(float, WS_YC) + ((size_t)(2 * bp) * 256 + c) * SEQ; float* y1 = y0 + (size_t)256 * SEQ;
#pragma unroll
    for (int hlf = 0; hlf < 2; ++hlf)
#pragma unroll
        for (int r = 0; r < 4; ++r) { const int m8 = hlf + 2 * r; sgpr_ptr(y0 + 512 * m8)[tid] = v[8 * hlf + r].x + zin[m8].x * dsk; sgpr_ptr(y1 + 512 * m8)[tid] = v[8 * hlf + r].y + zin[m8].y * dsk; }
    FFT_SYNC();
}
__device__ __forceinline__ void ph_hy_post(Frame& F) {
    const int gw = F.vcu * NWAVES + F.wave, NGW = F.G * NWAVES, lane = F.lane;
    LAS float* tile = (LAS float*)(F.lds + RING_OFF + F.wave * 16640);
    for (int it = gw; it < 1024; it += NGW) {
        const int cb = it & 3, tb = (it >> 2) & 63, b = it >> 8, t0 = tb * 64, c0 = cb * 64;
        const float* yc = WSP(float, WS_YC) + ((size_t)b * 256 + c0) * SEQ + t0;
#pragma unroll 1
        for (int ck = 0; ck < 4; ++ck) { float tv[16];
#pragma unroll
            for (int i = 0; i < 16; ++i) tv[i] = yc[(size_t)(16 * ck + i) * SEQ + lane];
#pragma unroll
            for (int i = 0; i < 16; ++i) tile[(16 * ck + i) * 65 + lane] = tv[i]; }
        LDS_WAIT(); asm volatile("" ::: "memory");
        const bf16* x0 = WSP(bf16, WS_X0) + (size_t)(b * SEQ + t0) * 256 + c0 + lane; bf16* ym = WSP(bf16, WS_YMIX) + (size_t)(b * SEQ + t0) * DM + 512 + c0 + lane;
#pragma unroll 1
        for (int ck = 0; ck < 4; ++ck) { float xv[16];
#pragma unroll
            for (int q = 0; q < 16; ++q) xv[q] = bf2f(x0[(size_t)(16 * ck + q) * 256]);
#pragma unroll
            for (int q = 0; q < 16; ++q) ym[(size_t)(16 * ck + q) * DM] = (bf16)f2bf(tile[lane * 65 + 16 * ck + q] * xv[q]); }
        LDS_WAIT(); asm volatile("" ::: "memory");
    }
}

__device__ __forceinline__ void ph_mixers(Frame& F, int l, char* lds_generic) {
    {
        typedef attn_body::bf16 abf;
        const abf* Qb = (const abf*)WSP(bf16, WS_Q); const abf* Kb = (const abf*)WSP(bf16, WS_K); const abf* Vb = (const abf*)WSP(bf16, WS_V);
        const abf* Pb = (const abf*)WSP(bf16, WS_P); abf* Ym = (abf*)WSP(bf16, WS_YMIX);
        const int nunits = 512 + (l == 0 ? 48 : 0);
        REPS(20) for (int u = F.vcu; u < nunits; u += F.G) {
            const abf *Qu, *Kh, *Vh; abf* Ou; int QP, KP, NT;
            if (u < 512) { const int bk = u >> 6, b = bk >> 1, kvh = bk & 1, hq = (u >> 4) & 3, qb = u & 15, head = kvh * 4 + hq;
                Qu = Qb + (size_t)(b * SEQ + qb * 256) * 512 + head * 64; Kh = Kb + (size_t)b * KVLEN * 128 + kvh * 64; Vh = Vb + (size_t)b * KVLEN * 128 + kvh * 64;
                Ou = Ym + (size_t)(b * SEQ + qb * 256) * DM + head * 64; QP = 512; KP = 128; NT = KVLEN / 64; }
            else if (u < 544) { const int j = u - 512, b = j >> 3, head = j & 7, kvh = head >> 2;
                Qu = Qb + (size_t)(NLAT + b * CTXL) * 512 + head * 64; Kh = Kb + ((size_t)b * KVLEN + SEQ) * 128 + kvh * 64; Vh = Vb + ((size_t)b * KVLEN + SEQ) * 128 + kvh * 64;
                Ou = Ym + (size_t)(NLAT + b * CTXL) * DM + head * 64; QP = 512; KP = 128; NT = 4; }
            else { const int j = u - 544, b = j >> 2, h = j & 3;
                Qu = Pb + (size_t)(NLAT + b * CTXL) * DIN + CNQ + h * 64; Kh = Pb + (size_t)(NLAT + b * CTXL) * DIN + CNK + h * 64; Vh = Pb + (size_t)(NLAT + b * CTXL) * DIN + CNV + h * 64;
                Ou = Ym + (size_t)(NLAT + b * CTXL) * DM + 768 + h * 64; QP = DIN; KP = DIN; NT = 4; }
            attn_body::attn_unit<8>(Qu, Kh, Vh, Ou, QP, KP, DM, NT, lds_generic, F.tid);
        }
    }
    __syncthreads();
    { Frame Fn = F; asm volatile("" : "+s"(Fn.ws), "+v"(Fn.tid), "+v"(Fn.lane), "+s"(Fn.wave));
      const int gw = Fn.vcu * NWAVES + Fn.wave, NGW = Fn.G * NWAVES;
      const float* rpb_l = INP(IN_RPB) + (size_t)l * 4 * 15 * 31;
      REPS(21) for (int w = gw; w < 2048; w += NGW) { const int h = (w >> 7) & 3; na_wave_unit(Fn, rpb_l + h * 15 * 31, w >> 9, h, (w >> 1) & 63, w & 1, Fn.lds + RING_OFF + Fn.wave * 16384); } }
    __syncthreads();
    { Frame Fh = F; asm volatile("" : "+s"(Fh.ws), "+v"(Fh.tid), "+v"(Fh.lane), "+s"(Fh.wave));
      const float* hd_l = INP(IN_HD) + l * 256;
      REPS(22) { for (int it = Fh.vcu; it < 512; it += Fh.G) hy_fft_item(Fh, hd_l, l, it >> 1, it & 1);
        if (l == 0) for (int it = Fh.vcu; it < 256; it += Fh.G) hy_ctx_item(Fh, hd_l, l, it); } }
}

__device__ __forceinline__ void ph_r1(Frame& F, int l) {
    const int tid = F.tid, lane = F.lane;
    LAS float* rwT = (LAS float*)(F.lds + RING_OFF);
    volatile LAS unsigned* cntL = F.MISC + 16;
    { const float* rw = INP(IN_RW) + (size_t)l * DM * NEXP;
      for (int i = tid; i < DM * NEXP / 4; i += 512) { const f32x4 v = ((const f32x4*)rw)[i]; const int k = i >> 3, e4 = (i & 7) * 4;
          rwT[(e4 + 0) * DM + k] = v.x; rwT[(e4 + 1) * DM + k] = v.y; rwT[(e4 + 2) * DM + k] = v.z; rwT[(e4 + 3) * DM + k] = v.w; } }
    LAS float* lnl = rwT + DM * NEXP;
    { const float* ln1g = INP(IN_LN1G) + l * DM; const float* ln1b = INP(IN_LN1B) + l * DM; for (int i = tid; i < DM; i += 512) { lnl[i] = ln1g[i]; lnl[DM + i] = ln1b[i]; } }
    if (tid < 32) cntL[tid] = 0u;
    __syncthreads();
    const int gw = F.vcu * NWAVES + F.wave, NGW = F.G * NWAVES, nrows = l == 0 ? NTOK : NLAT;
    const float* rb = INP(IN_RB) + l * NEXP; const float* xin = INP(IN_X); const float* cin = INP(IN_CTX);
    int* topi = WSP(int, WS_ROUTE) + RT_TOPI; float* gate = WSP(float, WS_ROUTE) + RT_GATE; int* slotpos = WSP(int, WS_ROUTE) + RT_SLOTPOS;
    const int myq = lane >> 5, mye = lane & 31; const float mybias = rb[mye];
    for (int rA = gw; rA < nrows; rA += 2 * NGW) {
        f32x4 hv[2][4];
        { f32x4 v[2][4];
#pragma unroll
          for (int q = 0; q < 2; ++q) { const int r0 = rA + q * NGW, r = r0 < nrows ? r0 : rA; const int bsel = r < NLAT ? r / SEQ : 4;
              const float* xsrc = l == 0 ? (r < NLAT ? xin + (size_t)r * DM : cin + (size_t)(r - NLAT) * DM) : WSP(float, WS_X) + (size_t)r * DM;
              const bf16* yrow = WSP(bf16, WS_Y) + (size_t)r * DM; const float* g1 = modp(F, l, bsel, 2);
#pragma unroll
              for (int j = 0; j < 4; ++j) { const f32x4 xv = ((const f32x4*)xsrc)[lane + 64 * j]; const f32x4 gv = ((const f32x4*)g1)[lane + 64 * j];
                  const unsigned long long yw = ((const GAS unsigned long long*)yrow)[lane + 64 * j];
                  const f32x4 yv = {bflo((unsigned)yw), bfhi((unsigned)yw), bflo((unsigned)(yw >> 32)), bfhi((unsigned)(yw >> 32))};
                  v[q][j] = xv * DN_ALPHA + gv * yv; }
              }
#pragma unroll
          for (int q = 0; q < 2; ++q) { const int r = rA + q * NGW;
              if (r < nrows) { float mean, rstd; row_stats(v[q], mean, rstd);
                  float* xdst = WSP(float, WS_X1) + (size_t)r * DM;
#pragma unroll
                  for (int j = 0; j < 4; ++j) { const f32x4 gg = ((const LAS f32x4*)lnl)[lane + 64 * j], bb = ((const LAS f32x4*)(lnl + DM))[lane + 64 * j];
                      v[q][j] = (v[q][j] - mean) * rstd * gg + bb; ((f32x4*)xdst)[lane + 64 * j] = v[q][j]; }
                  { const int bsel = r < NLAT ? r / SEQ : 4; f32x4 sh[4], sc[4]; ldvec(modp(F, l, bsel, 3), lane, sh); ldvec(modp(F, l, bsel, 4), lane, sc);
                    modulate_store8(F, v[q], sh, sc, WSP(unsigned char, WS_H8) + (size_t)r * DM, hv[q]); } }
              else {
#pragma unroll
                  for (int j = 0; j < 4; ++j) hv[q][j] = (f32x4){0.f, 0.f, 0.f, 0.f}; } } }
        typedef float f32x2r __attribute__((ext_vector_type(2)));
        unsigned rbase0 = (unsigned)(uintptr_t)rwT + 16u * (unsigned)lane, rbase1 = rbase0 + 65536u; asm volatile("" : "+v"(rbase0), "+v"(rbase1));
        float pv[64];
#pragma unroll
        for (int e = 0; e < 32; ++e) { f32x2r a0 = {0.f, 0.f}, a1 = {0.f, 0.f};
#pragma unroll
            for (int j = 0; j < 4; ++j) { const f32x4 w4 = *(const LAS f32x4*)(uintptr_t)((e < 16 ? rbase0 : rbase1) + (unsigned)((e & 15) * 4096 + 1024 * j));
                const f32x2r wl = {w4.x, w4.y}, wh = {w4.z, w4.w};
                a0 += (f32x2r){hv[0][j].x, hv[0][j].y} * wl; a0 += (f32x2r){hv[0][j].z, hv[0][j].w} * wh;
                a1 += (f32x2r){hv[1][j].x, hv[1][j].y} * wl; a1 += (f32x2r){hv[1][j].z, hv[1][j].w} * wh; }
            pv[e] = a0.x + a0.y; pv[32 + e] = a1.x + a1.y;
            if ((e & 3) == 3) asm volatile("" ::: "memory"); }
        const float mylg = rs64(pv, lane) + mybias;
        { const int fb = __float_as_int(mylg); int key = ((fb ^ ((fb >> 31) & 0x7fffffff)) & ~31) | (31 - mye);
          int te[2][4];
#pragma unroll
          for (int k = 0; k < 4; ++k) { int mk = key;
              mk = max(mk, __builtin_amdgcn_update_dpp(0, mk, 0xB1, 0xF, 0xF, true)); mk = max(mk, __builtin_amdgcn_update_dpp(0, mk, 0x4E, 0xF, 0xF, true));
              mk = max(mk, __builtin_amdgcn_update_dpp(0, mk, 0x141, 0xF, 0xF, true)); mk = max(mk, __builtin_amdgcn_update_dpp(0, mk, 0x140, 0xF, 0xF, true));
              const int mA = max(__builtin_amdgcn_readlane(mk, 0), __builtin_amdgcn_readlane(mk, 16)), mB = max(__builtin_amdgcn_readlane(mk, 32), __builtin_amdgcn_readlane(mk, 48));
              te[0][k] = 31 - (mA & 31); te[1][k] = 31 - (mB & 31);
              if (key == (myq ? mB : mA)) key = (int)0x80000000; }
#pragma unroll
          for (int q = 0; q < 2; ++q) { const int r = rA + q * NGW;
              if (r < nrows) { const int mli = __float_as_int(mylg);
                  const float t0 = __int_as_float(__builtin_amdgcn_readlane(mli, 32 * q + te[q][0])), t1 = __int_as_float(__builtin_amdgcn_readlane(mli, 32 * q + te[q][1]));
                  const float t2 = __int_as_float(__builtin_amdgcn_readlane(mli, 32 * q + te[q][2])), t3 = __int_as_float(__builtin_amdgcn_readlane(mli, 32 * q + te[q][3]));
                  const float e1 = __expf(t1 - t0), e2 = __expf(t2 - t0), e3 = __expf(t3 - t0); const float inv = 1.f / (1.f + e1 + e2 + e3);
                  if (lane < 4) { const int e = lane == 0 ? te[q][0] : lane == 1 ? te[q][1] : lane == 2 ? te[q][2] : te[q][3];
                      const float wg = (lane == 0 ? 1.f : lane == 1 ? e1 : lane == 2 ? e2 : e3) * inv;
                      const unsigned lp = __hip_atomic_fetch_add((LAS unsigned*)(cntL + e), 1u, __ATOMIC_RELAXED, __HIP_MEMORY_SCOPE_WORKGROUP);
                      topi[r * 4 + lane] = e; gate[r * 4 + lane] = wg; slotpos[r * 4 + lane] = (int)lp; } } } }
    }
    __syncthreads();
    if (tid < 32) (WSP(int, WS_ROUTE) + RT_CNT)[F.vcu * 32 + tid] = (int)cntL[tid];
}

__device__ __forceinline__ void ph_gather(Frame& F, int l) {
    const int tid = F.tid, lane = F.lane;
    volatile LAS int* sm = (volatile LAS int*)(F.lds + RING_OFF);
    const int* cnt = WSP(int, WS_ROUTE) + RT_CNT;
    { const int e = tid & 31, g = tid >> 5, per = (F.G + 15) / 16; int st = 0, sp = 0;
      for (int bb = 0; bb < per; ++bb) { const int blk = g * per + bb; if (blk < F.G) { const int v = cnt[blk * 32 + e]; st += v; if (blk < F.vcu) sp += v; } }
      sm[g * 32 + e] = st; sm[512 + g * 32 + e] = sp; }
    __syncthreads();
    if (tid < 32) { int tot = 0, pre = 0;
        for (int g = 0; g < 16; ++g) { tot += sm[g * 32 + tid]; pre += sm[512 + g * 32 + tid]; }
        sm[1024 + tid] = tot; sm[1056 + tid] = pre; }
    __syncthreads();
    if (tid == 0) { int base = 0; for (int e = 0; e < 32; ++e) { sm[1088 + e] = base; base += ((sm[1024 + e] + 255) / 256) * 256; } sm[1120] = base / 256; }
    __syncthreads();
    int* TT = WSP(int, WS_ROUTE) + RT_TT; int* rowslot = WSP(int, WS_ROUTE) + RT_ROWSLOT;
    if (F.vcu == 0) {
        if (tid == 0) TT[0] = sm[1120];
        for (int e = 0; e < 32; ++e) { const int tot = sm[1024 + e], base = sm[1088 + e], nte = (tot + 255) / 256;
            for (int i = tid; i < nte; i += 512) TT[1 + base / 256 + i] = e;
            for (int p = tot + tid; p < nte * 256; p += 512) rowslot[base + p] = -1; }
    }
    const int NGW = F.G * NWAVES, nrows = l == 0 ? NTOK : NLAT;
    const int* topi = WSP(int, WS_ROUTE) + RT_TOPI; const int* slotpos = WSP(int, WS_ROUTE) + RT_SLOTPOS;
    for (int s = tid; s < ((nrows + NGW - 1) / NGW) * 32; s += 512) { const int k = s & 3, w = (s >> 2) & 7, i = s >> 5, r = F.vcu * NWAVES + w + i * NGW;
        if (r < nrows) { const int e = topi[r * 4 + k], lp = slotpos[r * 4 + k]; rowslot[sm[1088 + e] + sm[1056 + e] + lp] = r * 4 + k; }
    }
}

namespace pg8 {
struct EpiBf16S {
    static constexpr bool PERM = true, AFTER_DRAIN = false;
    bf16_t* O; int ldc; int stile; float sval;
    __device__ __forceinline__ void operator()(const f32x4 (&acc)[2][2][4][2], const Unit& u, int wr, int wc, int fr, int fq) const {
        const int row0 = u.pm * BM + wr * 64 + fr, col0 = u.pn * BM + wc * 32 + 8 * fq; const float sc = (u.pn == stile) ? sval : 1.f;
#pragma unroll
        for (int ai = 0; ai < 2; ++ai)
#pragma unroll
            for (int m = 0; m < 4; ++m) { bf16_t* rowp = O + (size_t)(row0 + ai * HALF + m * 16) * ldc + col0;
#pragma unroll
                for (int bj = 0; bj < 2; ++bj) { const f32x4 v0 = acc[ai][bj][m][0] * sc, v1 = acc[ai][bj][m][1] * sc;
                    u32x4 w; w.x = cvt_pk_bf16(v0[0], v0[1]); w.y = cvt_pk_bf16(v0[2], v0[3]); w.z = cvt_pk_bf16(v1[0], v1[1]); w.w = cvt_pk_bf16(v1[2], v1[3]);
                    *(u32x4*)(rowp + bj * HALF) = w; } }
    }
};
}
namespace pg8 {
struct EpiI8S {
    static constexpr bool PERM = true, AFTER_DRAIN = false;
    bf16_t* O; int ldc; int stile; float sval; const float* srow; const int* cmaxbits;
    __device__ __forceinline__ void operator()(const f32x4 (&acc)[2][2][4][2], const Unit& u, int wr, int wc, int fr, int fq) const {
        const int row0 = u.pm * BM + wr * 64 + fr, col0 = u.pn * BM + wc * 32 + 8 * fq; const float sc = ((u.pn == stile) ? sval : 1.f) * (1.f / 127.f);
        f32x4 cs[2][2];
#pragma unroll
        for (int bj = 0; bj < 2; ++bj)
#pragma unroll
            for (int n = 0; n < 2; ++n) { const int* cb = cmaxbits + col0 + bj * HALF + 4 * n; cs[bj][n] = (f32x4){__int_as_float(cb[0]), __int_as_float(cb[1]), __int_as_float(cb[2]), __int_as_float(cb[3])} * sc; }
#pragma unroll
        for (int ai = 0; ai < 2; ++ai)
#pragma unroll
            for (int m = 0; m < 4; ++m) { const int row = row0 + ai * HALF + m * 16; const float rs = srow[row]; bf16_t* rowp = O + (size_t)row * ldc + col0;
#pragma unroll
                for (int bj = 0; bj < 2; ++bj) { const f32x4 v0 = acc[ai][bj][m][0] * cs[bj][0] * rs, v1 = acc[ai][bj][m][1] * cs[bj][1] * rs;
                    u32x4 w; w.x = cvt_pk_bf16(v0[0], v0[1]); w.y = cvt_pk_bf16(v0[2], v0[3]); w.z = cvt_pk_bf16(v1[0], v1[1]); w.w = cvt_pk_bf16(v1[2], v1[3]);
                    *(u32x4*)(rowp + bj * HALF) = w; } }
    }
};
}
namespace pg8 {
struct GroupedOrder {
    const PG8_LAS int* TT; int nN, G, c;
    __device__ __forceinline__ bool tile_of(int i, int& rt, int& pn) const {
        const int T = __builtin_amdgcn_readfirstlane(TT[0]);
        if ((G & 7) == 0) { const int x = c & 7, j = c >> 3, W = G >> 3, lo = (x * T) >> 3, hi = ((x + 1) * T) >> 3, uu = i * W + j;
            if (uu >= (hi - lo) * nN) return false; rt = lo + uu / nN; pn = uu % nN; }
        else { const long L = (long)i * G + c; if (L >= (long)T * nN) return false; rt = (int)(L / nN); pn = (int)(L % nN); }
        return true;
    }
    __device__ __forceinline__ bool next(int i, Unit& u) const {
        int rt, pn; if (!tile_of(i, rt, pn)) return false;
        const int e = __builtin_amdgcn_readfirstlane(TT[1 + rt]);
        u.pm = rt; u.pn = pn; u.pe = e; u.pb = e * nN + pn; return true;
    }
    __device__ __forceinline__ void a_ready(const Unit&) const {}
    __device__ __forceinline__ void done(const Unit&) const {}
};
struct EpiSwiGLU {
    static constexpr bool PERM = true, AFTER_DRAIN = false;
    unsigned char* O; const float* b1;
    __device__ __forceinline__ void operator()(const f32x4 (&acc)[2][2][4][2], const Unit& u, int wr, int wc, int fr, int fq) const {
        const int row0 = u.pm * BM + wr * 64 + fr, cc0 = u.pn * 128 + wc * 32 + 8 * fq;
        const float* bg = b1 + (size_t)u.pe * 2048 + cc0; const float* bl = bg + 1024;
        f32x4 vg[2], vl[2];
#pragma unroll
        for (int n = 0; n < 2; ++n) { vg[n] = *(const f32x4*)(bg + 4 * n); vl[n] = *(const f32x4*)(bl + 4 * n); }
#pragma unroll
        for (int ai = 0; ai < 2; ++ai)
#pragma unroll
            for (int m = 0; m < 4; ++m) { unsigned char* rowp = O + (size_t)(row0 + ai * HALF + m * 16) * 1024 + cc0; float o[8];
#pragma unroll
                for (int n = 0; n < 2; ++n) { const f32x4 g = acc[ai][0][m][n] * (1.0f / W1_SCALE) + vg[n], li = acc[ai][1][m][n] * (1.0f / W1_SCALE) + vl[n];
#pragma unroll
                    for (int j = 0; j < 4; ++j) { const float gg = fminf(g[j], 7.0f), ll = fminf(fmaxf(li[j], -7.0f), 7.0f);
                        o[n * 4 + j] = gg * (1.0f / (1.0f + __expf(-1.702f * gg))) * (ll + 1.0f); } }
                *(unsigned long long*)rowp = (unsigned long long)pk4_fp8(o[0], o[1], o[2], o[3]) | ((unsigned long long)pk4_fp8(o[4], o[5], o[6], o[7]) << 32); }
    }
};
struct EpiMoeOut {
    static constexpr bool PERM = true, AFTER_DRAIN = false;
    unsigned char* O; const float* b2; const float* gate; const int* rowslot;
    __device__ __forceinline__ void operator()(const f32x4 (&acc)[2][2][4][2], const Unit& u, int wr, int wc, int fr, int fq) const {
        const int row0 = u.pm * BM + wr * 64 + fr, col0 = u.pn * BM + wc * 32 + 8 * fq;
        f32x4 bv[2][2];
#pragma unroll
        for (int bj = 0; bj < 2; ++bj)
#pragma unroll
            for (int n = 0; n < 2; ++n) bv[bj][n] = *(const f32x4*)(b2 + (size_t)u.pe * 1024 + col0 + bj * HALF + 4 * n);
#pragma unroll
        for (int ai = 0; ai < 2; ++ai)
#pragma unroll
            for (int m = 0; m < 4; ++m) { const int slot = rowslot[row0 + ai * HALF + m * 16];
                if (slot >= 0) { const float gt = gate[slot]; unsigned char* rowp = O + (size_t)slot * 1024 + col0;
#pragma unroll
                    for (int bj = 0; bj < 2; ++bj) { const f32x4 v0 = (acc[ai][bj][m][0] * (1.0f / W2_SCALE) + bv[bj][0]) * gt, v1 = (acc[ai][bj][m][1] * (1.0f / W2_SCALE) + bv[bj][1]) * gt;
                        *(unsigned long long*)(rowp + bj * HALF) = (unsigned long long)pk4_fp8(v0[0], v0[1], v0[2], v0[3]) | ((unsigned long long)pk4_fp8(v1[0], v1[1], v1[2], v1[3]) << 32); } } }
    }
};
}

__device__ __forceinline__ void ph_r2(Frame& F, int l) {
    const int lane = F.lane, tid = F.tid, gw = F.vcu * NWAVES + F.wave, NGW = F.G * NWAVES, nrows = l == 0 ? NTOK : NLAT;
    LAS float* Lv = (LAS float*)(F.lds + RING_OFF);
    { const float* ln2g = INP(IN_LN2G) + l * DM; const float* ln2b = INP(IN_LN2B) + l * DM; const int ln = l + 1 < DEPTH ? l + 1 : l;
      for (int i = tid; i < DM; i += 512) { Lv[i] = ln2g[i]; Lv[DM + i] = ln2b[i];
#pragma unroll
          for (int b = 0; b < 5; ++b) { Lv[(2 + b) * DM + i] = modp(F, l, b, 5)[i]; Lv[(7 + b) * DM + i] = modp(F, ln, b, 0)[i]; Lv[(12 + b) * DM + i] = modp(F, ln, b, 1)[i]; } } }
    __syncthreads();
    for (int rA = gw; rA < nrows; rA += 2 * NGW) {
        f32x4 xv[2][4]; unsigned yw[2][4][4];
#pragma unroll
        for (int q = 0; q < 2; ++q) { const int r0 = rA + q * NGW, r = r0 < nrows ? r0 : rA;
            const float* xsrc = WSP(float, WS_X1) + (size_t)r * DM; const unsigned char* y4 = WSP(unsigned char, WS_Y4) + (size_t)r * 4 * DM;
#pragma unroll
            for (int j = 0; j < 4; ++j) { xv[q][j] = ((const f32x4*)xsrc)[lane + 64 * j];
#pragma unroll
                for (int k = 0; k < 4; ++k) yw[q][j][k] = ((const GAS unsigned*)(y4 + (size_t)k * DM))[lane + 64 * j]; } }
#pragma unroll
        for (int q = 0; q < 2; ++q) { const int r = rA + q * NGW;
            if (r < nrows) { const int bsel = r < NLAT ? r / SEQ : 4; f32x4 v[4];
#pragma unroll
                for (int j = 0; j < 4; ++j) { f32x4 mo = {0.f, 0.f, 0.f, 0.f}; typedef float f32x2c __attribute__((ext_vector_type(2)));
#pragma unroll
                    for (int k = 0; k < 4; ++k) { const int w = (int)yw[q][j][k]; const f32x2c lo = __builtin_amdgcn_cvt_pk_f32_fp8(w, false), hi = __builtin_amdgcn_cvt_pk_f32_fp8(w, true); mo += (f32x4){lo.x, lo.y, hi.x, hi.y}; }
                    v[j] = xv[q][j] * DN_ALPHA + ((const LAS f32x4*)(Lv + (2 + bsel) * DM))[lane + 64 * j] * mo; }
                float mean, rstd; row_stats(v, mean, rstd);
                float* xdst = (l == DEPTH - 1) ? F.out + (size_t)r * DM : WSP(float, WS_X) + (size_t)r * DM;
#pragma unroll
                for (int j = 0; j < 4; ++j) { const f32x4 gg = ((const LAS f32x4*)Lv)[lane + 64 * j], bb = ((const LAS f32x4*)(Lv + DM))[lane + 64 * j];
                    v[j] = (v[j] - mean) * rstd * gg + bb; ((f32x4*)xdst)[lane + 64 * j] = v[j]; }
                if (l + 1 < DEPTH) { f32x4 sh[4], sc[4];
#pragma unroll
                    for (int j = 0; j < 4; ++j) { sh[j] = ((const LAS f32x4*)(Lv + (7 + bsel) * DM))[lane + 64 * j]; sc[j] = ((const LAS f32x4*)(Lv + (12 + bsel) * DM))[lane + 64 * j]; }
                    modulate_store_i8(F, v, sh, sc, WSP(unsigned char, WS_H) + (size_t)r * DM, WSP(float, WS_ROUTE) + RT_SH + r); } } }
    }
}

#define PHASE_LOCAL Frame P = F; int l = l_; asm volatile("" : "+s"(P.ws), "+s"(P.out), "+v"(P.tid), "+v"(P.lane), "+s"(P.wave), "+s"(P.vcu), "+s"(P.G), "+s"(l))
#define IN(k) (lo <= (k) && (k) < hi)
#define SEAM(k) do { if (IN((k) + 1)) xcd_barrier(bar); } while (0)
template <int LAYER> __device__ __forceinline__ void layer_body(Frame& F, const XcdBarrier& bar, const int lo, const int hi, unsigned char* lds) {
    {
        constexpr int l_ = LAYER; constexpr int pb = 2 + PH_PER_LAYER * l_;
        if (IN(pb + 0)) { PHASE_LOCAL;
            pg8::Gemm g{(const bf16*)(P.ws + WS_H), (const bf16*)(P.ws + WS_WIN + (size_t)l * DIN * DM), NTOK, DIN, DM / 2}; pg8::StaticOrder S; S.init(NTOK, DIN, P.G, (int)blockIdx.x);
            pg8::EpiI8S E{(bf16*)(P.ws + WS_P), DIN, CNQ / 256, C2, (const float*)(P.ws + WS_ROUTE) + RT_SH, (const int*)(F.ctl + CW_WCMAX) + l * DIN};
            REPS(2) pg8::gemm_phase<pg8::EpiI8S, pg8::StaticOrder, true, true, false, false, true>(P.lds + RING_OFF, g, S, E, P.tid);
            SEAM(pb + 0); }
        if (IN(pb + 1)) { PHASE_LOCAL; REPS(3) ph_prep(P, l); SEAM(pb + 1); }
        if (IN(pb + 2)) { PHASE_LOCAL; ph_mixers(P, l, (char*)lds + RING_OFF); SEAM(pb + 2); }
        if (IN(pb + 3)) { PHASE_LOCAL; REPS(4) ph_hy_post(P); SEAM(pb + 3); }
        if (IN(pb + 4)) { PHASE_LOCAL;
            const int M = l == 0 ? NTOK : NLAT;
            pg8::Gemm g{(const bf16*)(P.ws + WS_YMIX), (const bf16*)(P.ws + WS_WOUT) + (size_t)l * DM * DM, M, DM, DM}; pg8::StaticOrder S; S.init(M, DM, P.G, (int)blockIdx.x);
            pg8::EpiBf16<0> E{(bf16*)(P.ws + WS_Y), DM, nullptr, 0, 0, 1.f};
            REPS(5) pg8::gemm_phase<pg8::EpiBf16<0>, pg8::StaticOrder, true, true>(P.lds + RING_OFF, g, S, E, P.tid);
            SEAM(pb + 4); }
        if (IN(pb + 5)) { PHASE_LOCAL; REPS(6) ph_r1(P, l); SEAM(pb + 5); }
        if (IN(pb + 6)) { PHASE_LOCAL; REPS(7) ph_gather(P, l); SEAM(pb + 6); }
        if (IN(pb + 7)) { PHASE_LOCAL;
            pg8::Gemm g{(const bf16*)(P.ws + WS_H8), (const bf16*)(P.ws + WS_W1 + (size_t)l * NEXP * 2048 * DM), MAXSORT, 2048, DM / 2};
            LAS int* TTl = (LAS int*)(P.lds + LDS_TT_OFF); { const int* TTg = (const int*)(P.ws + WS_ROUTE) + RT_TT; if (P.tid < 320) TTl[P.tid] = TTg[P.tid]; __syncthreads(); }
            pg8::GroupedOrder S{TTl, 8, P.G, (int)blockIdx.x};
            pg8::EpiSwiGLU E{(unsigned char*)(P.ws + WS_ACT), INP(IN_EB1) + (size_t)l * NEXP * 2048};
            LAS int* gtab = (LAS int*)(P.lds + RING_OFF + pg8::STAGE_BYTES);
            { const int* rowslot = (const int*)(P.ws + WS_ROUTE) + RT_ROWSLOT; pg8::Unit uu;
              { const int half = P.tid >> 8, r = P.tid & 255;
#pragma unroll
                for (int i0 = 0; i0 < 16; i0 += 2) { int rt, pn; if (S.tile_of(i0 + half, rt, pn)) { const int slot = rowslot[rt * 256 + r]; gtab[(i0 + half) * 256 + r] = slot < 0 ? 0 : slot >> 2; } } }
              (void)uu;
              __syncthreads(); }
            REPS(8) pg8::gemm_phase<pg8::EpiSwiGLU, pg8::GroupedOrder, true, true, true, true>(P.lds + RING_OFF, g, S, E, P.tid, gtab);
            SEAM(pb + 7); }
        if (IN(pb + 8)) { PHASE_LOCAL;
            pg8::Gemm g{(const bf16*)(P.ws + WS_ACT), (const bf16*)(P.ws + WS_W2 + (size_t)l * NEXP * DM * DM), MAXSORT, DM, DM / 2};
            LAS int* TTl = (LAS int*)(P.lds + LDS_TT_OFF); { const int* TTg = (const int*)(P.ws + WS_ROUTE) + RT_TT; if (P.tid < 320) TTl[P.tid] = TTg[P.tid]; __syncthreads(); }
            pg8::GroupedOrder S{TTl, 4, P.G, (int)blockIdx.x};
            pg8::EpiMoeOut E{(unsigned char*)(P.ws + WS_Y4), INP(IN_EB2) + (size_t)l * NEXP * DM, (const float*)(P.ws + WS_ROUTE) + RT_GATE, (const int*)(P.ws + WS_ROUTE) + RT_ROWSLOT};
            REPS(9) pg8::gemm_phase<pg8::EpiMoeOut, pg8::GroupedOrder, true, true, true>(P.lds + RING_OFF, g, S, E, P.tid);
            SEAM(pb + 8); }
        if (IN(pb + 9)) { PHASE_LOCAL; REPS(10) ph_r2(P, l); SEAM(pb + 9); if ((PROBE_MASK >> 12) & 1) { for (int xb = 0; xb < 10; ++xb) xcd_barrier(bar); } }
    }
}
struct Args { const float* in[31]; float* out; unsigned char* ws; int ph_lo, ph_hi; };
__global__ void __launch_bounds__(NWAVES * 64, 2) mega_fwd(Args args) {
    extern __shared__ __attribute__((aligned(16))) unsigned char lds[];
    Frame F;
    F.lds = (LAS unsigned char*)lds;
    F.MISC = (volatile LAS unsigned*)(F.lds + LDSCTL_OFF);
    F.tid = threadIdx.x; F.lane = F.tid & 63; F.wave = __builtin_amdgcn_readfirstlane(F.tid >> 6);
    F.G = gridDim.x; { const int bx = blockIdx.x; F.vcu = (F.G % 8 == 0) ? (bx % 8) * (F.G / 8) + bx / 8 : bx; }
    F.ws = args.ws; F.ctl = (gu32*)(args.ws + WS_CTL); F.out = args.out;
    for (int u = F.tid; u < 1024 / 4; u += NWAVES * 64) ((LAS unsigned*)(F.lds + LDSCTL_OFF))[u] = 0u;
    __syncthreads();
    const int lo = args.ph_lo, hi = args.ph_hi;
    const bool multi = (hi - lo) > 1;
    XcdBarrier bar; bar.bar = (unsigned*)(F.ctl + CW_BAR); bar.x = 0; bar.st = nullptr;
    if (multi) bar = xcd_barrier_post((unsigned*)(F.ctl + CW_BAR), F.MISC + 8);

    if (IN(0)) { REPS(0) ph_prologue(F); SEAM(0); }
    if (IN(1)) { REPS(1) { ph_r0(F); { LAS float* scr = (LAS float*)(F.lds + RING_OFF + F.wave * 16640); const int gw = F.vcu * NWAVES + F.wave, NGW = F.G * NWAVES; for (int it = gw; it < 2 * 576; it += NGW) p1_win_i8_item(F, it, scr); } __syncthreads(); { Frame Fs = F; asm volatile("" : "+s"(Fs.ws), "+v"(Fs.tid), "+v"(Fs.lane), "+s"(Fs.wave)); for (int it = Fs.vcu; it < 512; it += Fs.G) hy_spectrum_item(Fs, it >> 8, it & 255); } } SEAM(1); }
    layer_body<0>(F, bar, lo, hi, lds);
    layer_body<1>(F, bar, lo, hi, lds);
#undef IN
#undef SEAM
}

#ifndef MK_N_LAUNCHES
#define MK_N_LAUNCHES 1
#endif
extern "C" void kernel_launch(void* const* d_in, const int* in_sizes, int n_in, void* d_out, int out_size, void* d_ws, size_t ws_size, hipStream_t stream) {
    static int grid = 0;
    if (grid == 0) {
        if (n_in != 31 || out_size != NLAT * DM || ws_size < WS_END) { fprintf(stderr, "kernel_launch: unexpected problem (n_in %d, out %d, ws %zu); nothing launched\n", n_in, out_size, ws_size); grid = -1; return; }
        int dev = 0, cus = 0, per_cu = 0;
        if (hipGetDevice(&dev) != hipSuccess || hipDeviceGetAttribute(&cus, hipDeviceAttributeMultiprocessorCount, dev) != hipSuccess) { grid = -1; return; }
        if (hipFuncSetAttribute((const void*)mega_fwd, hipFuncAttributeMaxDynamicSharedMemorySize, LDS_BYTES) != hipSuccess) { fprintf(stderr, "kernel_launch: hipFuncSetAttribute failed\n"); grid = -1; return; }
        if (hipOccupancyMaxActiveBlocksPerMultiprocessor(&per_cu, (const void*)mega_fwd, NWAVES * 64, LDS_BYTES) != hipSuccess || per_cu < 1)
            fprintf(stderr, "kernel_launch: note: occupancy query reports %d workgroups per CU\n", per_cu);
        (void)hipGetLastError();
        grid = cus;
        if (grid > 256) grid = 256;
    }
    if (grid < 0) return;
    if (hipMemsetAsync((char*)d_ws + WS_CTL, 0, CTL_ZERO_BYTES, stream) != hipSuccess) return;
    Args a{};
    for (int i = 0; i < 31; ++i) a.in[i] = (const float*)d_in[i];
    a.out = (float*)d_out; a.ws = (unsigned char*)d_ws;
    if (MK_N_LAUNCHES == 1) { a.ph_lo = 0; a.ph_hi = NPHASE; hipLaunchKernelGGL(mega_fwd, dim3(grid), dim3(NWAVES * 64), LDS_BYTES, stream, a); }
    else for (int k = 0; k < NPHASE; ++k) { a.ph_lo = k; a.ph_hi = k + 1; hipLaunchKernelGGL(mega_fwd, dim3(grid), dim3(NWAVES * 64), LDS_BYTES, stream, a); }
}
```
